# Optimizing an MI355X kernel written in HIP

```python
import math
import jax
import jax.numpy as jnp
from jax import lax
import numpy as np


D_MODEL = 1024
BATCH = 8
SEQ = 4096
DEPTH = 1

GRID_W = 64
CTX_LEN = 256
RET_HEADS = 4
RET_DK = D_MODEL // RET_HEADS
RET_DV = 2 * RET_DK
RET_CHUNK = 128
DIFF_DH = 64
DIFF_HEADS = D_MODEL // (2 * DIFF_DH)
DIFF_BLOCK = 128
D_FF = ((8 * D_MODEL // 3 + 127) // 128) * 128
CONV_W = 3
ROPE_BASE = 10000.0
LN_EPS = 1e-5
RET_Q = RET_HEADS * RET_DK
RET_V = RET_HEADS * RET_DV
DIFF_QK = DIFF_HEADS * 2 * DIFF_DH
DIFF_V = DIFF_HEADS * 2 * DIFF_DH
IN_SIZES = (RET_Q, RET_Q, RET_V, RET_V, DIFF_QK, DIFF_QK, DIFF_V, D_MODEL, D_MODEL)
N_IN = 2 * RET_Q + 2 * RET_V + 2 * DIFF_QK + DIFF_V + 2 * D_MODEL

kernel_name = 'hybrid_retention_diffattn_dit_layer'


def layer_norm(x, g, b):
    xf = x.astype(jnp.float32)
    mu = xf.mean(-1, keepdims=True)
    var = jnp.mean(jnp.square(xf - mu), -1, keepdims=True)
    return ((xf - mu) * lax.rsqrt(var + LN_EPS) * g + b).astype(x.dtype)


def axial_rope(row, col, head_dim):
    half = head_dim // 2
    inv = ROPE_BASE ** (-(jnp.arange(0, half, 2, dtype=jnp.float32) / half))
    ang = jnp.concatenate([row[:, None] * inv, col[:, None] * inv], axis=-1)
    return jnp.cos(ang), jnp.sin(ang)


def apply_rope(x, cos, sin):
    d = x.shape[-1] // 2
    x1, x2 = x[..., :d], x[..., d:]
    return jnp.concatenate([x1 * cos - x2 * sin, x2 * cos + x1 * sin], axis=-1)


def split_in(p):
    offs = np.cumsum(IN_SIZES)[:-1].tolist()
    return jnp.split(p, offs, axis=-1)


def to_heads(t, n):
    B, T, _ = t.shape
    return t.reshape(B, T, n, -1).transpose(0, 2, 1, 3)


def merge_heads(t):
    B, H, T, d = t.shape
    return t.transpose(0, 2, 1, 3).reshape(B, T, H * d)


def diff_qk_heads(t):
    B, T, _ = t.shape
    return t.reshape(B, T, DIFF_HEADS, 2, DIFF_DH).transpose(0, 2, 3, 1, 4)


def project_heads(p, rope_ret=None, rope_dif=None):
    qr, kr, vr, gr, qd, kd, vd, gate_r, gate_d = split_in(p)
    qr, kr, vr = to_heads(qr, RET_HEADS), to_heads(kr, RET_HEADS), to_heads(vr, RET_HEADS)
    qd, kd = diff_qk_heads(qd), diff_qk_heads(kd)
    vd = to_heads(vd, DIFF_HEADS)
    if rope_ret is not None:
        qr, kr = apply_rope(qr, *rope_ret), apply_rope(kr, *rope_ret)
        qd, kd = apply_rope(qd, *rope_dif), apply_rope(kd, *rope_dif)
    return (qr, kr * RET_DK ** -0.5, vr, gr, qd * DIFF_DH ** -0.5, kd, vd, gate_r, gate_d)


def retention_chunked(q, k, v, log_g, s0):
    B, H, T, _ = q.shape
    dv = v.shape[-1]
    n = T // RET_CHUNK
    pos = jnp.arange(RET_CHUNK, dtype=jnp.float32)
    rel = pos[:, None] - pos[None, :]
    d_in = jnp.where(rel >= 0, jnp.exp(jnp.maximum(rel, 0.0) * log_g[:, None, None]), 0.0)
    d_q = jnp.exp((pos + 1.0) * log_g[:, None])[..., None]
    d_k = jnp.exp((RET_CHUNK - 1.0 - pos) * log_g[:, None])[..., None]
    d_s = jnp.exp(RET_CHUNK * log_g)[:, None, None]

    def chunks(t):
        return t.reshape(B, H, n, RET_CHUNK, t.shape[-1]).transpose(2, 0, 1, 3, 4)

    def step(s, qkv):
        qc, kc, vc = qkv
        inner = jnp.einsum('bhqd,bhkd->bhqk', qc, kc) * d_in
        y = jnp.einsum('bhqk,bhkv->bhqv', inner, vc) + jnp.einsum('bhqd,bhdv->bhqv', qc, s) * d_q
        s = s * d_s + jnp.einsum('bhkd,bhkv->bhdv', kc * d_k, vc)
        return s, y

    s_fin, ys = lax.scan(step, s0, (chunks(q), chunks(k), chunks(v)))
    return ys.transpose(1, 2, 0, 3, 4).reshape(B, H, T, dv), s_fin


def context_state(k, v, log_g, reverse):
    P = k.shape[2]
    pos = jnp.arange(P, dtype=jnp.float32)
    dist = pos if reverse else (P - 1.0) - pos
    w = jnp.exp(dist[None, :] * log_g[:, None])
    return jnp.einsum('bhtd,bhtv->bhdv', k * w[None, :, :, None], v)


def flip_t(t):
    return t[:, :, ::-1]


def diff_attention(q, k, v, lam):
    B, H, _, T, d = q.shape
    nb = T // DIFF_BLOCK
    qb = q.reshape(B, H, 2, nb, DIFF_BLOCK, d).transpose(3, 0, 1, 2, 4, 5)

    def one(qblk):
        s = jnp.einsum('bhcqd,bhckd->bhcqk', qblk, k)
        p = jax.nn.softmax(s, axis=-1)
        a = p[:, :, 0] - lam * p[:, :, 1]
        return jnp.einsum('bhqk,bhkv->bhqv', a, v)

    o = lax.map(one, qb)
    return o.transpose(1, 2, 0, 3, 4).reshape(B, H, T, v.shape[-1])


def retention_readout(y, g, w):
    mu = y.mean(-1, keepdims=True)
    var = jnp.mean(jnp.square(y - mu), -1, keepdims=True)
    y = merge_heads((y - mu) * lax.rsqrt(var + LN_EPS))
    return (jax.nn.silu(g) * y) @ w


def diff_readout(o, g_sub, lam_init, w):
    o = o * lax.rsqrt(jnp.mean(jnp.square(o), -1, keepdims=True) + LN_EPS) * g_sub * (1.0 - lam_init)
    return merge_heads(o) @ w


def merge_branches(y_ret, y_dif, gate_r, gate_d, b_gate, w_o):
    gr = jax.nn.sigmoid(gate_r + b_gate[:D_MODEL])
    gd = jax.nn.sigmoid(gate_d + b_gate[D_MODEL:])
    return (gr * y_ret + gd * y_dif) @ w_o


def dwconv_centred(a, w, b):
    pad = CONV_W // 2
    T = a.shape[1]
    ap = jnp.pad(a, ((0, 0), (pad, pad), (0, 0)))
    out = b
    for j in range(CONV_W):
        out = out + ap[:, j:j + T] * w[j]
    return out


def conv_ffn(h, w_up, conv_w, conv_b, w_down):
    u, gate = jnp.split(h @ w_up, 2, axis=-1)
    u = dwconv_centred(u, conv_w, conv_b)
    return (jax.nn.gelu(u, approximate=False) * gate) @ w_down


def setup_inputs(seed: int = 0) -> dict:
    key = jax.random.key(seed)
    ks = jax.random.split(key, 24)
    L, D = DEPTH, D_MODEL
    beta = (8.0 * DEPTH) ** -0.25

    def nrm(k, shape, scale):
        return scale * jax.random.normal(k, shape, jnp.float32)

    gamma0 = 1.0 - 2.0 ** (-5.0 - np.arange(RET_HEADS, dtype=np.float32))
    logit0 = jnp.asarray(np.log(gamma0 / (1.0 - gamma0)), jnp.float32)
    return {
        'x': nrm(ks[0], (BATCH, SEQ, D), 1.0),
        'c': nrm(ks[1], (BATCH, D), 1.0),
        'ctx': nrm(ks[2], (BATCH, CTX_LEN, D), 1.0),
        'c_ctx': nrm(ks[3], (D,), 1.0),
        'ln_in_g': 1.0 + nrm(ks[4], (D,), 0.02),
        'ln_in_b': nrm(ks[5], (D,), 0.02),
        'w_mod': nrm(ks[6], (L, D, 6 * D), 0.5 * D ** -0.5),
        'b_mod': nrm(ks[7], (L, 6 * D), 0.02),
        'w_in': nrm(ks[8], (L, D, N_IN), D ** -0.5),
        'b_gate': nrm(ks[9], (L, 2 * D), 0.02),
        'ret_decay_logit': logit0 + nrm(ks[10], (L, 2, RET_HEADS), 0.1),
        'diff_lambda': nrm(ks[11], (L, 4, DIFF_DH), 0.1),
        'diff_subln_g': 1.0 + nrm(ks[12], (L, 2 * DIFF_DH), 0.02),
        'w_ret_out': nrm(ks[13], (L, RET_V, D), RET_V ** -0.5),
        'w_diff_out': nrm(ks[14], (L, DIFF_V, D), DIFF_V ** -0.5),
        'w_o': nrm(ks[15], (L, D, D), beta * D ** -0.5),
        'ln1_g': 1.0 + nrm(ks[16], (L, D), 0.02),
        'ln1_b': nrm(ks[17], (L, D), 0.02),
        'w_up': nrm(ks[18], (L, D, 2 * D_FF), D ** -0.5),
        'conv_w': nrm(ks[19], (L, CONV_W, D_FF), CONV_W ** -0.5),
        'conv_b': nrm(ks[20], (L, D_FF), 0.02),
        'w_down': nrm(ks[21], (L, D_FF, D), beta * D_FF ** -0.5),
        'ln2_g': 1.0 + nrm(ks[22], (L, D), 0.02),
        'ln2_b': nrm(ks[23], (L, D), 0.02),
    }


def reference(x, c, ctx, c_ctx, ln_in_g, ln_in_b, w_mod, b_mod, w_in, b_gate, ret_decay_logit,
              diff_lambda, diff_subln_g, w_ret_out, w_diff_out, w_o, ln1_g, ln1_b,
              w_up, conv_w, conv_b, w_down, ln2_g, ln2_b):
    f32 = jnp.float32
    dtype = x.dtype
    S = x.shape[1]
    ROWS = S // GRID_W
    row = jnp.repeat(jnp.arange(ROWS, dtype=f32), GRID_W)
    col = jnp.tile(jnp.arange(GRID_W, dtype=f32), ROWS)
    rope_ret = axial_rope(row, col, RET_DK)
    rope_dif = axial_rope(row, col, DIFF_DH)
    alpha = (2.0 * DEPTH) ** 0.25

    x = layer_norm(x, ln_in_g, ln_in_b)
    xc = layer_norm(ctx, ln_in_g, ln_in_b)
    cond = jax.nn.silu(c)
    cond_ctx = jax.nn.silu(c_ctx)

    for i in range(DEPTH):
        ctx_out = i < DEPTH - 1
        lam_init = 0.8 - 0.6 * math.exp(-0.3 * i)
        mod = cond @ w_mod[i] + b_mod[i]
        mod_c = cond_ctx @ w_mod[i] + b_mod[i]
        sh1, sc1, g1, sh2, sc2, g2 = jnp.split(mod[:, None, :], 6, axis=-1)
        sh1c, sc1c, g1c, sh2c, sc2c, g2c = jnp.split(mod_c, 6)

        lq1, lk1, lq2, lk2 = diff_lambda[i].astype(f32)
        lam = jnp.exp(jnp.sum(lq1 * lk1)) - jnp.exp(jnp.sum(lq2 * lk2)) + lam_init
        log_g = jax.nn.log_sigmoid(ret_decay_logit[i].astype(f32))

        p = ((x * (1 + sc1) + sh1) @ w_in[i]).astype(f32)
        pc = ((xc * (1 + sc1c) + sh1c) @ w_in[i]).astype(f32)
        qr, kr, vr, gr, qd, kd, vd, gate_r, gate_d = project_heads(p, rope_ret, rope_dif)
        qr_c, kr_c, vr_c, gr_c, qd_c, kd_c, vd_c, gate_r_c, gate_d_c = project_heads(pc)

        if ctx_out:
            zeros = jnp.zeros(kr_c.shape[:2] + (RET_DK, RET_DV), f32)
            yc_f, s_f = retention_chunked(qr_c, kr_c, vr_c, log_g[0], zeros)
            yc_b, s_b = retention_chunked(flip_t(qr_c), flip_t(kr_c), flip_t(vr_c), log_g[1], zeros)
            yc_ret = yc_f + flip_t(yc_b)
        else:
            s_f = context_state(kr_c, vr_c, log_g[0], reverse=False)
            s_b = context_state(kr_c, vr_c, log_g[1], reverse=True)
        y_f, _ = retention_chunked(qr, kr, vr, log_g[0], s_f)
        y_b, _ = retention_chunked(flip_t(qr), flip_t(kr), flip_t(vr), log_g[1], s_b)
        y_ret = retention_readout(y_f + flip_t(y_b), gr, w_ret_out[i])

        k_all = jnp.concatenate([kd, kd_c], axis=3)
        v_all = jnp.concatenate([vd, vd_c], axis=2)
        y_dif = diff_readout(diff_attention(qd, k_all, v_all, lam), diff_subln_g[i], lam_init, w_diff_out[i])

        y_mix = merge_branches(y_ret, y_dif, gate_r, gate_d, b_gate[i], w_o[i]).astype(dtype)
        x = layer_norm(alpha * x + g1 * y_mix, ln1_g[i], ln1_b[i])

        if ctx_out:
            yc_r = retention_readout(yc_ret, gr_c, w_ret_out[i])
            yc_d = diff_readout(diff_attention(qd_c, kd_c, vd_c, lam), diff_subln_g[i], lam_init, w_diff_out[i])
            yc_mix = merge_branches(yc_r, yc_d, gate_r_c, gate_d_c, b_gate[i], w_o[i]).astype(dtype)
            xc = layer_norm(alpha * xc + g1c * yc_mix, ln1_g[i], ln1_b[i])

        y_ff = conv_ffn(x * (1 + sc2) + sh2, w_up[i], conv_w[i], conv_b[i], w_down[i])
        x = layer_norm(alpha * x + g2 * y_ff, ln2_g[i], ln2_b[i])
        if ctx_out:
            yc_ff = conv_ffn(xc * (1 + sc2c) + sh2c, w_up[i], conv_w[i], conv_b[i], w_down[i])
            xc = layer_norm(alpha * xc + g2c * yc_ff, ln2_g[i], ln2_b[i])

    return x
```

```cpp
#include <hip/hip_runtime.h>
#include <cstdio>
#include <cstdint>
#include <cmath>

typedef unsigned short bf16_t;
typedef short bf16x8 __attribute__((ext_vector_type(8)));
typedef float f32x4 __attribute__((ext_vector_type(4)));

constexpr int D = 1024, NB = 8, SEQ = 4096, CTX = 256, ML = NB * SEQ  , MC = NB * CTX  , MA = ML + MC  ;
constexpr int NIN = 11264, DFF = 2816;
constexpr int C_QR = 0, C_KR = 1024, C_VR = 2048, C_GR = 4096, C_QD = 6144, C_KD = 7168, C_VD = 8192, C_GATE = 9216;
constexpr float LN_EPS = 1e-5f;
constexpr float ALPHA = 1.189207115002721f;
constexpr float LAM_INIT = 0.2f;

constexpr size_t MiB = 1u << 20;
constexpr size_t WS_MOD = 0;
constexpr size_t WS_TAB = 256 * 1024;
constexpr size_t WS_SCAL = 320 * 1024;
constexpr size_t WS_STATS = 512 * 1024;
constexpr size_t WS_RS = 1 * MiB;
constexpr size_t WS_WIN = 2 * MiB;
constexpr size_t WS_WRET = 24 * MiB;
constexpr size_t WS_WDIF = 28 * MiB;
constexpr size_t WS_WO = 30 * MiB;
constexpr size_t WS_WUP = 32 * MiB;
constexpr size_t WS_WDN = 43 * MiB;
constexpr size_t WS_XM = 50 * MiB;
constexpr size_t WS_R = 118 * MiB;
constexpr size_t WS_QR = WS_R;
constexpr size_t WS_KR = WS_R + 64 * MiB;
constexpr size_t WS_VR = WS_R + 132 * MiB;
constexpr size_t WS_SST = WS_R + 272 * MiB;
constexpr size_t WS_QD = WS_R;
constexpr size_t WS_KD = WS_R + 64 * MiB;
constexpr size_t WS_VD = WS_R + 132 * MiB;
constexpr size_t WS_OD = WS_R + 200 * MiB;
constexpr size_t WS_AD = WS_R + 328 * MiB;
constexpr size_t WS_SG = WS_R;
constexpr size_t WS_MR = WS_R + 128 * MiB;
constexpr size_t WS_MB = WS_R + 256 * MiB;
constexpr size_t WS_UG = WS_R;
constexpr size_t WS_H = WS_R + 176 * MiB;
constexpr size_t WS_NEED = 512 * MiB;

__device__ __forceinline__ float bf2f(bf16_t v) { return __uint_as_float(((unsigned)v) << 16); }
__device__ __forceinline__ bf16_t f2bf(float f) { unsigned u = __float_as_uint(f); return (bf16_t)((u + 0x7fffu + ((u >> 16) & 1u)) >> 16); }
__device__ __forceinline__ float siluf(float x) { return x / (1.f + __expf(-x)); }
__device__ __forceinline__ float sigmf(float x) { return 1.f / (1.f + __expf(-x)); }
__device__ __forceinline__ float wave_sum(float v) {
#pragma unroll
    for (int o = 1; o < 64; o <<= 1) v += __shfl_xor(v, o);
    return v;
}

__global__ __launch_bounds__(256) void k_convT(const float* __restrict__ W, int K, int N, int n0, bf16_t* __restrict__ Wt) {
    __shared__ float t[32][33];
    const int tx = threadIdx.x & 31, ty = threadIdx.x >> 5;
    const int nb = blockIdx.x * 32, kb = blockIdx.y * 32;
    for (int i = ty; i < 32; i += 8) t[i][tx] = W[(size_t)(kb + i) * N + n0 + nb + tx];
    __syncthreads();
    for (int i = ty; i < 32; i += 8) Wt[(size_t)(nb + i) * K + kb + tx] = f2bf(t[tx][i]);
}

__global__ __launch_bounds__(256) void k_mod(const float* __restrict__ c, const float* __restrict__ cctx, const float* __restrict__ wmod,
                                             const float* __restrict__ bmod, float* __restrict__ MOD) {
    __shared__ float sc[9][1024];
    for (int i = threadIdx.x; i < 9 * 1024; i += 256) { const int r = i >> 10, k = i & 1023; const float v = r < 8 ? c[r * 1024 + k] : cctx[k]; sc[r][k] = siluf(v); }
    __syncthreads();
    const int j = blockIdx.x * 256 + threadIdx.x;
    float acc[9];
#pragma unroll
    for (int r = 0; r < 9; ++r) acc[r] = bmod[j];
    for (int k = 0; k < 1024; ++k) { const float w = wmod[(size_t)k * 6144 + j];
#pragma unroll
        for (int r = 0; r < 9; ++r) acc[r] += sc[r][k] * w; }
#pragma unroll
    for (int r = 0; r < 9; ++r) MOD[r * 6144 + j] = acc[r];
}

__device__ __forceinline__ void sincos_acc(float ang, float& cs, float& sn) {
    const double TWO_PI = 6.283185307179586476925286766559;
    double a = (double)ang; const double k = rint(a / TWO_PI); double r = a - k * TWO_PI;
    const double r2 = r * r;
    double s = 1.0, c = 1.0;
#pragma unroll
    for (int n = 13; n >= 1; --n) { s = 1.0 - s * r2 / (double)((2 * n) * (2 * n + 1)); c = 1.0 - c * r2 / (double)((2 * n - 1) * (2 * n)); }
    sn = (float)(r * s); cs = (float)c;
}
__global__ __launch_bounds__(256) void k_tables(const float* __restrict__ logit, const float* __restrict__ dlam, float* __restrict__ TAB, float* __restrict__ SCAL) {
    const int tid = threadIdx.x;
    if (blockIdx.x == 0) {
        if (tid < 64) {
            float a = dlam[tid] * dlam[64 + tid], b = dlam[128 + tid] * dlam[192 + tid];
            a = wave_sum(a); b = wave_sum(b);
            if (tid == 0) SCAL[0] = expf(a) - expf(b) + LAM_INIT;
        } else if (tid < 72) { const float x = logit[tid - 64]; SCAL[1 + tid - 64] = fminf(x, 0.f) - log1pf(expf(-fabsf(x))); }
    }
    for (int i = blockIdx.x * 256 + tid; i < 64 * 64 + 64 * 16; i += gridDim.x * 256) {
        if (i < 4096) { const int p = i >> 6, f = i & 63; const float inv = powf(10000.f, -((float)(2 * f) / 128.f)); float cs, sn; sincos_acc((float)p * inv, cs, sn); TAB[i] = cs; TAB[4096 + i] = sn; }
        else { const int q = i - 4096, p = q >> 4, f = q & 15; const float inv = powf(10000.f, -((float)(2 * f) / 32.f)); float cs, sn; sincos_acc((float)p * inv, cs, sn); TAB[8192 + q] = cs; TAB[8192 + 1024 + q] = sn; }
    }
}

__global__ __launch_bounds__(256) void k_lnmod(const float* __restrict__ x, const float* __restrict__ ctx, const float* __restrict__ g, const float* __restrict__ bb,
                                               const float* __restrict__ MOD, bf16_t* __restrict__ XM, float* __restrict__ STATS) {
    const int lane = threadIdx.x & 63, row = blockIdx.x * 4 + (threadIdx.x >> 6);
    const float* src = row < ML ? x + (size_t)row * D : ctx + (size_t)(row - ML) * D;
    const int mr = row < ML ? row / SEQ : 8;
    const float* sh = MOD + mr * 6144; const float* sc = sh + 1024;
    f32x4 v[4]; float s = 0.f;
#pragma unroll
    for (int j = 0; j < 4; ++j) { v[j] = *(const f32x4*)(src + j * 256 + lane * 4); s += (v[j].x + v[j].y) + (v[j].z + v[j].w); }
    const float mean = wave_sum(s) * (1.f / D); float s2 = 0.f;
#pragma unroll
    for (int j = 0; j < 4; ++j) { v[j] = v[j] - mean; s2 += (v[j].x * v[j].x + v[j].y * v[j].y) + (v[j].z * v[j].z + v[j].w * v[j].w); }
    const float rstd = 1.f / sqrtf(wave_sum(s2) * (1.f / D) + LN_EPS);
    if (row < ML && lane == 0) { STATS[row * 2] = mean; STATS[row * 2 + 1] = rstd; }
#pragma unroll
    for (int j = 0; j < 4; ++j) { const int c0 = j * 256 + lane * 4;
        const f32x4 gg = *(const f32x4*)(g + c0), bv = *(const f32x4*)(bb + c0), s1 = *(const f32x4*)(sc + c0), h1 = *(const f32x4*)(sh + c0);
        const f32x4 xn = v[j] * rstd * gg + bv; const f32x4 o = xn * (s1 + 1.f) + h1;
        ushort4 w; w.x = f2bf(o.x); w.y = f2bf(o.y); w.z = f2bf(o.z); w.w = f2bf(o.w);
        *(ushort4*)(XM + (size_t)row * D + c0) = w; }
}

template <class Epi>
__global__ __launch_bounds__(256) void k_gemm(const bf16_t* __restrict__ A, int lda, const bf16_t* __restrict__ Bt, int ldb, int K, Epi epi) {
    const int wave = threadIdx.x >> 6, lane = threadIdx.x & 63, fr = lane & 15, fq = lane >> 4;
    const int row0 = blockIdx.y * 128 + (wave >> 1) * 64, col0 = blockIdx.x * 128 + (wave & 1) * 64;
    f32x4 acc[4][4];
#pragma unroll
    for (int i = 0; i < 4; ++i)
#pragma unroll
        for (int j = 0; j < 4; ++j) acc[i][j] = (f32x4){0.f, 0.f, 0.f, 0.f};
    const bf16_t* Ap = A + (size_t)(row0 + fr) * lda + fq * 8;
    const bf16_t* Bp = Bt + (size_t)(col0 + fr) * ldb + fq * 8;
    for (int k0 = 0; k0 < K; k0 += 32) {
        bf16x8 a[4], b[4];
#pragma unroll
        for (int i = 0; i < 4; ++i) { a[i] = *(const bf16x8*)(Ap + (size_t)i * 16 * lda + k0); b[i] = *(const bf16x8*)(Bp + (size_t)i * 16 * ldb + k0); }
#pragma unroll
        for (int i = 0; i < 4; ++i)
#pragma unroll
            for (int j = 0; j < 4; ++j) acc[i][j] = __builtin_amdgcn_mfma_f32_16x16x32_bf16(a[i], b[j], acc[i][j], 0, 0, 0);
    }
#pragma unroll
    for (int i = 0; i < 4; ++i)
#pragma unroll
        for (int j = 0; j < 4; ++j)
#pragma unroll
            for (int r = 0; r < 4; ++r) epi(row0 + i * 16 + fq * 4 + r, col0 + j * 16 + fr, acc[i][j][r]);
}

struct EpiRetQKV { bf16_t *QR, *KR, *VR;
    __device__ void operator()(int r, int c, float v) const {
        if (c < 1024) { if (r < ML) QR[(size_t)r * 1024 + c] = f2bf(v); }
        else if (c < 2048) KR[(size_t)r * 1024 + (c - 1024)] = f2bf(v * 0.0625f);
        else VR[(size_t)r * 2048 + (c - 2048)] = f2bf(v); } };
struct EpiDifQKV { bf16_t *QD, *KD, *VD;
    __device__ void operator()(int r, int c, float v) const {
        if (c < 1024) { if (r < ML) QD[(size_t)r * 1024 + c] = f2bf(v * 0.125f); }
        else if (c < 2048) KD[(size_t)r * 1024 + (c - 1024)] = f2bf(v);
        else VD[(size_t)r * 1024 + (c - 2048)] = f2bf(v); } };
struct EpiGr { bf16_t* YR; const float* RS;
    __device__ void operator()(int r, int c, float v) const {
        const int h = c >> 9; const float mu = RS[(r * 4 + h) * 2], rs = RS[(r * 4 + h) * 2 + 1];
        const size_t o = (size_t)r * 2048 + c; const float yn = (bf2f(YR[o]) - mu) * rs; YR[o] = f2bf(siluf(v) * yn); } };
struct EpiGate { bf16_t* SG; const float* bg;
    __device__ void operator()(int r, int c, float v) const { SG[(size_t)r * 2048 + c] = f2bf(sigmf(v + bg[c])); } };
struct EpiMr { float* MR; const bf16_t* SG;
    __device__ void operator()(int r, int c, float v) const { MR[(size_t)r * 1024 + c] = bf2f(SG[(size_t)r * 2048 + c]) * v; } };
struct EpiMb { bf16_t* MB; const float* MR; const bf16_t* SG;
    __device__ void operator()(int r, int c, float v) const { MB[(size_t)r * 1024 + c] = f2bf(MR[(size_t)r * 1024 + c] + bf2f(SG[(size_t)r * 2048 + 1024 + c]) * v); } };
struct EpiZ1 { float* Z; const float* x; const float* STATS; const float* g; const float* b; const float* MOD;
    __device__ void operator()(int r, int c, float v) const {
        const float xn = (x[(size_t)r * 1024 + c] - STATS[r * 2]) * STATS[r * 2 + 1] * g[c] + b[c];
        Z[(size_t)r * 1024 + c] = ALPHA * xn + MOD[(r / SEQ) * 6144 + 2048 + c] * v; } };
struct EpiUG { bf16_t* UG; int row_off; int pad;
    __device__ void operator()(int r, int c, float v) const { UG[(size_t)(r - row_off) * 5632 + c] = f2bf(v); } };
struct EpiZ2 { float* Z; const float* MOD;
    __device__ void operator()(int r, int c, float v) const { const size_t o = (size_t)r * 1024 + c; Z[o] = ALPHA * Z[o] + MOD[(r / SEQ) * 6144 + 5120 + c] * v; } };

__global__ __launch_bounds__(256) void k_rope_ret(bf16_t* __restrict__ X, const float* __restrict__ TAB) {
    const int idx = blockIdx.x * 256 + threadIdx.x;
    const int row = idx >> 9, p = idx & 511, h = p >> 7, j = p & 127;
    const int t = row & (SEQ - 1), pr = t >> 6, pc = t & 63;
    const int ti = j < 64 ? pr * 64 + j : pc * 64 + (j - 64);
    const float cs = TAB[ti], sn = TAB[4096 + ti];
    bf16_t* a = X + (size_t)row * 1024 + h * 256 + j;
    const float x1 = bf2f(a[0]), x2 = bf2f(a[128]);
    a[0] = f2bf(x1 * cs - x2 * sn); a[128] = f2bf(x2 * cs + x1 * sn);
}
__global__ __launch_bounds__(256) void k_rope_dif(bf16_t* __restrict__ X, const float* __restrict__ TAB) {
    const int idx = blockIdx.x * 256 + threadIdx.x;
    const int row = idx >> 9, p = idx & 511, blk = p >> 5, j = p & 31;
    const int t = row & (SEQ - 1), pr = t >> 6, pc = t & 63;
    const int ti = j < 16 ? pr * 16 + j : pc * 16 + (j - 16);
    const float cs = TAB[8192 + ti], sn = TAB[8192 + 1024 + ti];
    bf16_t* a = X + (size_t)row * 1024 + blk * 64 + j;
    const float x1 = bf2f(a[0]), x2 = bf2f(a[32]);
    a[0] = f2bf(x1 * cs - x2 * sn); a[32] = f2bf(x2 * cs + x1 * sn);
}

constexpr int RET_LDS = 128 * 256 * 2 * 2 + 128 * 64 * 2;
__global__ __launch_bounds__(512) void k_ret_naive(const bf16_t* __restrict__ QR, const bf16_t* __restrict__ KR, const bf16_t* __restrict__ VR,
                                                   bf16_t* __restrict__ YR, float* __restrict__ Sg, const float* __restrict__ SCAL) {
    extern __shared__ __attribute__((aligned(16))) unsigned char smem[];
    bf16_t* qs = (bf16_t*)smem; bf16_t* ks = qs + 128 * 256; bf16_t* vs = ks + 128 * 256; bf16_t* Ps = qs;
    const int tid = threadIdx.x, bid = blockIdx.x, vsl = bid & 7, h = (bid >> 3) & 3, b = bid >> 5;
    float* S = Sg + (size_t)bid * 16384;
    const float lgf = SCAL[1 + h], lgb = SCAL[5 + h];
    const int c = tid & 63, g8 = tid >> 6;
    for (int pass = 0; pass < 2; ++pass) {
        const float lg = pass ? lgb : lgf;
        for (int i = 0; i < 32; ++i) S[(g8 * 32 + i) * 64 + c] = 0.f;
        __syncthreads();
        for (int step = 0; step < 34; ++step) {
            const bool lat = step >= 2;
            int rowbase;
            if (!lat) { const int cc = pass ? 1 - step : step; rowbase = ML + b * CTX + cc * 128; }
            else { const int n = pass ? 33 - step : step - 2; rowbase = b * SEQ + n * 128; }
            for (int p = tid; p < 128 * 32; p += 512) { const int r = p >> 5, ch = p & 31;
                *(bf16x8*)(ks + r * 256 + ch * 8) = *(const bf16x8*)(KR + (size_t)(rowbase + r) * 1024 + h * 256 + ch * 8);
                if (lat) *(bf16x8*)(qs + r * 256 + ch * 8) = *(const bf16x8*)(QR + (size_t)(rowbase + r) * 1024 + h * 256 + ch * 8); }
            for (int p = tid; p < 128 * 8; p += 512) { const int r = p >> 3, ch = p & 7;
                *(bf16x8*)(vs + r * 64 + ch * 8) = *(const bf16x8*)(VR + (size_t)(rowbase + r) * 2048 + h * 512 + vsl * 64 + ch * 8); }
            __syncthreads();
            if (lat) {
                float yacc[16];
#pragma unroll
                for (int ii = 0; ii < 16; ++ii) { const int i = g8 * 16 + ii; float a = 0.f;
                    for (int d = 0; d < 256; ++d) a += bf2f(qs[i * 256 + d]) * bf2f(f2bf(S[d * 64 + c]));
                    yacc[ii] = a * __expf(lg * (pass ? (float)(128 - i) : (float)(i + 1))); }
                if (pass == 0) {
                    const int j = tid & 127, g4 = tid >> 7; float pv[32];
#pragma unroll
                    for (int ii = 0; ii < 32; ++ii) { const int i = g4 * 32 + ii; float a = 0.f;
                        for (int d = 0; d < 256; ++d) a += bf2f(qs[i * 256 + d]) * bf2f(ks[j * 256 + d]);
                        const float m = i > j ? __expf(lgf * (float)(i - j)) : (i < j ? __expf(lgb * (float)(j - i)) : 2.f);
                        pv[ii] = a * m; }
                    __syncthreads();
#pragma unroll
                    for (int ii = 0; ii < 32; ++ii) Ps[(g4 * 32 + ii) * 128 + j] = f2bf(pv[ii]);
                    __syncthreads();
#pragma unroll
                    for (int ii = 0; ii < 16; ++ii) { const int i = g8 * 16 + ii; float a = 0.f;
                        for (int jj = 0; jj < 128; ++jj) a += bf2f(Ps[i * 128 + jj]) * bf2f(vs[jj * 64 + c]);
                        yacc[ii] += a; }
                }
#pragma unroll
                for (int ii = 0; ii < 16; ++ii) { const int i = g8 * 16 + ii; bf16_t* yp = YR + (size_t)(rowbase + i) * 2048 + h * 512 + vsl * 64 + c;
                    if (pass == 0) *yp = f2bf(yacc[ii]); else *yp = f2bf(bf2f(*yp) + yacc[ii]); }
            }
            const float ds = __expf(lg * 128.f);
            float acc[32];
#pragma unroll
            for (int i = 0; i < 32; ++i) acc[i] = 0.f;
            for (int jj = 0; jj < 128; ++jj) { const float vv = bf2f(f2bf(bf2f(vs[jj * 64 + c]) * __expf(lg * (pass ? (float)jj : (float)(127 - jj)))));
#pragma unroll
                for (int i = 0; i < 32; ++i) acc[i] += bf2f(ks[jj * 256 + g8 * 32 + i]) * vv; }
            __syncthreads();
#pragma unroll
            for (int i = 0; i < 32; ++i) { float* sp = S + (g8 * 32 + i) * 64 + c; *sp = *sp * ds + acc[i]; }
            __syncthreads();
        }
    }
}

__global__ __launch_bounds__(256) void k_attn_naive(const bf16_t* __restrict__ QD, const bf16_t* __restrict__ KD, const bf16_t* __restrict__ VD, bf16_t* __restrict__ OD) {
    __shared__ __attribute__((aligned(16))) bf16_t Ks[64 * 64];
    __shared__ __attribute__((aligned(16))) bf16_t Vs[64 * 128];
    __shared__ float Pm[64 * 65];
    const int tid = threadIdx.x, qi = tid >> 2, part = tid & 3;
    const int qb = blockIdx.x & 63, cc = (blockIdx.x >> 6) & 1, h = (blockIdx.x >> 7) & 7, b = blockIdx.x >> 10;
    const int qrow = b * SEQ + qb * 64 + qi;
    float q[64];
#pragma unroll
    for (int d = 0; d < 64; ++d) q[d] = bf2f(QD[(size_t)qrow * 1024 + h * 128 + cc * 64 + d]);
    float o[32];
#pragma unroll
    for (int e = 0; e < 32; ++e) o[e] = 0.f;
    float m = -1e30f, l = 0.f;
    for (int kt = 0; kt < 68; ++kt) {
        const int krow0 = kt < 64 ? b * SEQ + kt * 64 : ML + b * CTX + (kt - 64) * 64;
        for (int p = tid; p < 64 * 8; p += 256) { const int r = p >> 3, ch = p & 7; *(bf16x8*)(Ks + r * 64 + ch * 8) = *(const bf16x8*)(KD + (size_t)(krow0 + r) * 1024 + h * 128 + cc * 64 + ch * 8); }
        for (int p = tid; p < 64 * 16; p += 256) { const int r = p >> 4, ch = p & 15; *(bf16x8*)(Vs + r * 128 + ch * 8) = *(const bf16x8*)(VD + (size_t)(krow0 + r) * 1024 + h * 128 + ch * 8); }
        __syncthreads();
        float s[16]; float mx = -1e30f;
#pragma unroll
        for (int jj = 0; jj < 16; ++jj) { const int j = part * 16 + jj; float a = 0.f;
#pragma unroll
            for (int d = 0; d < 64; ++d) a += q[d] * bf2f(Ks[j * 64 + d]);
            s[jj] = a; mx = fmaxf(mx, a); }
        mx = fmaxf(mx, __shfl_xor(mx, 1)); mx = fmaxf(mx, __shfl_xor(mx, 2));
        const float mn = fmaxf(m, mx), al = __expf(m - mn); m = mn;
        float ps = 0.f;
#pragma unroll
        for (int jj = 0; jj < 16; ++jj) { const float p = __expf(s[jj] - mn); ps += p; Pm[qi * 65 + part * 16 + jj] = bf2f(f2bf(p)); }
        l = l * al + ps;
#pragma unroll
        for (int e = 0; e < 32; ++e) o[e] *= al;
        __syncthreads();
        for (int j = 0; j < 64; ++j) { const float p = Pm[qi * 65 + j];
#pragma unroll
            for (int e = 0; e < 32; ++e) o[e] += p * bf2f(Vs[j * 128 + part * 32 + e]); }
        __syncthreads();
    }
    l += __shfl_xor(l, 1); l += __shfl_xor(l, 2);
    const float il = 1.f / l;
#pragma unroll
    for (int e = 0; e < 32; ++e) OD[(size_t)qrow * 2048 + h * 256 + cc * 128 + part * 32 + e] = f2bf(o[e] * il);
}

__global__ __launch_bounds__(256) void k_prep_diff(const bf16_t* __restrict__ OD, const float* __restrict__ gsub, const float* __restrict__ SCAL, bf16_t* __restrict__ AD) {
    const int row = blockIdx.x, h = threadIdx.x >> 5, l = threadIdx.x & 31; const float lam = SCAL[0];
    float a[4]; float ss = 0.f;
#pragma unroll
    for (int i = 0; i < 4; ++i) { const int e = l * 4 + i; a[i] = bf2f(OD[(size_t)row * 2048 + h * 256 + e]) - lam * bf2f(OD[(size_t)row * 2048 + h * 256 + 128 + e]); ss += a[i] * a[i]; }
    for (int o = 1; o < 32; o <<= 1) ss += __shfl_xor(ss, o);
    const float rs = 1.f / sqrtf(ss * (1.f / 128.f) + LN_EPS);
#pragma unroll
    for (int i = 0; i < 4; ++i) { const int e = l * 4 + i; AD[(size_t)row * 1024 + h * 128 + e] = f2bf(a[i] * rs * gsub[e] * (1.f - LAM_INIT)); }
}
__global__ __launch_bounds__(256) void k_ret_stats(const bf16_t* __restrict__ YR, float* __restrict__ RS) {
    const int row = blockIdx.x, h = threadIdx.x >> 6, lane = threadIdx.x & 63;
    float v[8]; float s = 0.f;
#pragma unroll
    for (int i = 0; i < 8; ++i) { v[i] = bf2f(YR[(size_t)row * 2048 + h * 512 + lane * 8 + i]); s += v[i]; }
    const float mu = wave_sum(s) * (1.f / 512.f); float s2 = 0.f;
#pragma unroll
    for (int i = 0; i < 8; ++i) { const float d = v[i] - mu; s2 += d * d; }
    const float var = wave_sum(s2) * (1.f / 512.f);
    if (lane == 0) { RS[(row * 4 + h) * 2] = mu; RS[(row * 4 + h) * 2 + 1] = 1.f / sqrtf(var + LN_EPS); }
}

__global__ __launch_bounds__(256) void k_ln_rows(float* __restrict__ Z, const float* __restrict__ g, const float* __restrict__ bb, const float* __restrict__ MOD, bf16_t* __restrict__ XM) {
    const int lane = threadIdx.x & 63, row = blockIdx.x * 4 + (threadIdx.x >> 6);
    float* src = Z + (size_t)row * D;
    f32x4 v[4]; float s = 0.f;
#pragma unroll
    for (int j = 0; j < 4; ++j) { v[j] = *(const f32x4*)(src + j * 256 + lane * 4); s += (v[j].x + v[j].y) + (v[j].z + v[j].w); }
    const float mean = wave_sum(s) * (1.f / D); float s2 = 0.f;
#pragma unroll
    for (int j = 0; j < 4; ++j) { v[j] = v[j] - mean; s2 += (v[j].x * v[j].x + v[j].y * v[j].y) + (v[j].z * v[j].z + v[j].w * v[j].w); }
    const float rstd = 1.f / sqrtf(wave_sum(s2) * (1.f / D) + LN_EPS);
    const float* sh = MOD + (row / SEQ) * 6144 + 3072; const float* sc = sh + 1024;
#pragma unroll
    for (int j = 0; j < 4; ++j) { const int c0 = j * 256 + lane * 4;
        const f32x4 gg = *(const f32x4*)(g + c0), bv = *(const f32x4*)(bb + c0);
        const f32x4 xn = v[j] * rstd * gg + bv; *(f32x4*)(src + c0) = xn;
        if (XM) { const f32x4 s1 = *(const f32x4*)(sc + c0), h1 = *(const f32x4*)(sh + c0); const f32x4 o = xn * (s1 + 1.f) + h1;
            ushort4 w; w.x = f2bf(o.x); w.y = f2bf(o.y); w.z = f2bf(o.z); w.w = f2bf(o.w); *(ushort4*)(XM + (size_t)row * D + c0) = w; } }
}

__global__ __launch_bounds__(256) void k_convgate(const bf16_t* __restrict__ UG, int row_off, const float* __restrict__ cw, const float* __restrict__ cb, bf16_t* __restrict__ H) {
    const size_t idx = (size_t)blockIdx.x * 256 + threadIdx.x;
    const int lr = (int)(idx / DFF), f = (int)(idx % DFF), row = row_off + lr, t = row & (SEQ - 1);
    float u = cb[f] + cw[DFF + f] * bf2f(UG[(size_t)lr * 5632 + f]);
    if (t > 0) u += cw[f] * bf2f(UG[(size_t)(lr - 1) * 5632 + f]);
    if (t < SEQ - 1) u += cw[2 * DFF + f] * bf2f(UG[(size_t)(lr + 1) * 5632 + f]);
    const float ge = 0.5f * u * (1.f + erff(u * 0.70710678118654752f));
    H[(size_t)row * DFF + f] = f2bf(ge * bf2f(UG[(size_t)lr * 5632 + DFF + f]));
}

template <class Epi> static void launch_gemm(const bf16_t* A, int lda, const bf16_t* Bt, int ldb, int M, int N, int K, Epi e, hipStream_t st) {
    hipLaunchKernelGGL((k_gemm<Epi>), dim3(N / 128, M / 128), dim3(256), 0, st, A, lda, Bt, ldb, K, e);
}

extern "C" void kernel_launch(void* const* d_in, const int* in_sizes, int n_in, void* d_out, int out_size, void* d_ws, size_t ws_size, hipStream_t stream) {
    static int inited = 0;
    if (!inited) {
        if (ws_size < WS_NEED) { fprintf(stderr, "kernel_launch: ws too small %zu\n", ws_size); inited = -1; return; }
        hipFuncSetAttribute((const void*)k_ret_naive, hipFuncAttributeMaxDynamicSharedMemorySize, RET_LDS);
        inited = 1;
    }
    if (inited < 0) return;
    const float* x = (const float*)d_in[0]; const float* c = (const float*)d_in[1]; const float* ctx = (const float*)d_in[2]; const float* cctx = (const float*)d_in[3];
    const float* lng = (const float*)d_in[4]; const float* lnb = (const float*)d_in[5]; const float* wmod = (const float*)d_in[6]; const float* bmod = (const float*)d_in[7];
    const float* win = (const float*)d_in[8]; const float* bgate = (const float*)d_in[9]; const float* logit = (const float*)d_in[10]; const float* dlam = (const float*)d_in[11];
    const float* gsub = (const float*)d_in[12]; const float* wret = (const float*)d_in[13]; const float* wdif = (const float*)d_in[14]; const float* wo = (const float*)d_in[15];
    const float* ln1g = (const float*)d_in[16]; const float* ln1b = (const float*)d_in[17]; const float* wup = (const float*)d_in[18]; const float* cw = (const float*)d_in[19];
    const float* cb = (const float*)d_in[20]; const float* wdn = (const float*)d_in[21]; const float* ln2g = (const float*)d_in[22]; const float* ln2b = (const float*)d_in[23];
    unsigned char* ws = (unsigned char*)d_ws; float* out = (float*)d_out;
    float* MOD = (float*)(ws + WS_MOD); float* TAB = (float*)(ws + WS_TAB); float* SCAL = (float*)(ws + WS_SCAL); float* STATS = (float*)(ws + WS_STATS); float* RS = (float*)(ws + WS_RS);
    bf16_t* WIN = (bf16_t*)(ws + WS_WIN); bf16_t* WRET = (bf16_t*)(ws + WS_WRET); bf16_t* WDIF = (bf16_t*)(ws + WS_WDIF); bf16_t* WO = (bf16_t*)(ws + WS_WO);
    bf16_t* WUP = (bf16_t*)(ws + WS_WUP); bf16_t* WDN = (bf16_t*)(ws + WS_WDN); bf16_t* XM = (bf16_t*)(ws + WS_XM);
    bf16_t* QR = (bf16_t*)(ws + WS_QR); bf16_t* KR = (bf16_t*)(ws + WS_KR); bf16_t* VR = (bf16_t*)(ws + WS_VR); float* SST = (float*)(ws + WS_SST);
    bf16_t* QD = (bf16_t*)(ws + WS_QD); bf16_t* KD = (bf16_t*)(ws + WS_KD); bf16_t* VD = (bf16_t*)(ws + WS_VD); bf16_t* OD = (bf16_t*)(ws + WS_OD); bf16_t* AD = (bf16_t*)(ws + WS_AD);
    bf16_t* SG = (bf16_t*)(ws + WS_SG); float* MR = (float*)(ws + WS_MR); bf16_t* MB = (bf16_t*)(ws + WS_MB);
    bf16_t* UG = (bf16_t*)(ws + WS_UG); bf16_t* H = (bf16_t*)(ws + WS_H);
    bf16_t* YR = (bf16_t*)d_out;

    hipLaunchKernelGGL(k_convT, dim3(NIN / 32, 1024 / 32), dim3(256), 0, stream, win, 1024, NIN, 0, WIN);
    hipLaunchKernelGGL(k_convT, dim3(1024 / 32, 2048 / 32), dim3(256), 0, stream, wret, 2048, 1024, 0, WRET);
    hipLaunchKernelGGL(k_convT, dim3(1024 / 32, 1024 / 32), dim3(256), 0, stream, wdif, 1024, 1024, 0, WDIF);
    hipLaunchKernelGGL(k_convT, dim3(1024 / 32, 1024 / 32), dim3(256), 0, stream, wo, 1024, 1024, 0, WO);
    hipLaunchKernelGGL(k_convT, dim3(5632 / 32, 1024 / 32), dim3(256), 0, stream, wup, 1024, 5632, 0, WUP);
    hipLaunchKernelGGL(k_convT, dim3(1024 / 32, 2816 / 32), dim3(256), 0, stream, wdn, 2816, 1024, 0, WDN);
    hipLaunchKernelGGL(k_mod, dim3(6144 / 256), dim3(256), 0, stream, c, cctx, wmod, bmod, MOD);
    hipLaunchKernelGGL(k_tables, dim3(20), dim3(256), 0, stream, logit, dlam, TAB, SCAL);
    hipLaunchKernelGGL(k_lnmod, dim3(MA / 4), dim3(256), 0, stream, x, ctx, lng, lnb, MOD, XM, STATS);
    launch_gemm(XM, 1024, WIN + (size_t)C_QR * 1024, 1024, MA, 4096, 1024, EpiRetQKV{QR, KR, VR}, stream);
    hipLaunchKernelGGL(k_rope_ret, dim3(ML * 512 / 256), dim3(256), 0, stream, QR, TAB);
    hipLaunchKernelGGL(k_rope_ret, dim3(ML * 512 / 256), dim3(256), 0, stream, KR, TAB);
    hipLaunchKernelGGL(k_ret_naive, dim3(256), dim3(512), RET_LDS, stream, QR, KR, VR, YR, SST, SCAL);
    hipLaunchKernelGGL(k_ret_stats, dim3(ML), dim3(256), 0, stream, YR, RS);
    launch_gemm(XM, 1024, WIN + (size_t)C_QD * 1024, 1024, MA, 3072, 1024, EpiDifQKV{QD, KD, VD}, stream);
    hipLaunchKernelGGL(k_rope_dif, dim3(ML * 512 / 256), dim3(256), 0, stream, QD, TAB);
    hipLaunchKernelGGL(k_rope_dif, dim3(ML * 512 / 256), dim3(256), 0, stream, KD, TAB);
    hipLaunchKernelGGL(k_attn_naive, dim3(NB * 8 * 2 * 64), dim3(256), 0, stream, QD, KD, VD, OD);
    hipLaunchKernelGGL(k_prep_diff, dim3(ML), dim3(256), 0, stream, OD, gsub, SCAL, AD);
    launch_gemm(XM, 1024, WIN + (size_t)C_GR * 1024, 1024, ML, 2048, 1024, EpiGr{YR, RS}, stream);
    launch_gemm(XM, 1024, WIN + (size_t)C_GATE * 1024, 1024, ML, 2048, 1024, EpiGate{SG, bgate}, stream);
    launch_gemm(YR, 2048, WRET, 2048, ML, 1024, 2048, EpiMr{MR, SG}, stream);
    launch_gemm(AD, 1024, WDIF, 1024, ML, 1024, 1024, EpiMb{MB, MR, SG}, stream);
    launch_gemm(MB, 1024, WO, 1024, ML, 1024, 1024, EpiZ1{out, x, STATS, lng, lnb, MOD}, stream);
    hipLaunchKernelGGL(k_ln_rows, dim3(ML / 4), dim3(256), 0, stream, out, ln1g, ln1b, MOD, XM);
    for (int hf = 0; hf < 2; ++hf) {
        const int r0 = hf * (ML / 2);
        hipLaunchKernelGGL((k_gemm<EpiUG>), dim3(5632 / 128, (ML / 2) / 128), dim3(256), 0, stream, XM + (size_t)r0 * 1024, 1024, WUP, 1024, 1024, EpiUG{UG, 0, 0});
        hipLaunchKernelGGL(k_convgate, dim3((unsigned)((size_t)(ML / 2) * DFF / 256)), dim3(256), 0, stream, UG, r0, cw, cb, H);
    }
    launch_gemm(H, DFF, WDN, DFF, ML, 1024, DFF, EpiZ2{out, MOD}, stream);
    hipLaunchKernelGGL(k_ln_rows, dim3(ML / 4), dim3(256), 0, stream, out, ln2g, ln2b, MOD, (bf16_t*)nullptr);
}
```

```cpp
#include <hip/hip_runtime.h>
#include <hip/hip_cooperative_groups.h>
namespace cg = cooperative_groups;
#include <cstdio>
#include <cstdint>
#include <cmath>

typedef unsigned short bf16_t;
typedef short bf16x8 __attribute__((ext_vector_type(8)));
typedef float f32x4 __attribute__((ext_vector_type(4)));

constexpr int D = 1024, NB = 8, SEQ = 4096, CTX = 256, ML = NB * SEQ  , MC = NB * CTX  , MA = ML + MC  ;
constexpr int NIN = 11264, DFF = 2816;
constexpr int C_QR = 0, C_KR = 1024, C_VR = 2048, C_GR = 4096, C_QD = 6144, C_KD = 7168, C_VD = 8192, C_GATE = 9216;
constexpr float LN_EPS = 1e-5f;
constexpr float ALPHA = 1.189207115002721f;
constexpr float LAM_INIT = 0.2f;

constexpr size_t MiB = 1u << 20;
constexpr size_t WS_MOD = 0;
constexpr size_t WS_TAB = 256 * 1024;
constexpr size_t WS_SCAL = 320 * 1024;
constexpr size_t WS_STATS = 512 * 1024;
constexpr size_t WS_RS = 1 * MiB;
constexpr size_t WS_WIN = 2 * MiB;
constexpr size_t WS_WRET = 24 * MiB;
constexpr size_t WS_WDIF = 28 * MiB;
constexpr size_t WS_WO = 30 * MiB;
constexpr size_t WS_WUP = 32 * MiB;
constexpr size_t WS_WDN = 43 * MiB;
constexpr size_t WS_XM = 50 * MiB;
constexpr size_t WS_R = 118 * MiB;
constexpr size_t WS_QR = WS_R;
constexpr size_t WS_KR = WS_R + 64 * MiB;
constexpr size_t WS_VR = WS_R + 132 * MiB;
constexpr size_t WS_SST = WS_R + 272 * MiB;
constexpr size_t WS_QD = WS_R;
constexpr size_t WS_KD = WS_R + 64 * MiB;
constexpr size_t WS_VD = WS_R + 132 * MiB;
constexpr size_t WS_OD = WS_R + 200 * MiB;
constexpr size_t WS_AD = WS_R + 328 * MiB;
constexpr size_t WS_SG = WS_R;
constexpr size_t WS_MR = WS_R + 128 * MiB;
constexpr size_t WS_MB = WS_R + 256 * MiB;
constexpr size_t WS_UG = WS_R;
constexpr size_t WS_H = WS_R + 176 * MiB;
constexpr size_t WS_NEED = 512 * MiB;

__device__ __forceinline__ float bf2f(bf16_t v) { return __uint_as_float(((unsigned)v) << 16); }
__device__ __forceinline__ bf16_t f2bf(float f) { unsigned u = __float_as_uint(f); return (bf16_t)((u + 0x7fffu + ((u >> 16) & 1u)) >> 16); }
__device__ __forceinline__ float siluf(float x) { return x / (1.f + __expf(-x)); }
__device__ __forceinline__ float sigmf(float x) { return 1.f / (1.f + __expf(-x)); }
__device__ __forceinline__ float wave_sum(float v) {
#pragma unroll
    for (int o = 1; o < 64; o <<= 1) v += __shfl_xor(v, o);
    return v;
}

#define LAS __attribute__((address_space(3)))
__device__ __forceinline__ unsigned pk2(float lo, float hi) { return (unsigned)f2bf(lo) | ((unsigned)f2bf(hi) << 16); }
typedef unsigned v4u __attribute__((ext_vector_type(4)));
__device__ __forceinline__ void transpose_item(const float* __restrict__ W, int K, int N, bf16_t* __restrict__ WT, float* scr, int item, int lane) {
    const int nblk = N / 32, kb = item / nblk, nb = item % nblk, k0 = 64 * kb, n0 = 32 * nb;
#pragma unroll 8
    for (int i = 0; i < 32; ++i) { const int kk = 2 * i + (lane >> 5); scr[kk * 33 + (lane & 31)] = W[(size_t)(k0 + kk) * N + n0 + (lane & 31)]; }
    __builtin_amdgcn_s_waitcnt(0xC07F); __builtin_amdgcn_wave_barrier();
    const int c = lane & 7;
#pragma unroll
    for (int j = 0; j < 4; ++j) { const int n = (lane >> 3) + 8 * j; const float* s = scr + (8 * c) * 33 + n;
        v4u o; o.x = pk2(s[0 * 33], s[1 * 33]); o.y = pk2(s[2 * 33], s[3 * 33]); o.z = pk2(s[4 * 33], s[5 * 33]); o.w = pk2(s[6 * 33], s[7 * 33]);
        *(v4u*)(WT + (size_t)(n0 + n) * K + k0 + 8 * c) = o; }
    __builtin_amdgcn_s_waitcnt(0xC07F); __builtin_amdgcn_wave_barrier();
}


struct Ctx { int tid, lane, wave, bx, G, gw, NGW, gt, NGT; unsigned char* lds; };

__device__ __forceinline__ void d_mod(const Ctx& C, const float* __restrict__ c, const float* __restrict__ cctx, const float* __restrict__ wmod,
                                      const float* __restrict__ bmod, float* __restrict__ MOD) {
    if (C.bx >= 192) return;
    float* sc = (float*)C.lds;
    float* red = sc + 9 * 1024;
    for (int i = C.tid; i < 9 * 1024; i += 512) { const int r = i >> 10, k = i & 1023; const float v = r < 8 ? c[r * 1024 + k] : cctx[k]; sc[i] = siluf(v); }
    __syncthreads();
    for (int grp = C.bx; grp < 192; grp += C.G) {
        const int col = C.tid & 31, ks = C.tid >> 5, j = grp * 32 + col;
        float acc[9];
#pragma unroll
        for (int r = 0; r < 9; ++r) acc[r] = 0.f;
        for (int k = ks * 64; k < ks * 64 + 64; ++k) { const float w = wmod[(size_t)k * 6144 + j];
#pragma unroll
            for (int r = 0; r < 9; ++r) acc[r] += sc[r * 1024 + k] * w; }
#pragma unroll
        for (int r = 0; r < 9; ++r) red[(ks * 9 + r) * 32 + col] = acc[r];
        __syncthreads();
        if (C.tid < 288) { const int r = C.tid >> 5, cc = C.tid & 31; float a = bmod[grp * 32 + cc];
#pragma unroll
            for (int s = 0; s < 16; ++s) a += red[(s * 9 + r) * 32 + cc];
            MOD[r * 6144 + grp * 32 + cc] = a; }
        __syncthreads();
    }
}

__device__ __forceinline__ void sincos_acc(float ang, float& cs, float& sn) {
    const double TWO_PI = 6.283185307179586476925286766559;
    double a = (double)ang; const double k = rint(a / TWO_PI); double r = a - k * TWO_PI;
    const double r2 = r * r;
    double s = 1.0, c = 1.0;
#pragma unroll
    for (int n = 13; n >= 1; --n) { s = 1.0 - s * r2 / (double)((2 * n) * (2 * n + 1)); c = 1.0 - c * r2 / (double)((2 * n - 1) * (2 * n)); }
    sn = (float)(r * s); cs = (float)c;
}
__device__ __forceinline__ void d_tables(const Ctx& C, const float* __restrict__ logit, const float* __restrict__ dlam, float* __restrict__ TAB, float* __restrict__ SCAL) {
    if (C.bx == C.G - 1) {
        if (C.tid < 64) { float a = dlam[C.tid] * dlam[64 + C.tid], b = dlam[128 + C.tid] * dlam[192 + C.tid];
            a = wave_sum(a); b = wave_sum(b);
            if (C.tid == 0) SCAL[0] = expf(a) - expf(b) + LAM_INIT;
        } else if (C.tid < 72) { const float x = logit[C.tid - 64]; SCAL[1 + C.tid - 64] = fminf(x, 0.f) - log1pf(expf(-fabsf(x))); }
    }
    for (int i = C.gt; i < 64 * 64 + 64 * 16; i += C.NGT) {
        if (i < 4096) { const int p = i >> 6, f = i & 63; const float inv = powf(10000.f, -((float)(2 * f) / 128.f)); float cs, sn; sincos_acc((float)p * inv, cs, sn); TAB[i] = cs; TAB[4096 + i] = sn; }
        else { const int q = i - 4096, p = q >> 4, f = q & 15; const float inv = powf(10000.f, -((float)(2 * f) / 32.f)); float cs, sn; sincos_acc((float)p * inv, cs, sn); TAB[8192 + q] = cs; TAB[8192 + 1024 + q] = sn; }
    }
}

__device__ __forceinline__ void d_lnmod(const Ctx& C, const float* __restrict__ x, const float* __restrict__ ctx, const float* __restrict__ g, const float* __restrict__ bb,
                                        const float* __restrict__ MOD, bf16_t* __restrict__ XM, float* __restrict__ STATS) {
    const int lane = C.lane;
    for (int row = C.gw; row < MA; row += C.NGW) {
        const float* src = row < ML ? x + (size_t)row * D : ctx + (size_t)(row - ML) * D;
        const int mr = row < ML ? row / SEQ : 8;
        const float* sh = MOD + mr * 6144; const float* sc = sh + 1024;
        f32x4 v[4]; float s = 0.f;
#pragma unroll
        for (int j = 0; j < 4; ++j) { v[j] = *(const f32x4*)(src + j * 256 + lane * 4); s += (v[j].x + v[j].y) + (v[j].z + v[j].w); }
        const float mean = wave_sum(s) * (1.f / D); float s2 = 0.f;
#pragma unroll
        for (int j = 0; j < 4; ++j) { v[j] = v[j] - mean; s2 += (v[j].x * v[j].x + v[j].y * v[j].y) + (v[j].z * v[j].z + v[j].w * v[j].w); }
        const float rstd = 1.f / sqrtf(wave_sum(s2) * (1.f / D) + LN_EPS);
        if (row < ML && lane == 0) { STATS[row * 2] = mean; STATS[row * 2 + 1] = rstd; }
#pragma unroll
        for (int j = 0; j < 4; ++j) { const int c0 = j * 256 + lane * 4;
            const f32x4 gg = *(const f32x4*)(g + c0), bv = *(const f32x4*)(bb + c0), s1 = *(const f32x4*)(sc + c0), h1 = *(const f32x4*)(sh + c0);
            const f32x4 xn = v[j] * rstd * gg + bv; const f32x4 o = xn * (s1 + 1.f) + h1;
            ushort4 w; w.x = f2bf(o.x); w.y = f2bf(o.y); w.z = f2bf(o.z); w.w = f2bf(o.w);
            *(ushort4*)(XM + (size_t)row * D + c0) = w; }
    }
}

template <class Epi>
__device__ __forceinline__ void d_gemm(const Ctx& C, const bf16_t* __restrict__ A, int lda, const bf16_t* __restrict__ Bt, int ldb, int M, int N, int K, const Epi& epi) {
    const int fr = C.lane & 15, fq = C.lane >> 4, ntn = N / 256, nt = (M / 128) * ntn;
    for (int t = C.bx; t < nt; t += C.G) {
        const int row0 = (t / ntn) * 128 + (C.wave >> 2) * 64, col0 = (t % ntn) * 256 + (C.wave & 3) * 64;
        f32x4 acc[4][4];
#pragma unroll
        for (int i = 0; i < 4; ++i)
#pragma unroll
            for (int j = 0; j < 4; ++j) acc[i][j] = (f32x4){0.f, 0.f, 0.f, 0.f};
        const bf16_t* Ap = A + (size_t)(row0 + fr) * lda + fq * 8;
        const bf16_t* Bp = Bt + (size_t)(col0 + fr) * ldb + fq * 8;
        for (int k0 = 0; k0 < K; k0 += 32) {
            bf16x8 a[4], b[4];
#pragma unroll
            for (int i = 0; i < 4; ++i) { a[i] = *(const bf16x8*)(Ap + (size_t)i * 16 * lda + k0); b[i] = *(const bf16x8*)(Bp + (size_t)i * 16 * ldb + k0); }
#pragma unroll
            for (int i = 0; i < 4; ++i)
#pragma unroll
                for (int j = 0; j < 4; ++j) acc[i][j] = __builtin_amdgcn_mfma_f32_16x16x32_bf16(a[i], b[j], acc[i][j], 0, 0, 0);
        }
#pragma unroll
        for (int i = 0; i < 4; ++i)
#pragma unroll
            for (int j = 0; j < 4; ++j)
#pragma unroll
                for (int r = 0; r < 4; ++r) epi(row0 + i * 16 + fq * 4 + r, col0 + j * 16 + fr, acc[i][j][r]);
    }
}

struct EpiRetQKV { bf16_t *QR, *KR, *VR;
    __device__ __forceinline__ void operator()(int r, int c, float v) const {
        if (c < 1024) { if (r < ML) QR[(size_t)r * 1024 + c] = f2bf(v); }
        else if (c < 2048) KR[(size_t)r * 1024 + (c - 1024)] = f2bf(v * 0.0625f);
        else VR[(size_t)r * 2048 + (c - 2048)] = f2bf(v); } };
struct EpiDifQKV { bf16_t *QD, *KD, *VD;
    __device__ __forceinline__ void operator()(int r, int c, float v) const {
        if (c < 1024) { if (r < ML) QD[(size_t)r * 1024 + c] = f2bf(v * 0.125f); }
        else if (c < 2048) KD[(size_t)r * 1024 + (c - 1024)] = f2bf(v);
        else VD[(size_t)r * 1024 + (c - 2048)] = f2bf(v); } };
struct EpiGr { bf16_t* YR; const float* RS;
    __device__ __forceinline__ void operator()(int r, int c, float v) const {
        const int h = c >> 9; const float mu = RS[(r * 4 + h) * 2], rs = RS[(r * 4 + h) * 2 + 1];
        const size_t o = (size_t)r * 2048 + c; const float yn = (bf2f(YR[o]) - mu) * rs; YR[o] = f2bf(siluf(v) * yn); } };
struct EpiGate { bf16_t* SG; const float* bg;
    __device__ __forceinline__ void operator()(int r, int c, float v) const { SG[(size_t)r * 2048 + c] = f2bf(sigmf(v + bg[c])); } };
struct EpiMr { float* MR; const bf16_t* SG;
    __device__ __forceinline__ void operator()(int r, int c, float v) const { MR[(size_t)r * 1024 + c] = bf2f(SG[(size_t)r * 2048 + c]) * v; } };
struct EpiMb { bf16_t* MB; const float* MR; const bf16_t* SG;
    __device__ __forceinline__ void operator()(int r, int c, float v) const { MB[(size_t)r * 1024 + c] = f2bf(MR[(size_t)r * 1024 + c] + bf2f(SG[(size_t)r * 2048 + 1024 + c]) * v); } };
struct EpiZ1 { float* Z; const float* x; const float* STATS; const float* g; const float* b; const float* MOD;
    __device__ __forceinline__ void operator()(int r, int c, float v) const {
        const float xn = (x[(size_t)r * 1024 + c] - STATS[r * 2]) * STATS[r * 2 + 1] * g[c] + b[c];
        Z[(size_t)r * 1024 + c] = ALPHA * xn + MOD[(r / SEQ) * 6144 + 2048 + c] * v; } };
struct EpiUG { bf16_t* UG;
    __device__ __forceinline__ void operator()(int r, int c, float v) const { UG[(size_t)r * 5632 + c] = f2bf(v); } };
struct EpiZ2 { float* Z; const float* MOD;
    __device__ __forceinline__ void operator()(int r, int c, float v) const { const size_t o = (size_t)r * 1024 + c; Z[o] = ALPHA * Z[o] + MOD[(r / SEQ) * 6144 + 5120 + c] * v; } };

__device__ __forceinline__ void d_rope_ret(const Ctx& C, bf16_t* __restrict__ X, const float* __restrict__ TAB) {
    for (int idx = C.gt; idx < ML * 512; idx += C.NGT) {
        const int row = idx >> 9, p = idx & 511, h = p >> 7, j = p & 127;
        const int t = row & (SEQ - 1), pr = t >> 6, pc = t & 63;
        const int ti = j < 64 ? pr * 64 + j : pc * 64 + (j - 64);
        const float cs = TAB[ti], sn = TAB[4096 + ti];
        bf16_t* a = X + (size_t)row * 1024 + h * 256 + j;
        const float x1 = bf2f(a[0]), x2 = bf2f(a[128]);
        a[0] = f2bf(x1 * cs - x2 * sn); a[128] = f2bf(x2 * cs + x1 * sn);
    }
}
__device__ __forceinline__ void d_rope_dif(const Ctx& C, bf16_t* __restrict__ X, const float* __restrict__ TAB) {
    for (int idx = C.gt; idx < ML * 512; idx += C.NGT) {
        const int row = idx >> 9, p = idx & 511, blk = p >> 5, j = p & 31;
        const int t = row & (SEQ - 1), pr = t >> 6, pc = t & 63;
        const int ti = j < 16 ? pr * 16 + j : pc * 16 + (j - 16);
        const float cs = TAB[8192 + ti], sn = TAB[8192 + 1024 + ti];
        bf16_t* a = X + (size_t)row * 1024 + blk * 64 + j;
        const float x1 = bf2f(a[0]), x2 = bf2f(a[32]);
        a[0] = f2bf(x1 * cs - x2 * sn); a[32] = f2bf(x2 * cs + x1 * sn);
    }
}

__device__ __forceinline__ void d_ret_naive(const Ctx& C, const bf16_t* __restrict__ QR, const bf16_t* __restrict__ KR, const bf16_t* __restrict__ VR,
                                            bf16_t* __restrict__ YR, float* __restrict__ Sg, const float* __restrict__ SCAL) {
    bf16_t* qs = (bf16_t*)C.lds; bf16_t* ks = qs + 128 * 256; bf16_t* vs = ks + 128 * 256; bf16_t* Ps = qs;
    const int tid = C.tid;
    for (int bid = C.bx; bid < 256; bid += C.G) {
    const int vsl = bid & 7, h = (bid >> 3) & 3, b = bid >> 5;
    float* S = Sg + (size_t)bid * 16384;
    const float lgf = SCAL[1 + h], lgb = SCAL[5 + h];
    const int c = tid & 63, g8 = tid >> 6;
    for (int pass = 0; pass < 2; ++pass) {
        const float lg = pass ? lgb : lgf;
        for (int i = 0; i < 32; ++i) S[(g8 * 32 + i) * 64 + c] = 0.f;
        __syncthreads();
        for (int step = 0; step < 34; ++step) {
            const bool lat = step >= 2;
            int tz = 0; asm volatile("" : "+v"(tz));
            int rowbase;
            if (!lat) { const int cc = pass ? 1 - step : step; rowbase = ML + b * CTX + cc * 128; }
            else { const int n = pass ? 33 - step : step - 2; rowbase = b * SEQ + n * 128; }
            for (int p = tid; p < 128 * 32; p += 512) { const int r = p >> 5, ch = p & 31;
                *(bf16x8*)(ks + r * 256 + ch * 8) = *(const bf16x8*)(KR + (size_t)(rowbase + r) * 1024 + h * 256 + ch * 8);
                if (lat) *(bf16x8*)(qs + r * 256 + ch * 8) = *(const bf16x8*)(QR + (size_t)(rowbase + r) * 1024 + h * 256 + ch * 8); }
            for (int p = tid; p < 128 * 8; p += 512) { const int r = p >> 3, ch = p & 7;
                *(bf16x8*)(vs + r * 64 + ch * 8) = *(const bf16x8*)(VR + (size_t)(rowbase + r) * 2048 + h * 512 + vsl * 64 + ch * 8); }
            __syncthreads();
            if (lat) {
                float yacc[16];
#pragma unroll
                for (int ii = 0; ii < 16; ++ii) { const int i = g8 * 16 + ii + tz; float a = 0.f;
#pragma unroll 2
                    for (int d = 0; d < 256; ++d) a += bf2f(qs[i * 256 + d]) * bf2f(f2bf(S[d * 64 + c]));
                    yacc[ii] = a * __expf(lg * (pass ? (float)(128 - i) : (float)(i + 1))); }
                if (pass == 0) {
                    const int j = (tid & 127) + tz, g4 = tid >> 7; float pv[32];
#pragma unroll
                    for (int ii = 0; ii < 32; ++ii) { const int i = g4 * 32 + ii; float a = 0.f;
#pragma unroll 2
                        for (int d = 0; d < 256; ++d) a += bf2f(qs[i * 256 + d]) * bf2f(ks[j * 256 + d]);
                        const float m = i > j ? __expf(lgf * (float)(i - j)) : (i < j ? __expf(lgb * (float)(j - i)) : 2.f);
                        pv[ii] = a * m; }
                    __syncthreads();
#pragma unroll
                    for (int ii = 0; ii < 32; ++ii) Ps[(g4 * 32 + ii) * 128 + j] = f2bf(pv[ii]);
                    __syncthreads();
#pragma unroll
                    for (int ii = 0; ii < 16; ++ii) { const int i = g8 * 16 + ii; float a = 0.f;
#pragma unroll 2
                        for (int jj = 0; jj < 128; ++jj) a += bf2f(Ps[i * 128 + jj]) * bf2f(vs[jj * 64 + c]);
                        yacc[ii] += a; }
                }
#pragma unroll
                for (int ii = 0; ii < 16; ++ii) { const int i = g8 * 16 + ii; bf16_t* yp = YR + (size_t)(rowbase + i) * 2048 + h * 512 + vsl * 64 + c;
                    if (pass == 0) *yp = f2bf(yacc[ii]); else *yp = f2bf(bf2f(*yp) + yacc[ii]); }
            }
            const float ds = __expf(lg * 128.f);
            float acc[32];
#pragma unroll
            for (int i = 0; i < 32; ++i) acc[i] = 0.f;
#pragma unroll 1
            for (int jj = 0; jj < 128; ++jj) { const float vv = bf2f(f2bf(bf2f(vs[jj * 64 + c]) * __expf(lg * (pass ? (float)(jj + tz) : (float)(127 - jj + tz)))));
#pragma unroll
                for (int i = 0; i < 32; ++i) acc[i] += bf2f(ks[jj * 256 + g8 * 32 + i]) * vv; }
            __syncthreads();
#pragma unroll
            for (int i = 0; i < 32; ++i) { float* sp = S + (g8 * 32 + i) * 64 + c; *sp = *sp * ds + acc[i]; }
            __syncthreads();
        }
    }
    }
}

constexpr int ATTN_NAIVE_LDS = 64 * 64 * 2 + 64 * 128 * 2 + 64 * 65 * 4;
__device__ __forceinline__ void d_attn_naive(const Ctx& C, const bf16_t* __restrict__ QD, const bf16_t* __restrict__ KD, const bf16_t* __restrict__ VD, bf16_t* __restrict__ OD) {
    const int half = C.tid >> 8, tid = C.tid & 255, qi = tid >> 2, part = tid & 3;
    unsigned char* base = C.lds + half * ATTN_NAIVE_LDS;
    bf16_t* Ks = (bf16_t*)base; bf16_t* Vs = Ks + 64 * 64; float* Pm = (float*)(Vs + 64 * 128);
    for (int vb2 = C.bx; vb2 < 4096; vb2 += C.G) {
        const int vb = vb2 * 2 + half;
        const int qb = vb & 63, cc = (vb >> 6) & 1, h = (vb >> 7) & 7, b = vb >> 10;
        const int qrow = b * SEQ + qb * 64 + qi;
        float q[64];
#pragma unroll
        for (int d = 0; d < 64; ++d) q[d] = bf2f(QD[(size_t)qrow * 1024 + h * 128 + cc * 64 + d]);
        float o[32];
#pragma unroll
        for (int e = 0; e < 32; ++e) o[e] = 0.f;
        float m = -1e30f, l = 0.f;
        for (int kt = 0; kt < 68; ++kt) {
            const int krow0 = kt < 64 ? b * SEQ + kt * 64 : ML + b * CTX + (kt - 64) * 64;
            for (int p = tid; p < 64 * 8; p += 256) { const int r = p >> 3, ch = p & 7; *(bf16x8*)(Ks + r * 64 + ch * 8) = *(const bf16x8*)(KD + (size_t)(krow0 + r) * 1024 + h * 128 + cc * 64 + ch * 8); }
            for (int p = tid; p < 64 * 16; p += 256) { const int r = p >> 4, ch = p & 15; *(bf16x8*)(Vs + r * 128 + ch * 8) = *(const bf16x8*)(VD + (size_t)(krow0 + r) * 1024 + h * 128 + ch * 8); }
            __syncthreads();
            float s[16]; float mx = -1e30f;
#pragma unroll
            for (int jj = 0; jj < 16; ++jj) { const int j = part * 16 + jj; float a = 0.f;
#pragma unroll
                for (int d = 0; d < 64; ++d) a += q[d] * bf2f(Ks[j * 64 + d]);
                s[jj] = a; mx = fmaxf(mx, a); }
            mx = fmaxf(mx, __shfl_xor(mx, 1)); mx = fmaxf(mx, __shfl_xor(mx, 2));
            const float mn = fmaxf(m, mx), al = __expf(m - mn); m = mn;
            float ps = 0.f;
#pragma unroll
            for (int jj = 0; jj < 16; ++jj) { const float p = __expf(s[jj] - mn); ps += p; Pm[qi * 65 + part * 16 + jj] = bf2f(f2bf(p)); }
            l = l * al + ps;
#pragma unroll
            for (int e = 0; e < 32; ++e) o[e] *= al;
            __syncthreads();
            for (int j = 0; j < 64; ++j) { const float p = Pm[qi * 65 + j];
#pragma unroll
                for (int e = 0; e < 32; ++e) o[e] += p * bf2f(Vs[j * 128 + part * 32 + e]); }
            __syncthreads();
        }
        l += __shfl_xor(l, 1); l += __shfl_xor(l, 2);
        const float il = 1.f / l;
#pragma unroll
        for (int e = 0; e < 32; ++e) OD[(size_t)qrow * 2048 + h * 256 + cc * 128 + part * 32 + e] = f2bf(o[e] * il);
    }
}

__device__ __forceinline__ void d_prep_diff(const Ctx& C, const bf16_t* __restrict__ OD, const float* __restrict__ gsub, const float* __restrict__ SCAL, bf16_t* __restrict__ AD) {
    const int t = C.tid & 255, h = t >> 5, l = t & 31; const float lam = SCAL[0];
    for (int r2 = C.bx; r2 < ML / 2; r2 += C.G) {
        const int row = r2 * 2 + (C.tid >> 8);
        float a[4]; float ss = 0.f;
#pragma unroll
        for (int i = 0; i < 4; ++i) { const int e = l * 4 + i; a[i] = bf2f(OD[(size_t)row * 2048 + h * 256 + e]) - lam * bf2f(OD[(size_t)row * 2048 + h * 256 + 128 + e]); ss += a[i] * a[i]; }
#pragma unroll
        for (int o = 1; o < 32; o <<= 1) ss += __shfl_xor(ss, o);
        const float rs = 1.f / sqrtf(ss * (1.f / 128.f) + LN_EPS);
#pragma unroll
        for (int i = 0; i < 4; ++i) { const int e = l * 4 + i; AD[(size_t)row * 1024 + h * 128 + e] = f2bf(a[i] * rs * gsub[e] * (1.f - LAM_INIT)); }
    }
}
__device__ __forceinline__ void d_ret_stats(const Ctx& C, const bf16_t* __restrict__ YR, float* __restrict__ RS) {
    for (int it = C.gw; it < ML * 4; it += C.NGW) {
        const int row = it >> 2, h = it & 3;
        float v[8]; float s = 0.f;
#pragma unroll
        for (int i = 0; i < 8; ++i) { v[i] = bf2f(YR[(size_t)row * 2048 + h * 512 + C.lane * 8 + i]); s += v[i]; }
        const float mu = wave_sum(s) * (1.f / 512.f); float s2 = 0.f;
#pragma unroll
        for (int i = 0; i < 8; ++i) { const float d = v[i] - mu; s2 += d * d; }
        const float var = wave_sum(s2) * (1.f / 512.f);
        if (C.lane == 0) { RS[it * 2] = mu; RS[it * 2 + 1] = 1.f / sqrtf(var + LN_EPS); }
    }
}

__device__ __forceinline__ void d_ln_rows(const Ctx& C, float* __restrict__ Z, const float* __restrict__ g, const float* __restrict__ bb, const float* __restrict__ MOD, bf16_t* __restrict__ XM) {
    const int lane = C.lane;
    for (int row = C.gw; row < ML; row += C.NGW) {
        float* src = Z + (size_t)row * D;
        f32x4 v[4]; float s = 0.f;
#pragma unroll
        for (int j = 0; j < 4; ++j) { v[j] = *(const f32x4*)(src + j * 256 + lane * 4); s += (v[j].x + v[j].y) + (v[j].z + v[j].w); }
        const float mean = wave_sum(s) * (1.f / D); float s2 = 0.f;
#pragma unroll
        for (int j = 0; j < 4; ++j) { v[j] = v[j] - mean; s2 += (v[j].x * v[j].x + v[j].y * v[j].y) + (v[j].z * v[j].z + v[j].w * v[j].w); }
        const float rstd = 1.f / sqrtf(wave_sum(s2) * (1.f / D) + LN_EPS);
        const float* sh = MOD + (row / SEQ) * 6144 + 3072; const float* sc = sh + 1024;
#pragma unroll
        for (int j = 0; j < 4; ++j) { const int c0 = j * 256 + lane * 4;
            const f32x4 gg = *(const f32x4*)(g + c0), bv = *(const f32x4*)(bb + c0);
            const f32x4 xn = v[j] * rstd * gg + bv; *(f32x4*)(src + c0) = xn;
            if (XM) { const f32x4 s1 = *(const f32x4*)(sc + c0), h1 = *(const f32x4*)(sh + c0); const f32x4 o = xn * (s1 + 1.f) + h1;
                ushort4 w; w.x = f2bf(o.x); w.y = f2bf(o.y); w.z = f2bf(o.z); w.w = f2bf(o.w); *(ushort4*)(XM + (size_t)row * D + c0) = w; } }
    }
}

__device__ __forceinline__ void d_convgate(const Ctx& C, const bf16_t* __restrict__ UG, int row_off, const float* __restrict__ cw, const float* __restrict__ cb, bf16_t* __restrict__ H) {
    for (int idx = C.gt; idx < (ML / 2) * DFF; idx += C.NGT) {
        const int lr = idx / DFF, f = idx % DFF, row = row_off + lr, t = row & (SEQ - 1);
        float u = cb[f] + cw[DFF + f] * bf2f(UG[(size_t)lr * 5632 + f]);
        if (t > 0) u += cw[f] * bf2f(UG[(size_t)(lr - 1) * 5632 + f]);
        if (t < SEQ - 1) u += cw[2 * DFF + f] * bf2f(UG[(size_t)(lr + 1) * 5632 + f]);
        const float ge = 0.5f * u * (1.f + erff(u * 0.70710678118654752f));
        H[(size_t)row * DFF + f] = f2bf(ge * bf2f(UG[(size_t)lr * 5632 + DFF + f]));
    }
}

constexpr int LDS_BYTES = 147456;
struct Params { const float* in[24]; float* out; unsigned char* ws; };
__global__ void __launch_bounds__(512, 2) mega(Params P) {
    extern __shared__ __attribute__((aligned(16))) unsigned char lds[];
    cg::grid_group grid = cg::this_grid();
    Ctx C; C.tid = threadIdx.x; C.lane = C.tid & 63; C.wave = C.tid >> 6; C.bx = blockIdx.x; C.G = gridDim.x;
    C.gw = C.bx * 8 + C.wave; C.NGW = C.G * 8; C.gt = C.bx * 512 + C.tid; C.NGT = C.G * 512; C.lds = lds;
    const float* x = P.in[0]; const float* c = P.in[1]; const float* ctx = P.in[2]; const float* cctx = P.in[3];
    const float* lng = P.in[4]; const float* lnb = P.in[5]; const float* wmod = P.in[6]; const float* bmod = P.in[7];
    const float* win = P.in[8]; const float* bgate = P.in[9]; const float* logit = P.in[10]; const float* dlam = P.in[11];
    const float* gsub = P.in[12]; const float* wret = P.in[13]; const float* wdif = P.in[14]; const float* wo = P.in[15];
    const float* ln1g = P.in[16]; const float* ln1b = P.in[17]; const float* wup = P.in[18]; const float* cw = P.in[19];
    const float* cb = P.in[20]; const float* wdn = P.in[21]; const float* ln2g = P.in[22]; const float* ln2b = P.in[23];
    unsigned char* ws = P.ws; float* out = P.out;
    float* MOD = (float*)(ws + WS_MOD); float* TAB = (float*)(ws + WS_TAB); float* SCAL = (float*)(ws + WS_SCAL); float* STATS = (float*)(ws + WS_STATS); float* RS = (float*)(ws + WS_RS);
    bf16_t* WIN = (bf16_t*)(ws + WS_WIN); bf16_t* WRET = (bf16_t*)(ws + WS_WRET); bf16_t* WDIF = (bf16_t*)(ws + WS_WDIF); bf16_t* WO = (bf16_t*)(ws + WS_WO);
    bf16_t* WUP = (bf16_t*)(ws + WS_WUP); bf16_t* WDN = (bf16_t*)(ws + WS_WDN); bf16_t* XM = (bf16_t*)(ws + WS_XM);
    bf16_t* QR = (bf16_t*)(ws + WS_QR); bf16_t* KR = (bf16_t*)(ws + WS_KR); bf16_t* VR = (bf16_t*)(ws + WS_VR); float* SST = (float*)(ws + WS_SST);
    bf16_t* QD = (bf16_t*)(ws + WS_QD); bf16_t* KD = (bf16_t*)(ws + WS_KD); bf16_t* VD = (bf16_t*)(ws + WS_VD); bf16_t* OD = (bf16_t*)(ws + WS_OD); bf16_t* AD = (bf16_t*)(ws + WS_AD);
    bf16_t* SG = (bf16_t*)(ws + WS_SG); float* MR = (float*)(ws + WS_MR); bf16_t* MB = (bf16_t*)(ws + WS_MB);
    bf16_t* UG = (bf16_t*)(ws + WS_UG); bf16_t* H = (bf16_t*)(ws + WS_H);
    bf16_t* YR = (bf16_t*)out;

    {
        float* scr = (float*)(lds + 65536) + C.wave * (64 * 33);
        constexpr int I_IN = 16 * 352, I_RET = 32 * 32, I_DIF = 16 * 32, I_O = 16 * 32, I_UP = 16 * 176, I_DN = 44 * 32;
        constexpr int NIT = I_IN + I_RET + I_DIF + I_O + I_UP + I_DN;
        for (int it = C.gw; it < NIT; it += C.NGW) {
            int r = it;
            if (r < I_IN) { transpose_item(win, 1024, NIN, WIN, scr, r, C.lane); continue; } r -= I_IN;
            if (r < I_RET) { transpose_item(wret, 2048, 1024, WRET, scr, r, C.lane); continue; } r -= I_RET;
            if (r < I_DIF) { transpose_item(wdif, 1024, 1024, WDIF, scr, r, C.lane); continue; } r -= I_DIF;
            if (r < I_O) { transpose_item(wo, 1024, 1024, WO, scr, r, C.lane); continue; } r -= I_O;
            if (r < I_UP) { transpose_item(wup, 1024, 5632, WUP, scr, r, C.lane); continue; } r -= I_UP;
            transpose_item(wdn, 2816, 1024, WDN, scr, r, C.lane);
        }
        d_mod(C, c, cctx, wmod, bmod, MOD);
        d_tables(C, logit, dlam, TAB, SCAL);
    }
    grid.sync();
    d_lnmod(C, x, ctx, lng, lnb, MOD, XM, STATS);
    grid.sync();
    d_gemm(C, XM, 1024, WIN + (size_t)C_QR * 1024, 1024, MA, 4096, 1024, EpiRetQKV{QR, KR, VR});
    grid.sync();
    d_rope_ret(C, QR, TAB); d_rope_ret(C, KR, TAB);
    grid.sync();
    d_ret_naive(C, QR, KR, VR, YR, SST, SCAL);
    grid.sync();
    d_ret_stats(C, YR, RS);
    d_gemm(C, XM, 1024, WIN + (size_t)C_QD * 1024, 1024, MA, 3072, 1024, EpiDifQKV{QD, KD, VD});
    grid.sync();
    d_rope_dif(C, QD, TAB); d_rope_dif(C, KD, TAB);
    grid.sync();
    d_attn_naive(C, QD, KD, VD, OD);
    grid.sync();
    d_prep_diff(C, OD, gsub, SCAL, AD);
    d_gemm(C, XM, 1024, WIN + (size_t)C_GR * 1024, 1024, ML, 2048, 1024, EpiGr{YR, RS});
    grid.sync();
    d_gemm(C, XM, 1024, WIN + (size_t)C_GATE * 1024, 1024, ML, 2048, 1024, EpiGate{SG, bgate});
    grid.sync();
    d_gemm(C, YR, 2048, WRET, 2048, ML, 1024, 2048, EpiMr{MR, SG});
    grid.sync();
    d_gemm(C, AD, 1024, WDIF, 1024, ML, 1024, 1024, EpiMb{MB, MR, SG});
    grid.sync();
    d_gemm(C, MB, 1024, WO, 1024, ML, 1024, 1024, EpiZ1{out, x, STATS, lng, lnb, MOD});
    grid.sync();
    d_ln_rows(C, out, ln1g, ln1b, MOD, XM);
    grid.sync();
    for (int hf = 0; hf < 2; ++hf) {
        const int r0 = hf * (ML / 2);
        d_gemm(C, XM + (size_t)r0 * 1024, 1024, WUP, 1024, ML / 2, 5632, 1024, EpiUG{UG});
        grid.sync();
        d_convgate(C, UG, r0, cw, cb, H);
        grid.sync();
    }
    d_gemm(C, H, DFF, WDN, DFF, ML, 1024, DFF, EpiZ2{out, MOD});
    grid.sync();
    d_ln_rows(C, out, ln2g, ln2b, MOD, (bf16_t*)nullptr);
}

extern "C" void kernel_launch(void* const* d_in, const int* in_sizes, int n_in, void* d_out, int out_size, void* d_ws, size_t ws_size, hipStream_t stream) {
    static int grid = 0;
    if (grid == 0) {
        if (n_in != 24 || ws_size < WS_NEED) { fprintf(stderr, "kernel_launch: unexpected n_in %d / ws %zu\n", n_in, ws_size); grid = -1; return; }
        int dev = 0, cus = 0, per_cu = 0;
        if (hipGetDevice(&dev) != hipSuccess || hipDeviceGetAttribute(&cus, hipDeviceAttributeMultiprocessorCount, dev) != hipSuccess) { grid = -1; return; }
        if (hipFuncSetAttribute((const void*)mega, hipFuncAttributeMaxDynamicSharedMemorySize, LDS_BYTES) != hipSuccess) { fprintf(stderr, "kernel_launch: hipFuncSetAttribute failed\n"); grid = -1; return; }
        if (hipOccupancyMaxActiveBlocksPerMultiprocessor(&per_cu, (const void*)mega, 512, LDS_BYTES) != hipSuccess || per_cu < 1) { fprintf(stderr, "kernel_launch: occupancy query failed (%d)\n", per_cu); (void)hipGetLastError(); grid = -1; return; }
        grid = cus * 1;
        fprintf(stderr, "kernel_launch: cus %d per_cu %d grid %d\n", cus, per_cu, grid);
    }
    if (grid < 0) return;
    Params p{};
    for (int i = 0; i < 24; ++i) p.in[i] = (const float*)d_in[i];
    p.out = (float*)d_out; p.ws = (unsigned char*)d_ws;
    void* args[] = {&p};
    hipError_t e = hipLaunchCooperativeKernel((const void*)mega, dim3(grid), dim3(512), args, LDS_BYTES, stream);
    if (e != hipSuccess) fprintf(stderr, "kernel_launch: cooperative launch failed: %s (grid %d)\n", hipGetErrorString(e), grid);
}
```

```cpp
#include <hip/hip_runtime.h>
#include <hip/hip_cooperative_groups.h>
namespace cg = cooperative_groups;
#include <cstdio>
#include <cstdint>
#include <cmath>

typedef unsigned short bf16_t;
typedef short bf16x8 __attribute__((ext_vector_type(8)));
typedef float f32x4 __attribute__((ext_vector_type(4)));

constexpr int D = 1024, NB = 8, SEQ = 4096, CTX = 256, ML = NB * SEQ  , MC = NB * CTX  , MA = ML + MC  ;
constexpr int NIN = 11264, DFF = 2816;
constexpr int C_QR = 0, C_KR = 1024, C_VR = 2048, C_GR = 4096, C_QD = 6144, C_KD = 7168, C_VD = 8192, C_GATE = 9216;
constexpr float LN_EPS = 1e-5f;
constexpr float ALPHA = 1.189207115002721f;
constexpr float LAM_INIT = 0.2f;

constexpr size_t MiB = 1u << 20;
constexpr size_t WS_MOD = 0;
constexpr size_t WS_TAB = 256 * 1024;
constexpr size_t WS_SCAL = 320 * 1024;
constexpr size_t WS_STATS = 512 * 1024;
constexpr size_t WS_RS = 1 * MiB;
constexpr size_t WS_WIN = 2 * MiB;
constexpr size_t WS_WRET = 24 * MiB;
constexpr size_t WS_WDIF = 28 * MiB;
constexpr size_t WS_WO = 30 * MiB;
constexpr size_t WS_WUP = 32 * MiB;
constexpr size_t WS_WDN = 43 * MiB;
constexpr size_t WS_XM = 50 * MiB;
constexpr size_t WS_R = 118 * MiB;
constexpr size_t WS_QR = WS_R;
constexpr size_t WS_KR = WS_R + 64 * MiB;
constexpr size_t WS_VR = WS_R + 132 * MiB;
constexpr size_t WS_SST = WS_R + 272 * MiB;
constexpr size_t WS_QD = WS_R;
constexpr size_t WS_KD = WS_R + 64 * MiB;
constexpr size_t WS_VD = WS_R + 132 * MiB;
constexpr size_t WS_OD = WS_R + 200 * MiB;
constexpr size_t WS_AD = WS_R + 328 * MiB;
constexpr size_t WS_SG = WS_R;
constexpr size_t WS_MR = WS_R + 128 * MiB;
constexpr size_t WS_MB = WS_R + 256 * MiB;
constexpr size_t WS_UG = WS_R;
constexpr size_t WS_H = WS_R + 176 * MiB;
constexpr size_t WS_NEED = 512 * MiB;

__device__ __forceinline__ float bf2f(bf16_t v) { return __uint_as_float(((unsigned)v) << 16); }
__device__ __forceinline__ bf16_t f2bf(float f) { unsigned u = __float_as_uint(f); return (bf16_t)((u + 0x7fffu + ((u >> 16) & 1u)) >> 16); }
__device__ __forceinline__ float siluf(float x) { return x / (1.f + __expf(-x)); }
__device__ __forceinline__ float sigmf(float x) { return 1.f / (1.f + __expf(-x)); }
__device__ __forceinline__ float wave_sum(float v) {
#pragma unroll
    for (int o = 1; o < 64; o <<= 1) v += __shfl_xor(v, o);
    return v;
}

#define LAS __attribute__((address_space(3)))
__device__ __forceinline__ unsigned pk2(float lo, float hi) { return (unsigned)f2bf(lo) | ((unsigned)f2bf(hi) << 16); }
typedef unsigned v4u __attribute__((ext_vector_type(4)));
template <int MAP>
__device__ __forceinline__ void transpose_item(const float* __restrict__ W, int K, int N, bf16_t* __restrict__ WT, float* scr, int item, int lane) {
    const int nblk = N / 32, kb = item / nblk, nb = item % nblk, k0 = 64 * kb, n0 = 32 * nb;
    int s0 = n0;
    if (MAP == 1) { if (n0 >= C_QD && n0 < C_QD + 2048) { const int r = n0 - C_QD, t = r >> 8, p = r & 255, bj = p >> 7, qq = p & 127; s0 = C_QD + t * 256 + 64 * (qq >> 5) + 32 * bj; } }
    if (MAP == 2) { const int t = n0 >> 8, p = n0 & 255; s0 = p < 128 ? 128 * t + p : 2816 + 128 * t + (p - 128); }
#pragma unroll 8
    for (int i = 0; i < 32; ++i) { const int kk = 2 * i + (lane >> 5); scr[kk * 33 + (lane & 31)] = W[(size_t)(k0 + kk) * N + s0 + (lane & 31)]; }
    __builtin_amdgcn_s_waitcnt(0xC07F); __builtin_amdgcn_wave_barrier();
    const int c = lane & 7;
#pragma unroll
    for (int j = 0; j < 4; ++j) { const int n = (lane >> 3) + 8 * j; const float* s = scr + (8 * c) * 33 + n;
        v4u o; o.x = pk2(s[0 * 33], s[1 * 33]); o.y = pk2(s[2 * 33], s[3 * 33]); o.z = pk2(s[4 * 33], s[5 * 33]); o.w = pk2(s[6 * 33], s[7 * 33]);
        *(v4u*)(WT + (size_t)(n0 + n) * K + k0 + 8 * c) = o; }
    __builtin_amdgcn_s_waitcnt(0xC07F); __builtin_amdgcn_wave_barrier();
}


struct Ctx { int tid, lane, wave, bx, G, gw, NGW, gt, NGT; unsigned char* lds; };

__device__ __forceinline__ void d_mod(const Ctx& C, const float* __restrict__ c, const float* __restrict__ cctx, const float* __restrict__ wmod,
                                      const float* __restrict__ bmod, float* __restrict__ MOD) {
    if (C.bx >= 192) return;
    float* sc = (float*)C.lds;
    float* red = sc + 9 * 1024;
    for (int i = C.tid; i < 9 * 1024; i += 512) { const int r = i >> 10, k = i & 1023; const float v = r < 8 ? c[r * 1024 + k] : cctx[k]; sc[i] = siluf(v); }
    __syncthreads();
    for (int grp = C.bx; grp < 192; grp += C.G) {
        const int col = C.tid & 31, ks = C.tid >> 5, j = grp * 32 + col;
        float acc[9];
#pragma unroll
        for (int r = 0; r < 9; ++r) acc[r] = 0.f;
        for (int k = ks * 64; k < ks * 64 + 64; ++k) { const float w = wmod[(size_t)k * 6144 + j];
#pragma unroll
            for (int r = 0; r < 9; ++r) acc[r] += sc[r * 1024 + k] * w; }
#pragma unroll
        for (int r = 0; r < 9; ++r) red[(ks * 9 + r) * 32 + col] = acc[r];
        __syncthreads();
        if (C.tid < 288) { const int r = C.tid >> 5, cc = C.tid & 31; float a = bmod[grp * 32 + cc];
#pragma unroll
            for (int s = 0; s < 16; ++s) a += red[(s * 9 + r) * 32 + cc];
            MOD[r * 6144 + grp * 32 + cc] = a; }
        __syncthreads();
    }
}

__device__ __forceinline__ void sincos_acc(float ang, float& cs, float& sn) {
    const double TWO_PI = 6.283185307179586476925286766559;
    double a = (double)ang; const double k = rint(a / TWO_PI); double r = a - k * TWO_PI;
    const double r2 = r * r;
    double s = 1.0, c = 1.0;
#pragma unroll
    for (int n = 13; n >= 1; --n) { s = 1.0 - s * r2 / (double)((2 * n) * (2 * n + 1)); c = 1.0 - c * r2 / (double)((2 * n - 1) * (2 * n)); }
    sn = (float)(r * s); cs = (float)c;
}
__device__ __forceinline__ void d_tables(const Ctx& C, const float* __restrict__ logit, const float* __restrict__ dlam, float* __restrict__ TAB, float* __restrict__ SCAL) {
    if (C.bx == C.G - 1) {
        if (C.tid < 64) { float a = dlam[C.tid] * dlam[64 + C.tid], b = dlam[128 + C.tid] * dlam[192 + C.tid];
            a = wave_sum(a); b = wave_sum(b);
            if (C.tid == 0) SCAL[0] = expf(a) - expf(b) + LAM_INIT;
        } else if (C.tid < 72) { const float x = logit[C.tid - 64]; SCAL[1 + C.tid - 64] = fminf(x, 0.f) - log1pf(expf(-fabsf(x))); }
    }
    for (int i = C.gt; i < 64 * 64 + 64 * 16; i += C.NGT) {
        if (i < 4096) { const int p = i >> 6, f = i & 63; const float inv = powf(10000.f, -((float)(2 * f) / 128.f)); float cs, sn; sincos_acc((float)p * inv, cs, sn); TAB[i] = cs; TAB[4096 + i] = sn; }
        else { const int q = i - 4096, p = q >> 4, f = q & 15; const float inv = powf(10000.f, -((float)(2 * f) / 32.f)); float cs, sn; sincos_acc((float)p * inv, cs, sn); TAB[8192 + q] = cs; TAB[8192 + 1024 + q] = sn; }
    }
}

__device__ __forceinline__ void d_lnmod(const Ctx& C, const float* __restrict__ x, const float* __restrict__ ctx, const float* __restrict__ g, const float* __restrict__ bb,
                                        const float* __restrict__ MOD, bf16_t* __restrict__ XM, float* __restrict__ STATS) {
    const int lane = C.lane;
    for (int row = C.gw; row < MA; row += C.NGW) {
        const float* src = row < ML ? x + (size_t)row * D : ctx + (size_t)(row - ML) * D;
        const int mr = row < ML ? row / SEQ : 8;
        const float* sh = MOD + mr * 6144; const float* sc = sh + 1024;
        f32x4 v[4]; float s = 0.f;
#pragma unroll
        for (int j = 0; j < 4; ++j) { v[j] = *(const f32x4*)(src + j * 256 + lane * 4); s += (v[j].x + v[j].y) + (v[j].z + v[j].w); }
        const float mean = wave_sum(s) * (1.f / D); float s2 = 0.f;
#pragma unroll
        for (int j = 0; j < 4; ++j) { v[j] = v[j] - mean; s2 += (v[j].x * v[j].x + v[j].y * v[j].y) + (v[j].z * v[j].z + v[j].w * v[j].w); }
        const float rstd = 1.f / sqrtf(wave_sum(s2) * (1.f / D) + LN_EPS);
        if (row < ML && lane == 0) { STATS[row * 2] = mean; STATS[row * 2 + 1] = rstd; }
#pragma unroll
        for (int j = 0; j < 4; ++j) { const int c0 = j * 256 + lane * 4;
            const f32x4 gg = *(const f32x4*)(g + c0), bv = *(const f32x4*)(bb + c0), s1 = *(const f32x4*)(sc + c0), h1 = *(const f32x4*)(sh + c0);
            const f32x4 xn = v[j] * rstd * gg + bv; const f32x4 o = xn * (s1 + 1.f) + h1;
            ushort4 w; w.x = f2bf(o.x); w.y = f2bf(o.y); w.z = f2bf(o.z); w.w = f2bf(o.w);
            *(ushort4*)(XM + (size_t)row * D + c0) = w; }
    }
}

template <class Epi>
__device__ __forceinline__ void d_gemm(const Ctx& C, const bf16_t* __restrict__ A, int lda, const bf16_t* __restrict__ Bt, int ldb, int M, int N, int K, const Epi& epi) {
    const int fr = C.lane & 15, fq = C.lane >> 4, ntn = N / 256, nt = (M / 128) * ntn;
    for (int t = C.bx; t < nt; t += C.G) {
        const int row0 = (t / ntn) * 128 + (C.wave >> 2) * 64, col0 = (t % ntn) * 256 + (C.wave & 3) * 64;
        f32x4 acc[4][4];
#pragma unroll
        for (int i = 0; i < 4; ++i)
#pragma unroll
            for (int j = 0; j < 4; ++j) acc[i][j] = (f32x4){0.f, 0.f, 0.f, 0.f};
        const bf16_t* Ap = A + (size_t)(row0 + fr) * lda + fq * 8;
        const bf16_t* Bp = Bt + (size_t)(col0 + fr) * ldb + fq * 8;
        for (int k0 = 0; k0 < K; k0 += 32) {
            bf16x8 a[4], b[4];
#pragma unroll
            for (int i = 0; i < 4; ++i) { a[i] = *(const bf16x8*)(Ap + (size_t)i * 16 * lda + k0); b[i] = *(const bf16x8*)(Bp + (size_t)i * 16 * ldb + k0); }
#pragma unroll
            for (int i = 0; i < 4; ++i)
#pragma unroll
                for (int j = 0; j < 4; ++j) acc[i][j] = __builtin_amdgcn_mfma_f32_16x16x32_bf16(a[i], b[j], acc[i][j], 0, 0, 0);
        }
#pragma unroll
        for (int i = 0; i < 4; ++i)
#pragma unroll
            for (int j = 0; j < 4; ++j)
#pragma unroll
                for (int r = 0; r < 4; ++r) epi(row0 + i * 16 + fq * 4 + r, col0 + j * 16 + fr, acc[i][j][r]);
    }
}

struct EpiRetQKV { bf16_t *QR, *KR, *VR;
    __device__ __forceinline__ void operator()(int r, int c, float v) const {
        if (c < 1024) { if (r < ML) QR[(size_t)r * 1024 + c] = f2bf(v); }
        else if (c < 2048) KR[(size_t)r * 1024 + (c - 1024)] = f2bf(v * 0.0625f);
        else VR[(size_t)r * 2048 + (c - 2048)] = f2bf(v); } };
struct EpiDifQKV { bf16_t *QD, *KD, *VD;
    __device__ __forceinline__ void operator()(int r, int c, float v) const {
        if (c < 1024) { if (r < ML) QD[(size_t)r * 1024 + c] = f2bf(v * 0.125f); }
        else if (c < 2048) KD[(size_t)r * 1024 + (c - 1024)] = f2bf(v);
        else VD[(size_t)r * 1024 + (c - 2048)] = f2bf(v); } };
struct EpiGr { bf16_t* YR; const float* RS;
    __device__ __forceinline__ void operator()(int r, int c, float v) const {
        const int h = c >> 9; const float mu = RS[(r * 4 + h) * 2], rs = RS[(r * 4 + h) * 2 + 1];
        const size_t o = (size_t)r * 2048 + c; const float yn = (bf2f(YR[o]) - mu) * rs; YR[o] = f2bf(siluf(v) * yn); } };
struct EpiGate { bf16_t* SG; const float* bg;
    __device__ __forceinline__ void operator()(int r, int c, float v) const { SG[(size_t)r * 2048 + c] = f2bf(sigmf(v + bg[c])); } };
struct EpiMr { float* MR; const bf16_t* SG;
    __device__ __forceinline__ void operator()(int r, int c, float v) const { MR[(size_t)r * 1024 + c] = bf2f(SG[(size_t)r * 2048 + c]) * v; } };
struct EpiMb { bf16_t* MB; const float* MR; const bf16_t* SG;
    __device__ __forceinline__ void operator()(int r, int c, float v) const { MB[(size_t)r * 1024 + c] = f2bf(MR[(size_t)r * 1024 + c] + bf2f(SG[(size_t)r * 2048 + 1024 + c]) * v); } };
struct EpiZ1 { float* Z; const float* x; const float* STATS; const float* g; const float* b; const float* MOD;
    __device__ __forceinline__ void operator()(int r, int c, float v) const {
        const float xn = (x[(size_t)r * 1024 + c] - STATS[r * 2]) * STATS[r * 2 + 1] * g[c] + b[c];
        Z[(size_t)r * 1024 + c] = ALPHA * xn + MOD[(r / SEQ) * 6144 + 2048 + c] * v; } };
struct EpiUG { bf16_t* UG;
    __device__ __forceinline__ void operator()(int r, int c, float v) const { UG[(size_t)r * 5632 + c] = f2bf(v); } };
struct EpiZ2 { float* Z; const float* MOD;
    __device__ __forceinline__ void operator()(int r, int c, float v) const { const size_t o = (size_t)r * 1024 + c; Z[o] = ALPHA * Z[o] + MOD[(r / SEQ) * 6144 + 5120 + c] * v; } };

__device__ __forceinline__ void d_rope_ret(const Ctx& C, bf16_t* __restrict__ X, const float* __restrict__ TAB) {
    for (int idx = C.gt; idx < ML * 512; idx += C.NGT) {
        const int row = idx >> 9, p = idx & 511, h = p >> 7, j = p & 127;
        const int t = row & (SEQ - 1), pr = t >> 6, pc = t & 63;
        const int ti = j < 64 ? pr * 64 + j : pc * 64 + (j - 64);
        const float cs = TAB[ti], sn = TAB[4096 + ti];
        bf16_t* a = X + (size_t)row * 1024 + h * 256 + j;
        const float x1 = bf2f(a[0]), x2 = bf2f(a[128]);
        a[0] = f2bf(x1 * cs - x2 * sn); a[128] = f2bf(x2 * cs + x1 * sn);
    }
}
__device__ __forceinline__ void d_rope_dif(const Ctx& C, bf16_t* __restrict__ X, const float* __restrict__ TAB) {
    for (int idx = C.gt; idx < ML * 512; idx += C.NGT) {
        const int row = idx >> 9, p = idx & 511, blk = p >> 5, j = p & 31;
        const int t = row & (SEQ - 1), pr = t >> 6, pc = t & 63;
        const int ti = j < 16 ? pr * 16 + j : pc * 16 + (j - 16);
        const float cs = TAB[8192 + ti], sn = TAB[8192 + 1024 + ti];
        bf16_t* a = X + (size_t)row * 1024 + blk * 64 + j;
        const float x1 = bf2f(a[0]), x2 = bf2f(a[32]);
        a[0] = f2bf(x1 * cs - x2 * sn); a[32] = f2bf(x2 * cs + x1 * sn);
    }
}

__device__ __forceinline__ void d_ret_naive(const Ctx& C, const bf16_t* __restrict__ QR, const bf16_t* __restrict__ KR, const bf16_t* __restrict__ VR,
                                            bf16_t* __restrict__ YR, float* __restrict__ Sg, const float* __restrict__ SCAL) {
    bf16_t* qs = (bf16_t*)C.lds; bf16_t* ks = qs + 128 * 256; bf16_t* vs = ks + 128 * 256; bf16_t* Ps = qs;
    const int tid = C.tid;
    for (int bid = C.bx; bid < 256; bid += C.G) {
    const int vsl = bid & 7, h = (bid >> 3) & 3, b = bid >> 5;
    float* S = Sg + (size_t)bid * 16384;
    const float lgf = SCAL[1 + h], lgb = SCAL[5 + h];
    const int c = tid & 63, g8 = tid >> 6;
    for (int pass = 0; pass < 2; ++pass) {
        const float lg = pass ? lgb : lgf;
        for (int i = 0; i < 32; ++i) S[(g8 * 32 + i) * 64 + c] = 0.f;
        __syncthreads();
        for (int step = 0; step < 34; ++step) {
            const bool lat = step >= 2;
            int tz = 0; asm volatile("" : "+v"(tz));
            int rowbase;
            if (!lat) { const int cc = pass ? 1 - step : step; rowbase = ML + b * CTX + cc * 128; }
            else { const int n = pass ? 33 - step : step - 2; rowbase = b * SEQ + n * 128; }
            for (int p = tid; p < 128 * 32; p += 512) { const int r = p >> 5, ch = p & 31;
                *(bf16x8*)(ks + r * 256 + ch * 8) = *(const bf16x8*)(KR + (size_t)(rowbase + r) * 1024 + h * 256 + ch * 8);
                if (lat) *(bf16x8*)(qs + r * 256 + ch * 8) = *(const bf16x8*)(QR + (size_t)(rowbase + r) * 1024 + h * 256 + ch * 8); }
            for (int p = tid; p < 128 * 8; p += 512) { const int r = p >> 3, ch = p & 7;
                *(bf16x8*)(vs + r * 64 + ch * 8) = *(const bf16x8*)(VR + (size_t)(rowbase + r) * 2048 + h * 512 + vsl * 64 + ch * 8); }
            __syncthreads();
            if (lat) {
                float yacc[16];
#pragma unroll
                for (int ii = 0; ii < 16; ++ii) { const int i = g8 * 16 + ii + tz; float a = 0.f;
#pragma unroll 2
                    for (int d = 0; d < 256; ++d) a += bf2f(qs[i * 256 + d]) * bf2f(f2bf(S[d * 64 + c]));
                    yacc[ii] = a * __expf(lg * (pass ? (float)(128 - i) : (float)(i + 1))); }
                if (pass == 0) {
                    const int j = (tid & 127) + tz, g4 = tid >> 7; float pv[32];
#pragma unroll
                    for (int ii = 0; ii < 32; ++ii) { const int i = g4 * 32 + ii; float a = 0.f;
#pragma unroll 2
                        for (int d = 0; d < 256; ++d) a += bf2f(qs[i * 256 + d]) * bf2f(ks[j * 256 + d]);
                        const float m = i > j ? __expf(lgf * (float)(i - j)) : (i < j ? __expf(lgb * (float)(j - i)) : 2.f);
                        pv[ii] = a * m; }
                    __syncthreads();
#pragma unroll
                    for (int ii = 0; ii < 32; ++ii) Ps[(g4 * 32 + ii) * 128 + j] = f2bf(pv[ii]);
                    __syncthreads();
#pragma unroll
                    for (int ii = 0; ii < 16; ++ii) { const int i = g8 * 16 + ii; float a = 0.f;
#pragma unroll 2
                        for (int jj = 0; jj < 128; ++jj) a += bf2f(Ps[i * 128 + jj]) * bf2f(vs[jj * 64 + c]);
                        yacc[ii] += a; }
                }
#pragma unroll
                for (int ii = 0; ii < 16; ++ii) { const int i = g8 * 16 + ii; bf16_t* yp = YR + (size_t)(rowbase + i) * 2048 + h * 512 + vsl * 64 + c;
                    if (pass == 0) *yp = f2bf(yacc[ii]); else *yp = f2bf(bf2f(*yp) + yacc[ii]); }
            }
            const float ds = __expf(lg * 128.f);
            float acc[32];
#pragma unroll
            for (int i = 0; i < 32; ++i) acc[i] = 0.f;
#pragma unroll 1
            for (int jj = 0; jj < 128; ++jj) { const float vv = bf2f(f2bf(bf2f(vs[jj * 64 + c]) * __expf(lg * (pass ? (float)(jj + tz) : (float)(127 - jj + tz)))));
#pragma unroll
                for (int i = 0; i < 32; ++i) acc[i] += bf2f(ks[jj * 256 + g8 * 32 + i]) * vv; }
            __syncthreads();
#pragma unroll
            for (int i = 0; i < 32; ++i) { float* sp = S + (g8 * 32 + i) * 64 + c; *sp = *sp * ds + acc[i]; }
            __syncthreads();
        }
    }
    }
}

constexpr int ATTN_NAIVE_LDS = 64 * 64 * 2 + 64 * 128 * 2 + 64 * 65 * 4;
__device__ __forceinline__ void d_attn_naive(const Ctx& C, const bf16_t* __restrict__ QD, const bf16_t* __restrict__ KD, const bf16_t* __restrict__ VD, bf16_t* __restrict__ OD) {
    const int half = C.tid >> 8, tid = C.tid & 255, qi = tid >> 2, part = tid & 3;
    unsigned char* base = C.lds + half * ATTN_NAIVE_LDS;
    bf16_t* Ks = (bf16_t*)base; bf16_t* Vs = Ks + 64 * 64; float* Pm = (float*)(Vs + 64 * 128);
    for (int vb2 = C.bx; vb2 < 4096; vb2 += C.G) {
        const int vb = vb2 * 2 + half;
        const int qb = vb & 63, cc = (vb >> 6) & 1, h = (vb >> 7) & 7, b = vb >> 10;
        const int qrow = b * SEQ + qb * 64 + qi;
        float q[64];
#pragma unroll
        for (int d = 0; d < 64; ++d) q[d] = bf2f(QD[(size_t)qrow * 1024 + h * 128 + cc * 64 + d]);
        float o[32];
#pragma unroll
        for (int e = 0; e < 32; ++e) o[e] = 0.f;
        float m = -1e30f, l = 0.f;
        for (int kt = 0; kt < 68; ++kt) {
            const int krow0 = kt < 64 ? b * SEQ + kt * 64 : ML + b * CTX + (kt - 64) * 64;
            for (int p = tid; p < 64 * 8; p += 256) { const int r = p >> 3, ch = p & 7; *(bf16x8*)(Ks + r * 64 + ch * 8) = *(const bf16x8*)(KD + (size_t)(krow0 + r) * 1024 + h * 128 + cc * 64 + ch * 8); }
            for (int p = tid; p < 64 * 16; p += 256) { const int r = p >> 4, ch = p & 15; *(bf16x8*)(Vs + r * 128 + ch * 8) = *(const bf16x8*)(VD + (size_t)(krow0 + r) * 1024 + h * 128 + ch * 8); }
            __syncthreads();
            float s[16]; float mx = -1e30f;
#pragma unroll
            for (int jj = 0; jj < 16; ++jj) { const int j = part * 16 + jj; float a = 0.f;
#pragma unroll
                for (int d = 0; d < 64; ++d) a += q[d] * bf2f(Ks[j * 64 + d]);
                s[jj] = a; mx = fmaxf(mx, a); }
            mx = fmaxf(mx, __shfl_xor(mx, 1)); mx = fmaxf(mx, __shfl_xor(mx, 2));
            const float mn = fmaxf(m, mx), al = __expf(m - mn); m = mn;
            float ps = 0.f;
#pragma unroll
            for (int jj = 0; jj < 16; ++jj) { const float p = __expf(s[jj] - mn); ps += p; Pm[qi * 65 + part * 16 + jj] = bf2f(f2bf(p)); }
            l = l * al + ps;
#pragma unroll
            for (int e = 0; e < 32; ++e) o[e] *= al;
            __syncthreads();
            for (int j = 0; j < 64; ++j) { const float p = Pm[qi * 65 + j];
#pragma unroll
                for (int e = 0; e < 32; ++e) o[e] += p * bf2f(Vs[j * 128 + part * 32 + e]); }
            __syncthreads();
        }
        l += __shfl_xor(l, 1); l += __shfl_xor(l, 2);
        const float il = 1.f / l;
#pragma unroll
        for (int e = 0; e < 32; ++e) OD[(size_t)qrow * 2048 + h * 256 + cc * 128 + part * 32 + e] = f2bf(o[e] * il);
    }
}

__device__ __forceinline__ void d_prep_diff(const Ctx& C, const bf16_t* __restrict__ OD, const float* __restrict__ gsub, const float* __restrict__ SCAL, bf16_t* __restrict__ AD) {
    const int t = C.tid & 255, h = t >> 5, l = t & 31; const float lam = SCAL[0];
    for (int r2 = C.bx; r2 < ML / 2; r2 += C.G) {
        const int row = r2 * 2 + (C.tid >> 8);
        float a[4]; float ss = 0.f;
#pragma unroll
        for (int i = 0; i < 4; ++i) { const int e = l * 4 + i; a[i] = bf2f(OD[(size_t)row * 2048 + h * 256 + e]) - lam * bf2f(OD[(size_t)row * 2048 + h * 256 + 128 + e]); ss += a[i] * a[i]; }
#pragma unroll
        for (int o = 1; o < 32; o <<= 1) ss += __shfl_xor(ss, o);
        const float rs = 1.f / sqrtf(ss * (1.f / 128.f) + LN_EPS);
#pragma unroll
        for (int i = 0; i < 4; ++i) { const int e = l * 4 + i; AD[(size_t)row * 1024 + h * 128 + e] = f2bf(a[i] * rs * gsub[e] * (1.f - LAM_INIT)); }
    }
}
__device__ __forceinline__ void d_ret_stats(const Ctx& C, const bf16_t* __restrict__ YR, float* __restrict__ RS) {
    for (int it = C.gw; it < ML * 4; it += C.NGW) {
        const int row = it >> 2, h = it & 3;
        float v[8]; float s = 0.f;
#pragma unroll
        for (int i = 0; i < 8; ++i) { v[i] = bf2f(YR[(size_t)row * 2048 + h * 512 + C.lane * 8 + i]); s += v[i]; }
        const float mu = wave_sum(s) * (1.f / 512.f); float s2 = 0.f;
#pragma unroll
        for (int i = 0; i < 8; ++i) { const float d = v[i] - mu; s2 += d * d; }
        const float var = wave_sum(s2) * (1.f / 512.f);
        if (C.lane == 0) { RS[it * 2] = mu; RS[it * 2 + 1] = 1.f / sqrtf(var + LN_EPS); }
    }
}

__device__ __forceinline__ void d_ln_rows(const Ctx& C, float* __restrict__ Z, const float* __restrict__ g, const float* __restrict__ bb, const float* __restrict__ MOD, bf16_t* __restrict__ XM) {
    const int lane = C.lane;
    for (int row = C.gw; row < ML; row += C.NGW) {
        float* src = Z + (size_t)row * D;
        f32x4 v[4]; float s = 0.f;
#pragma unroll
        for (int j = 0; j < 4; ++j) { v[j] = *(const f32x4*)(src + j * 256 + lane * 4); s += (v[j].x + v[j].y) + (v[j].z + v[j].w); }
        const float mean = wave_sum(s) * (1.f / D); float s2 = 0.f;
#pragma unroll
        for (int j = 0; j < 4; ++j) { v[j] = v[j] - mean; s2 += (v[j].x * v[j].x + v[j].y * v[j].y) + (v[j].z * v[j].z + v[j].w * v[j].w); }
        const float rstd = 1.f / sqrtf(wave_sum(s2) * (1.f / D) + LN_EPS);
        const float* sh = MOD + (row / SEQ) * 6144 + 3072; const float* sc = sh + 1024;
#pragma unroll
        for (int j = 0; j < 4; ++j) { const int c0 = j * 256 + lane * 4;
            const f32x4 gg = *(const f32x4*)(g + c0), bv = *(const f32x4*)(bb + c0);
            const f32x4 xn = v[j] * rstd * gg + bv; *(f32x4*)(src + c0) = xn;
            if (XM) { const f32x4 s1 = *(const f32x4*)(sc + c0), h1 = *(const f32x4*)(sh + c0); const f32x4 o = xn * (s1 + 1.f) + h1;
                ushort4 w; w.x = f2bf(o.x); w.y = f2bf(o.y); w.z = f2bf(o.z); w.w = f2bf(o.w); *(ushort4*)(XM + (size_t)row * D + c0) = w; } }
    }
}

__device__ __forceinline__ void d_convgate(const Ctx& C, const bf16_t* __restrict__ UG, int row_off, const float* __restrict__ cw, const float* __restrict__ cb, bf16_t* __restrict__ H) {
    for (int idx = C.gt; idx < (ML / 2) * DFF; idx += C.NGT) {
        const int lr = idx / DFF, f = idx % DFF, row = row_off + lr, t = row & (SEQ - 1);
        const int uc = (f >> 7) * 256 + (f & 127);
        float u = cb[f] + cw[DFF + f] * bf2f(UG[(size_t)lr * 5632 + uc]);
        if (t > 0) u += cw[f] * bf2f(UG[(size_t)(lr - 1) * 5632 + uc]);
        if (t < SEQ - 1) u += cw[2 * DFF + f] * bf2f(UG[(size_t)(lr + 1) * 5632 + uc]);
        const float ge = 0.5f * u * (1.f + erff(u * 0.70710678118654752f));
        H[(size_t)row * DFF + f] = f2bf(ge * bf2f(UG[(size_t)lr * 5632 + uc + 128]));
    }
}

namespace pg8 {
#define PG8_LAS __attribute__((address_space(3)))
typedef unsigned short bf16_t;
typedef short bf16x8 __attribute__((ext_vector_type(8)));
typedef float f32x4 __attribute__((ext_vector_type(4)));
typedef unsigned u32x4 __attribute__((ext_vector_type(4)));
constexpr int BM = 256, BK = 64, HALF = 128, HTB = HALF * BK * 2  , STAGE_BYTES = 8 * HTB, NXCD = 8, WGM = 8;

__host__ __device__ __forceinline__ int lds_byte(int r, int c) { const int st = (r >> 4) * 2 + (c >> 5), rr = r & 15, cc = c & 31, ob = rr * 64 + cc * 2; return st * 1024 + (ob ^ (((ob >> 9) & 1) << 5)); }
__host__ __device__ __forceinline__ void stage_rc(int b, int& R, int& C) { const int st = b / 1024, sb = b % 1024, swz = sb ^ (((sb >> 9) & 1) << 5); R = (st >> 1) * 16 + swz / 64; C = (st & 1) * 32 + (swz % 64) / 2; }
__host__ __device__ __forceinline__ int perm32(int rho) { const int n = rho >> 4, i = rho & 15; return 8 * (i >> 2) + 4 * n + (i & 3); }

struct Unit { int pm, pn; };
struct Gemm { const bf16_t* A; const bf16_t* Bt; int M, N, K; };

struct StaticOrder {
    int nM, nN, nwg, G, c;
    __host__ __device__ void init(int M, int N, int G_, int c_) { nM = M / BM; nN = N / BM; nwg = nM * nN; G = G_; c = c_; }
    __host__ __device__ bool next(int i, Unit& u) const {
        const long L = (long)i * G + c; if (L >= nwg) return false;
        int wgid = (int)L; { const int q = nwg / NXCD, r = nwg % NXCD, xcd = wgid % NXCD, off = wgid / NXCD; wgid = (xcd < r ? xcd * (q + 1) : r * (q + 1) + (xcd - r) * q) + off; }
        const int nig = WGM * nN, gid = wgid / nig, fm = gid * WGM, gsz = (nM - fm) < WGM ? (nM - fm) : WGM;
        u.pm = fm + ((wgid % nig) % gsz); u.pn = (wgid % nig) / gsz; return true;
    }
    __device__ __forceinline__ void a_ready(const Unit&) const {}
    __device__ __forceinline__ void done(const Unit&) const {}
};

template <class Epi, class Sched, bool ALIGN_EPI = false, bool SP2 = false>
__device__ __forceinline__ void gemm_phase(PG8_LAS unsigned char* lds, const Gemm g, const Sched& S, const Epi& E) {
    const int tid = threadIdx.x, wid = __builtin_amdgcn_readfirstlane(tid >> 6), lane = tid & 63, wr = wid >> 2, wc = wid & 3, fr = lane & 15, fq = lane >> 4;
    const int K = g.K, nt = K / BK;
    unsigned voffA[2], voffB[2];
#pragma unroll
    for (int i = 0; i < 2; ++i) { int R, C; stage_rc(tid * 16 + i * 8192, R, C); const int Rb = Epi::PERM ? ((R & ~31) + perm32(R & 31)) : R;
        voffA[i] = (unsigned)(R * K + C) * 2u; voffB[i] = (unsigned)(Rb * K + C) * 2u; }
    const size_t kstep = (size_t)(BK * 2);
    const size_t hstep = (size_t)HALF * K * 2;
    const size_t tstep = 2 * hstep;
    const unsigned ldsw = (unsigned)wid * 1024u;
    const int aoff = lds_byte(wr * 64 + fr, fq * 8), boff = lds_byte(wc * 32 + fr, fq * 8);
#define PG8_SA(b, h) (((b) * 2 + (h)) * HTB)
#define PG8_SB(b, h) ((4 + (b) * 2 + (h)) * HTB)
#define PG8_STAGE(bufoff, gbase, voff) do { _Pragma("unroll") for (int _i = 0; _i < 2; ++_i) \
        __builtin_amdgcn_global_load_lds((const unsigned*)((const char*)(gbase) + (voff)[_i]), (PG8_LAS unsigned*)(lds + (bufoff) + ldsw + _i * 8192), 16, 0, 0); } while (0)
#define PG8_LDA(dst, b, h) do { _Pragma("unroll") for (int m = 0; m < 4; ++m) _Pragma("unroll") for (int k = 0; k < 2; ++k) dst[m][k] = *(const PG8_LAS bf16x8*)(lds + PG8_SA(b, h) + aoff + m * 2048 + k * 1024); } while (0)
#define PG8_LDB(dst, b, h) do { _Pragma("unroll") for (int n = 0; n < 2; ++n) _Pragma("unroll") for (int k = 0; k < 2; ++k) dst[n][k] = *(const PG8_LAS bf16x8*)(lds + PG8_SB(b, h) + boff + n * 2048 + k * 1024); } while (0)
#define PG8_MMA(ai, bj, At, Bt) do { __builtin_amdgcn_s_setprio(1); _Pragma("unroll") for (int m = 0; m < 4; ++m) _Pragma("unroll") for (int n = 0; n < 2; ++n) _Pragma("unroll") for (int k = 0; k < 2; ++k) \
        acc[ai][bj][m][n] = __builtin_amdgcn_mfma_f32_16x16x32_bf16(Bt[n][k], At[m][k], acc[ai][bj][m][n], 0, 0, 0); __builtin_amdgcn_s_setprio(0); } while (0)
#define PG8_WAIT_V(n) asm volatile("s_waitcnt vmcnt(" #n ")" ::: "memory")
#define PG8_WAIT_L(n) asm volatile("s_waitcnt lgkmcnt(" #n ")" ::: "memory")
#define PG8_BAR __builtin_amdgcn_s_barrier()
#define PG8_SCHED __builtin_amdgcn_sched_barrier(0)
    Unit cur, nxt; int ui = 0;
    if (!S.next(0, cur)) return;
    f32x4 acc[2][2][4][2];
#pragma unroll
    for (int a = 0; a < 2; ++a)
#pragma unroll
        for (int b = 0; b < 2; ++b)
#pragma unroll
            for (int m = 0; m < 4; ++m)
#pragma unroll
                for (int n = 0; n < 2; ++n) acc[a][b][m][n] = (f32x4){0.f, 0.f, 0.f, 0.f};
    bf16x8 At[4][2], B0[2][2], B1[2][2];
    const char* cA = (const char*)g.A + (size_t)cur.pm * tstep; const char* cB = (const char*)g.Bt + (size_t)cur.pn * tstep;
    S.a_ready(cur);
    if constexpr (SP2) {
        PG8_STAGE(PG8_SB(0, 0), cB, voffB); PG8_STAGE(PG8_SB(0, 1), cB + hstep, voffB); PG8_STAGE(PG8_SA(0, 0), cA, voffA); PG8_STAGE(PG8_SA(0, 1), cA + hstep, voffA);
        if (wr == 1) PG8_BAR;
        PG8_WAIT_V(2); PG8_BAR;
        PG8_STAGE(PG8_SB(1, 0), cB + kstep, voffB); PG8_STAGE(PG8_SA(1, 0), cA + kstep, voffA); PG8_STAGE(PG8_SB(1, 1), cB + hstep + kstep, voffB);
        PG8_WAIT_V(6); PG8_BAR;
    } else {
        PG8_STAGE(PG8_SB(0, 0), cB, voffB); PG8_STAGE(PG8_SA(0, 0), cA, voffA); PG8_STAGE(PG8_SB(0, 1), cB + hstep, voffB); PG8_STAGE(PG8_SA(0, 1), cA + hstep, voffA);
        if (wr == 1) PG8_BAR;
        PG8_WAIT_V(4); PG8_BAR;
        PG8_STAGE(PG8_SB(1, 0), cB + kstep, voffB); PG8_STAGE(PG8_SA(1, 0), cA + kstep, voffA); PG8_STAGE(PG8_SB(1, 1), cB + hstep + kstep, voffB);
        PG8_WAIT_V(6); PG8_BAR;
    }
    for (;;) {
        const bool has_next = S.next(ui + 1, nxt);
        const char* nA = has_next ? (const char*)g.A + (size_t)nxt.pm * tstep : cA; const char* nB = has_next ? (const char*)g.Bt + (size_t)nxt.pn * tstep : cB;
        for (int t = 0; t < nt; t += 2) {
            const bool last = (t == nt - 2);
            const char* a1 = cA + (size_t)(t + 1) * kstep;
            const char* a2 = last ? nA : cA + (size_t)(t + 2) * kstep; const char* b2 = last ? nB : cB + (size_t)(t + 2) * kstep;
            const char* a3 = a2 + kstep; const char* b3 = b2 + kstep;
            if (last && has_next) S.a_ready(nxt);
            if constexpr (SP2) {
            PG8_LDB(B0, 0, 0); PG8_LDB(B1, 0, 1); PG8_SCHED; PG8_LDA(At, 0, 0); PG8_STAGE(PG8_SA(1, 1), a1 + hstep, voffA);
            PG8_WAIT_V(8); PG8_WAIT_L(0); PG8_BAR; PG8_MMA(0, 0, At, B0); PG8_MMA(0, 1, At, B1); PG8_BAR; PG8_SCHED;
            PG8_LDA(At, 0, 1); PG8_STAGE(PG8_SB(0, 0), b2, voffB); PG8_STAGE(PG8_SB(0, 1), b2 + hstep, voffB); PG8_STAGE(PG8_SA(0, 0), a2, voffA);
            PG8_WAIT_V(8); PG8_WAIT_L(0); PG8_BAR; PG8_MMA(1, 0, At, B0); PG8_MMA(1, 1, At, B1); PG8_BAR; PG8_SCHED;
            PG8_LDB(B0, 1, 0); PG8_LDB(B1, 1, 1); PG8_SCHED; PG8_LDA(At, 1, 0); PG8_STAGE(PG8_SA(0, 1), a2 + hstep, voffA);
            PG8_WAIT_V(8); PG8_WAIT_L(0); PG8_BAR; PG8_MMA(0, 0, At, B0); PG8_MMA(0, 1, At, B1); PG8_BAR; PG8_SCHED;
            PG8_LDA(At, 1, 1); PG8_STAGE(PG8_SB(1, 0), b3, voffB); PG8_STAGE(PG8_SB(1, 1), b3 + hstep, voffB); PG8_STAGE(PG8_SA(1, 0), a3, voffA);
            PG8_WAIT_V(8); PG8_WAIT_L(0); PG8_BAR; PG8_MMA(1, 0, At, B0); PG8_MMA(1, 1, At, B1); PG8_BAR; PG8_SCHED;
            } else {
            PG8_LDB(B0, 0, 0); PG8_SCHED; PG8_LDA(At, 0, 0); PG8_STAGE(PG8_SA(1, 1), a1 + hstep, voffA);
            PG8_WAIT_L(8); PG8_BAR; PG8_WAIT_L(0); PG8_MMA(0, 0, At, B0); PG8_BAR; PG8_SCHED;
            PG8_LDB(B1, 0, 1); PG8_STAGE(PG8_SB(0, 0), b2, voffB);
            PG8_BAR; PG8_WAIT_L(0); PG8_MMA(0, 1, At, B1); PG8_BAR;
            PG8_LDA(At, 0, 1); PG8_STAGE(PG8_SA(0, 0), a2, voffA);
            PG8_BAR; PG8_WAIT_L(0); PG8_MMA(1, 0, At, B0); PG8_BAR; PG8_SCHED;
            PG8_STAGE(PG8_SB(0, 1), b2 + hstep, voffB);
            PG8_WAIT_V(6); PG8_BAR; PG8_MMA(1, 1, At, B1); PG8_BAR;
            PG8_LDB(B0, 1, 0); PG8_SCHED; PG8_LDA(At, 1, 0); PG8_STAGE(PG8_SA(0, 1), a2 + hstep, voffA);
            PG8_WAIT_L(8); PG8_BAR; PG8_WAIT_L(0); PG8_MMA(0, 0, At, B0); PG8_BAR; PG8_SCHED;
            PG8_LDB(B1, 1, 1); PG8_STAGE(PG8_SB(1, 0), b3, voffB);
            PG8_BAR; PG8_WAIT_L(0); PG8_MMA(0, 1, At, B1); PG8_BAR;
            PG8_LDA(At, 1, 1); PG8_STAGE(PG8_SA(1, 0), a3, voffA);
            PG8_BAR; PG8_WAIT_L(0); PG8_MMA(1, 0, At, B0); PG8_BAR; PG8_SCHED;
            PG8_STAGE(PG8_SB(1, 1), b3 + hstep, voffB);
            PG8_WAIT_V(6); PG8_BAR; PG8_MMA(1, 1, At, B1); PG8_BAR;
            }
        }
        if constexpr (ALIGN_EPI) { if (wr == 0) PG8_BAR; }
        if constexpr (!Epi::AFTER_DRAIN) { E(acc, cur, wr, wc, fr, fq); S.done(cur); }
        if (!has_next) break;
#pragma unroll
        for (int a = 0; a < 2; ++a)
#pragma unroll
            for (int b = 0; b < 2; ++b)
#pragma unroll
                for (int m = 0; m < 4; ++m)
#pragma unroll
                    for (int n = 0; n < 2; ++n) acc[a][b][m][n] = (f32x4){0.f, 0.f, 0.f, 0.f};
        cur = nxt; cA = nA; cB = nB; ++ui;
        if constexpr (ALIGN_EPI) { if (wr == 1) PG8_BAR; }
    }
    PG8_WAIT_V(0);
    if constexpr (!ALIGN_EPI) { if (wr == 0) PG8_BAR; }
    PG8_BAR;
    if constexpr (Epi::AFTER_DRAIN) { E.fused(acc, cur, wr, wc, fr, fq, lds, wid, lane); S.done(cur); }
#undef PG8_SA
#undef PG8_SB
#undef PG8_STAGE
#undef PG8_LDA
#undef PG8_LDB
#undef PG8_MMA
#undef PG8_WAIT_V
#undef PG8_WAIT_L
#undef PG8_BAR
#undef PG8_SCHED
}
}


typedef unsigned u32x4 __attribute__((ext_vector_type(4)));
typedef float f32x2_t __attribute__((ext_vector_type(2))); typedef __bf16 bf16x2_t __attribute__((ext_vector_type(2)));
__device__ __forceinline__ unsigned cvtpk(float lo, float hi) { f32x2_t v = {lo, hi}; bf16x2_t b = __builtin_convertvector(v, bf16x2_t); return __builtin_bit_cast(unsigned, b); }
__device__ __forceinline__ u32x4 pack8(const f32x4& a, const f32x4& b) { u32x4 w; w.x = cvtpk(a[0], a[1]); w.y = cvtpk(a[2], a[3]); w.z = cvtpk(b[0], b[1]); w.w = cvtpk(b[2], b[3]); return w; }
__device__ __forceinline__ void unpack8(const u32x4& w, f32x4& a, f32x4& b) {
    a[0] = __uint_as_float(w.x << 16); a[1] = __uint_as_float(w.x & 0xffff0000u); a[2] = __uint_as_float(w.y << 16); a[3] = __uint_as_float(w.y & 0xffff0000u);
    b[0] = __uint_as_float(w.z << 16); b[1] = __uint_as_float(w.z & 0xffff0000u); b[2] = __uint_as_float(w.w << 16); b[3] = __uint_as_float(w.w & 0xffff0000u); }
typedef const f32x4 (&AccT)[2][2][4][2];
#define EPI_ROWS for (int ai = 0; ai < 2; ++ai) _Pragma("unroll") for (int m = 0; m < 4; ++m)

struct FEpiRetQKV { static constexpr bool PERM = true, AFTER_DRAIN = false; bf16_t *QR, *KR, *VR; const float* TAB;
    __device__ __forceinline__ void operator()(AccT acc, const pg8::Unit& u, int wr, int wc, int fr, int fq) const {
        const int row0 = u.pm * 256 + wr * 64 + fr, j0 = wc * 32 + 8 * fq;
        if (u.pn < 8) {
            const bool isq = u.pn < 4; const int h = u.pn & 3;
            if (isq && u.pm >= ML / 256) return;
            bf16_t* dst = (isq ? QR : KR) + h * 256 + j0; const float sc = isq ? 1.f : 0.0625f;
#pragma unroll
            EPI_ROWS { const int row = row0 + ai * 128 + m * 16;
                f32x4 c0 = {1.f, 1.f, 1.f, 1.f}, c1 = c0, s0 = {0.f, 0.f, 0.f, 0.f}, s1 = s0;
                if (row < ML) { const int t = row & (SEQ - 1), p = (j0 < 64) ? (t >> 6) : (t & 63); const float* tp = TAB + p * 64 + (j0 & 63);
                    c0 = *(const f32x4*)tp; c1 = *(const f32x4*)(tp + 4); s0 = *(const f32x4*)(tp + 4096); s1 = *(const f32x4*)(tp + 4100); }
                const f32x4 x1a = acc[ai][0][m][0], x1b = acc[ai][0][m][1], x2a = acc[ai][1][m][0], x2b = acc[ai][1][m][1];
                const f32x4 o1a = (x1a * c0 - x2a * s0) * sc, o1b = (x1b * c1 - x2b * s1) * sc, o2a = (x2a * c0 + x1a * s0) * sc, o2b = (x2b * c1 + x1b * s1) * sc;
                bf16_t* rp = dst + (size_t)row * 1024; *(u32x4*)rp = pack8(o1a, o1b); *(u32x4*)(rp + 128) = pack8(o2a, o2b); }
        } else {
            bf16_t* dst = VR + (u.pn - 8) * 256 + j0;
#pragma unroll
            EPI_ROWS { bf16_t* rp = dst + (size_t)(row0 + ai * 128 + m * 16) * 2048; *(u32x4*)rp = pack8(acc[ai][0][m][0], acc[ai][0][m][1]); *(u32x4*)(rp + 128) = pack8(acc[ai][1][m][0], acc[ai][1][m][1]); }
        }
    } };
constexpr float QSCALE = 0.125f;
struct FEpiDifQKV { static constexpr bool PERM = true, AFTER_DRAIN = false; bf16_t *QD, *KD, *VD; const float* TAB;
    __device__ __forceinline__ void operator()(AccT acc, const pg8::Unit& u, int wr, int wc, int fr, int fq) const {
        const int row0 = u.pm * 256 + wr * 64 + fr, j0 = wc * 32 + 8 * fq;
        if (u.pn < 8) {
            const bool isq = u.pn < 4; const int tl = u.pn & 3;
            if (isq && u.pm >= ML / 256) return;
            const int dd0 = 8 * fq;
            bf16_t* dst = (isq ? QD : KD) + tl * 256 + wc * 64 + dd0; const float sc = isq ? QSCALE : 1.f;
#pragma unroll
            EPI_ROWS { const int row = row0 + ai * 128 + m * 16;
                f32x4 c0 = {1.f, 1.f, 1.f, 1.f}, c1 = c0, s0 = {0.f, 0.f, 0.f, 0.f}, s1 = s0;
                if (row < ML) { const int t = row & (SEQ - 1), p = (dd0 < 16) ? (t >> 6) : (t & 63); const float* tp = TAB + 8192 + p * 16 + (dd0 & 15);
                    c0 = *(const f32x4*)tp; c1 = *(const f32x4*)(tp + 4); s0 = *(const f32x4*)(tp + 1024); s1 = *(const f32x4*)(tp + 1028); }
                const f32x4 x1a = acc[ai][0][m][0], x1b = acc[ai][0][m][1], x2a = acc[ai][1][m][0], x2b = acc[ai][1][m][1];
                const f32x4 o1a = (x1a * c0 - x2a * s0) * sc, o1b = (x1b * c1 - x2b * s1) * sc, o2a = (x2a * c0 + x1a * s0) * sc, o2b = (x2b * c1 + x1b * s1) * sc;
                bf16_t* rp = dst + (size_t)row * 1024; *(u32x4*)rp = pack8(o1a, o1b); *(u32x4*)(rp + 32) = pack8(o2a, o2b); }
        } else {
            bf16_t* dst = VD + (u.pn - 8) * 256 + j0;
#pragma unroll
            EPI_ROWS { bf16_t* rp = dst + (size_t)(row0 + ai * 128 + m * 16) * 1024; *(u32x4*)rp = pack8(acc[ai][0][m][0], acc[ai][0][m][1]); *(u32x4*)(rp + 128) = pack8(acc[ai][1][m][0], acc[ai][1][m][1]); }
        }
    } };
__device__ __forceinline__ f32x4 silu4(const f32x4& v) { f32x4 r; r[0] = siluf(v[0]); r[1] = siluf(v[1]); r[2] = siluf(v[2]); r[3] = siluf(v[3]); return r; }
__device__ __forceinline__ f32x4 sigm4(const f32x4& v) { f32x4 r; r[0] = sigmf(v[0]); r[1] = sigmf(v[1]); r[2] = sigmf(v[2]); r[3] = sigmf(v[3]); return r; }
struct FEpiGr { static constexpr bool PERM = true, AFTER_DRAIN = false; bf16_t* YR; const float* RS;
    __device__ __forceinline__ void operator()(AccT acc, const pg8::Unit& u, int wr, int wc, int fr, int fq) const {
        const int row0 = u.pm * 256 + wr * 64 + fr, j0 = wc * 32 + 8 * fq, h = u.pn >> 1;
#pragma unroll
        EPI_ROWS { const int row = row0 + ai * 128 + m * 16; const float mu = RS[(row * 4 + h) * 2], rs = RS[(row * 4 + h) * 2 + 1];
            bf16_t* rp = YR + (size_t)row * 2048 + u.pn * 256 + j0;
#pragma unroll
            for (int bj = 0; bj < 2; ++bj) { f32x4 ya, yb; unpack8(*(const u32x4*)(rp + bj * 128), ya, yb);
                *(u32x4*)(rp + bj * 128) = pack8(silu4(acc[ai][bj][m][0]) * ((ya - mu) * rs), silu4(acc[ai][bj][m][1]) * ((yb - mu) * rs)); } }
    } };
struct FEpiGate { static constexpr bool PERM = true, AFTER_DRAIN = false; bf16_t* SG; const float* bg;
    __device__ __forceinline__ void operator()(AccT acc, const pg8::Unit& u, int wr, int wc, int fr, int fq) const {
        const int row0 = u.pm * 256 + wr * 64 + fr, c0 = u.pn * 256 + wc * 32 + 8 * fq;
        f32x4 bv[2][2];
#pragma unroll
        for (int bj = 0; bj < 2; ++bj) { bv[bj][0] = *(const f32x4*)(bg + c0 + bj * 128); bv[bj][1] = *(const f32x4*)(bg + c0 + bj * 128 + 4); }
#pragma unroll
        EPI_ROWS { bf16_t* rp = SG + (size_t)(row0 + ai * 128 + m * 16) * 2048 + c0;
#pragma unroll
            for (int bj = 0; bj < 2; ++bj) *(u32x4*)(rp + bj * 128) = pack8(sigm4(acc[ai][bj][m][0] + bv[bj][0]), sigm4(acc[ai][bj][m][1] + bv[bj][1])); }
    } };
struct FEpiMr { static constexpr bool PERM = true, AFTER_DRAIN = false; float* MR; const bf16_t* SG;
    __device__ __forceinline__ void operator()(AccT acc, const pg8::Unit& u, int wr, int wc, int fr, int fq) const {
        const int row0 = u.pm * 256 + wr * 64 + fr, c0 = u.pn * 256 + wc * 32 + 8 * fq;
#pragma unroll
        EPI_ROWS { const int row = row0 + ai * 128 + m * 16;
#pragma unroll
            for (int bj = 0; bj < 2; ++bj) { f32x4 ga, gb; unpack8(*(const u32x4*)(SG + (size_t)row * 2048 + c0 + bj * 128), ga, gb);
                float* op = MR + (size_t)row * 1024 + c0 + bj * 128; *(f32x4*)op = ga * acc[ai][bj][m][0]; *(f32x4*)(op + 4) = gb * acc[ai][bj][m][1]; } }
    } };
struct FEpiMb { static constexpr bool PERM = true, AFTER_DRAIN = false; bf16_t* MB; const float* MR; const bf16_t* SG;
    __device__ __forceinline__ void operator()(AccT acc, const pg8::Unit& u, int wr, int wc, int fr, int fq) const {
        const int row0 = u.pm * 256 + wr * 64 + fr, c0 = u.pn * 256 + wc * 32 + 8 * fq;
#pragma unroll
        EPI_ROWS { const int row = row0 + ai * 128 + m * 16;
#pragma unroll
            for (int bj = 0; bj < 2; ++bj) { f32x4 ga, gb; unpack8(*(const u32x4*)(SG + (size_t)row * 2048 + 1024 + c0 + bj * 128), ga, gb);
                const float* ip = MR + (size_t)row * 1024 + c0 + bj * 128;
                *(u32x4*)(MB + (size_t)row * 1024 + c0 + bj * 128) = pack8(*(const f32x4*)ip + ga * acc[ai][bj][m][0], *(const f32x4*)(ip + 4) + gb * acc[ai][bj][m][1]); } }
    } };
struct FEpiZ1 { static constexpr bool PERM = true, AFTER_DRAIN = false; float* Z; const float* x; const float* STATS; const float* g; const float* b; const float* MOD;
    __device__ __forceinline__ void operator()(AccT acc, const pg8::Unit& u, int wr, int wc, int fr, int fq) const {
        const int row0 = u.pm * 256 + wr * 64 + fr, c0 = u.pn * 256 + wc * 32 + 8 * fq;
        const float* g1 = MOD + (u.pm / (SEQ / 256)) * 6144 + 2048;
#pragma unroll
        for (int bj = 0; bj < 2; ++bj)
#pragma unroll
            for (int n = 0; n < 2; ++n) { const int c = c0 + bj * 128 + n * 4; const f32x4 gg = *(const f32x4*)(g + c), bb = *(const f32x4*)(b + c), gm = *(const f32x4*)(g1 + c);
#pragma unroll
                EPI_ROWS { const int row = row0 + ai * 128 + m * 16; const float mu = STATS[row * 2], rs = STATS[row * 2 + 1];
                    const f32x4 xv = *(const f32x4*)(x + (size_t)row * 1024 + c); const f32x4 xn = (xv - mu) * rs * gg + bb;
                    *(f32x4*)(Z + (size_t)row * 1024 + c) = xn * ALPHA + gm * acc[ai][bj][m][n]; } }
    } };
struct FEpiUG { static constexpr bool PERM = true, AFTER_DRAIN = false; bf16_t* UG;
    __device__ __forceinline__ void operator()(AccT acc, const pg8::Unit& u, int wr, int wc, int fr, int fq) const {
        const int row0 = u.pm * 256 + wr * 64 + fr, c0 = u.pn * 256 + wc * 32 + 8 * fq;
#pragma unroll
        EPI_ROWS { bf16_t* rp = UG + (size_t)(row0 + ai * 128 + m * 16) * 5632 + c0; *(u32x4*)rp = pack8(acc[ai][0][m][0], acc[ai][0][m][1]); *(u32x4*)(rp + 128) = pack8(acc[ai][1][m][0], acc[ai][1][m][1]); }
    } };
struct FEpiZ2 { static constexpr bool PERM = true, AFTER_DRAIN = false; float* Z; const float* MOD;
    __device__ __forceinline__ void operator()(AccT acc, const pg8::Unit& u, int wr, int wc, int fr, int fq) const {
        const int row0 = u.pm * 256 + wr * 64 + fr, c0 = u.pn * 256 + wc * 32 + 8 * fq;
        const float* g2 = MOD + (u.pm / (SEQ / 256)) * 6144 + 5120;
#pragma unroll
        for (int bj = 0; bj < 2; ++bj)
#pragma unroll
            for (int n = 0; n < 2; ++n) { const int c = c0 + bj * 128 + n * 4; const f32x4 gm = *(const f32x4*)(g2 + c);
#pragma unroll
                EPI_ROWS { float* zp = Z + (size_t)(row0 + ai * 128 + m * 16) * 1024 + c; *(f32x4*)zp = *(const f32x4*)zp * ALPHA + gm * acc[ai][bj][m][n]; } }
    } };
template <class Epi> __device__ __forceinline__ void fast_gemm(unsigned char* lds, const bf16_t* A, const bf16_t* Bt, int M, int N, int K, const Epi& E) {
    pg8::Gemm g{A, Bt, M, N, K}; pg8::StaticOrder S; S.init(M, N, (int)gridDim.x, (int)blockIdx.x);
    pg8::gemm_phase<Epi, pg8::StaticOrder, true, true>((PG8_LAS unsigned char*)lds, g, S, E);
    __syncthreads();
}

constexpr int LDS_BYTES = 147456;
struct Params { const float* in[24]; float* out; unsigned char* ws; };
__global__ void __launch_bounds__(512, 2) mega(Params P) {
    extern __shared__ __attribute__((aligned(16))) unsigned char lds[];
    cg::grid_group grid = cg::this_grid();
    Ctx C; C.tid = threadIdx.x; C.lane = C.tid & 63; C.wave = C.tid >> 6; C.bx = blockIdx.x; C.G = gridDim.x;
    C.gw = C.bx * 8 + C.wave; C.NGW = C.G * 8; C.gt = C.bx * 512 + C.tid; C.NGT = C.G * 512; C.lds = lds;
    const float* x = P.in[0]; const float* c = P.in[1]; const float* ctx = P.in[2]; const float* cctx = P.in[3];
    const float* lng = P.in[4]; const float* lnb = P.in[5]; const float* wmod = P.in[6]; const float* bmod = P.in[7];
    const float* win = P.in[8]; const float* bgate = P.in[9]; const float* logit = P.in[10]; const float* dlam = P.in[11];
    const float* gsub = P.in[12]; const float* wret = P.in[13]; const float* wdif = P.in[14]; const float* wo = P.in[15];
    const float* ln1g = P.in[16]; const float* ln1b = P.in[17]; const float* wup = P.in[18]; const float* cw = P.in[19];
    const float* cb = P.in[20]; const float* wdn = P.in[21]; const float* ln2g = P.in[22]; const float* ln2b = P.in[23];
    unsigned char* ws = P.ws; float* out = P.out;
    float* MOD = (float*)(ws + WS_MOD); float* TAB = (float*)(ws + WS_TAB); float* SCAL = (float*)(ws + WS_SCAL); float* STATS = (float*)(ws + WS_STATS); float* RS = (float*)(ws + WS_RS);
    bf16_t* WIN = (bf16_t*)(ws + WS_WIN); bf16_t* WRET = (bf16_t*)(ws + WS_WRET); bf16_t* WDIF = (bf16_t*)(ws + WS_WDIF); bf16_t* WO = (bf16_t*)(ws + WS_WO);
    bf16_t* WUP = (bf16_t*)(ws + WS_WUP); bf16_t* WDN = (bf16_t*)(ws + WS_WDN); bf16_t* XM = (bf16_t*)(ws + WS_XM);
    bf16_t* QR = (bf16_t*)(ws + WS_QR); bf16_t* KR = (bf16_t*)(ws + WS_KR); bf16_t* VR = (bf16_t*)(ws + WS_VR); float* SST = (float*)(ws + WS_SST);
    bf16_t* QD = (bf16_t*)(ws + WS_QD); bf16_t* KD = (bf16_t*)(ws + WS_KD); bf16_t* VD = (bf16_t*)(ws + WS_VD); bf16_t* OD = (bf16_t*)(ws + WS_OD); bf16_t* AD = (bf16_t*)(ws + WS_AD);
    bf16_t* SG = (bf16_t*)(ws + WS_SG); float* MR = (float*)(ws + WS_MR); bf16_t* MB = (bf16_t*)(ws + WS_MB);
    bf16_t* UG = (bf16_t*)(ws + WS_UG); bf16_t* H = (bf16_t*)(ws + WS_H);
    bf16_t* YR = (bf16_t*)out;

    {
        float* scr = (float*)(lds + 65536) + C.wave * (64 * 33);
        constexpr int I_IN = 16 * 352, I_RET = 32 * 32, I_DIF = 16 * 32, I_O = 16 * 32, I_UP = 16 * 176, I_DN = 44 * 32;
        constexpr int NIT = I_IN + I_RET + I_DIF + I_O + I_UP + I_DN;
        for (int it = C.gw; it < NIT; it += C.NGW) {
            int r = it;
            if (r < I_IN) { transpose_item<1>(win, 1024, NIN, WIN, scr, r, C.lane); continue; } r -= I_IN;
            if (r < I_RET) { transpose_item<0>(wret, 2048, 1024, WRET, scr, r, C.lane); continue; } r -= I_RET;
            if (r < I_DIF) { transpose_item<0>(wdif, 1024, 1024, WDIF, scr, r, C.lane); continue; } r -= I_DIF;
            if (r < I_O) { transpose_item<0>(wo, 1024, 1024, WO, scr, r, C.lane); continue; } r -= I_O;
            if (r < I_UP) { transpose_item<2>(wup, 1024, 5632, WUP, scr, r, C.lane); continue; } r -= I_UP;
            transpose_item<0>(wdn, 2816, 1024, WDN, scr, r, C.lane);
        }
        d_mod(C, c, cctx, wmod, bmod, MOD);
        d_tables(C, logit, dlam, TAB, SCAL);
    }
    grid.sync();
    d_lnmod(C, x, ctx, lng, lnb, MOD, XM, STATS);
    grid.sync();
    fast_gemm(lds, XM, WIN + (size_t)C_QR * 1024, MA, 4096, 1024, FEpiRetQKV{QR, KR, VR, TAB});
    grid.sync();
    d_ret_naive(C, QR, KR, VR, YR, SST, SCAL);
    grid.sync();
    d_ret_stats(C, YR, RS);
    fast_gemm(lds, XM, WIN + (size_t)C_QD * 1024, MA, 3072, 1024, FEpiDifQKV{QD, KD, VD, TAB});
    grid.sync();
    d_attn_naive(C, QD, KD, VD, OD);
    grid.sync();
    d_prep_diff(C, OD, gsub, SCAL, AD);
    fast_gemm(lds, XM, WIN + (size_t)C_GR * 1024, ML, 2048, 1024, FEpiGr{YR, RS});
    grid.sync();
    fast_gemm(lds, XM, WIN + (size_t)C_GATE * 1024, ML, 2048, 1024, FEpiGate{SG, bgate});
    grid.sync();
    fast_gemm(lds, YR, WRET, ML, 1024, 2048, FEpiMr{MR, SG});
    grid.sync();
    fast_gemm(lds, AD, WDIF, ML, 1024, 1024, FEpiMb{MB, MR, SG});
    grid.sync();
    fast_gemm(lds, MB, WO, ML, 1024, 1024, FEpiZ1{out, x, STATS, lng, lnb, MOD});
    grid.sync();
    d_ln_rows(C, out, ln1g, ln1b, MOD, XM);
    grid.sync();
    for (int hf = 0; hf < 2; ++hf) {
        const int r0 = hf * (ML / 2);
        fast_gemm(lds, XM + (size_t)r0 * 1024, WUP, ML / 2, 5632, 1024, FEpiUG{UG});
        grid.sync();
        d_convgate(C, UG, r0, cw, cb, H);
        grid.sync();
    }
    fast_gemm(lds, H, WDN, ML, 1024, DFF, FEpiZ2{out, MOD});
    grid.sync();
    d_ln_rows(C, out, ln2g, ln2b, MOD, (bf16_t*)nullptr);
}

extern "C" void kernel_launch(void* const* d_in, const int* in_sizes, int n_in, void* d_out, int out_size, void* d_ws, size_t ws_size, hipStream_t stream) {
    static int grid = 0;
    if (grid == 0) {
        if (n_in != 24 || ws_size < WS_NEED) { fprintf(stderr, "kernel_launch: unexpected n_in %d / ws %zu\n", n_in, ws_size); grid = -1; return; }
        int dev = 0, cus = 0, per_cu = 0;
        if (hipGetDevice(&dev) != hipSuccess || hipDeviceGetAttribute(&cus, hipDeviceAttributeMultiprocessorCount, dev) != hipSuccess) { grid = -1; return; }
        if (hipFuncSetAttribute((const void*)mega, hipFuncAttributeMaxDynamicSharedMemorySize, LDS_BYTES) != hipSuccess) { fprintf(stderr, "kernel_launch: hipFuncSetAttribute failed\n"); grid = -1; return; }
        if (hipOccupancyMaxActiveBlocksPerMultiprocessor(&per_cu, (const void*)mega, 512, LDS_BYTES) != hipSuccess || per_cu < 1) { fprintf(stderr, "kernel_launch: occupancy query failed (%d)\n", per_cu); (void)hipGetLastError(); grid = -1; return; }
        grid = cus * 1;
        fprintf(stderr, "kernel_launch: cus %d per_cu %d grid %d\n", cus, per_cu, grid);
    }
    if (grid < 0) return;
    Params p{};
    for (int i = 0; i < 24; ++i) p.in[i] = (const float*)d_in[i];
    p.out = (float*)d_out; p.ws = (unsigned char*)d_ws;
    void* args[] = {&p};
    hipError_t e = hipLaunchCooperativeKernel((const void*)mega, dim3(grid), dim3(512), args, LDS_BYTES, stream);
    if (e != hipSuccess) fprintf(stderr, "kernel_launch: cooperative launch failed: %s (grid %d)\n", hipGetErrorString(e), grid);
}
```

```cpp
#include <hip/hip_runtime.h>
#include <hip/hip_cooperative_groups.h>
namespace cg = cooperative_groups;
#include <cstdio>
#include <cstdint>
#include <cmath>

typedef unsigned short bf16_t;
typedef short bf16x8 __attribute__((ext_vector_type(8)));
typedef float f32x4 __attribute__((ext_vector_type(4)));

constexpr int D = 1024, NB = 8, SEQ = 4096, CTX = 256, ML = NB * SEQ  , MC = NB * CTX  , MA = ML + MC  ;
constexpr int NIN = 11264, DFF = 2816;
constexpr int C_QR = 0, C_KR = 1024, C_VR = 2048, C_GR = 4096, C_QD = 6144, C_KD = 7168, C_VD = 8192, C_GATE = 9216;
constexpr float LN_EPS = 1e-5f;
constexpr float ALPHA = 1.189207115002721f;
constexpr float LAM_INIT = 0.2f;

constexpr size_t MiB = 1u << 20;
constexpr size_t WS_MOD = 0;
constexpr size_t WS_TAB = 256 * 1024;
constexpr size_t WS_SCAL = 320 * 1024;
constexpr size_t WS_STATS = 512 * 1024;
constexpr size_t WS_RS = 1 * MiB;
constexpr size_t WS_WIN = 2 * MiB;
constexpr size_t WS_WRET = 24 * MiB;
constexpr size_t WS_WDIF = 28 * MiB;
constexpr size_t WS_WO = 30 * MiB;
constexpr size_t WS_WUP = 32 * MiB;
constexpr size_t WS_WDN = 43 * MiB;
constexpr size_t WS_XM = 50 * MiB;
constexpr size_t WS_R = 118 * MiB;
constexpr size_t WS_QR = WS_R;
constexpr size_t WS_KR = WS_R + 64 * MiB;
constexpr size_t WS_VR = WS_R + 132 * MiB;
constexpr size_t WS_SST = WS_R + 272 * MiB;
constexpr size_t WS_QD = WS_R;
constexpr size_t WS_KD = WS_R + 64 * MiB;
constexpr size_t WS_VD = WS_R + 132 * MiB;
constexpr size_t WS_OD = WS_R + 200 * MiB;
constexpr size_t WS_AD = WS_R + 328 * MiB;
constexpr size_t WS_SG = WS_R;
constexpr size_t WS_MR = WS_R + 128 * MiB;
constexpr size_t WS_MB = WS_R + 256 * MiB;
constexpr size_t WS_UG = WS_R;
constexpr size_t WS_H = WS_R + 176 * MiB;
constexpr size_t WS_NEED = 512 * MiB;

__device__ __forceinline__ float bf2f(bf16_t v) { return __uint_as_float(((unsigned)v) << 16); }
__device__ __forceinline__ bf16_t f2bf(float f) { unsigned u = __float_as_uint(f); return (bf16_t)((u + 0x7fffu + ((u >> 16) & 1u)) >> 16); }
__device__ __forceinline__ float siluf(float x) { return x / (1.f + __expf(-x)); }
__device__ __forceinline__ float sigmf(float x) { return 1.f / (1.f + __expf(-x)); }
__device__ __forceinline__ float wave_sum(float v) {
#pragma unroll
    for (int o = 1; o < 64; o <<= 1) v += __shfl_xor(v, o);
    return v;
}

#define LAS __attribute__((address_space(3)))
__device__ __forceinline__ unsigned pk2(float lo, float hi) { return (unsigned)f2bf(lo) | ((unsigned)f2bf(hi) << 16); }
typedef unsigned v4u __attribute__((ext_vector_type(4)));
template <int MAP>
__device__ __forceinline__ void transpose_item(const float* __restrict__ W, int K, int N, bf16_t* __restrict__ WT, float* scr, int item, int lane) {
    const int nblk = N / 32, kb = item / nblk, nb = item % nblk, k0 = 64 * kb, n0 = 32 * nb;
    int s0 = n0;
    if (MAP == 1) { if (n0 >= C_QD && n0 < C_QD + 2048) { const int r = n0 - C_QD, t = r >> 8, p = r & 255, bj = p >> 7, qq = p & 127; s0 = C_QD + t * 256 + 64 * (qq >> 5) + 32 * bj; } }
    if (MAP == 2) { const int t = n0 >> 8, p = n0 & 255; s0 = p < 128 ? 128 * t + p : 2816 + 128 * t + (p - 128); }
#pragma unroll 8
    for (int i = 0; i < 32; ++i) { const int kk = 2 * i + (lane >> 5); scr[kk * 33 + (lane & 31)] = W[(size_t)(k0 + kk) * N + s0 + (lane & 31)]; }
    __builtin_amdgcn_s_waitcnt(0xC07F); __builtin_amdgcn_wave_barrier();
    const int c = lane & 7;
#pragma unroll
    for (int j = 0; j < 4; ++j) { const int n = (lane >> 3) + 8 * j; const float* s = scr + (8 * c) * 33 + n;
        v4u o; o.x = pk2(s[0 * 33], s[1 * 33]); o.y = pk2(s[2 * 33], s[3 * 33]); o.z = pk2(s[4 * 33], s[5 * 33]); o.w = pk2(s[6 * 33], s[7 * 33]);
        *(v4u*)(WT + (size_t)(n0 + n) * K + k0 + 8 * c) = o; }
    __builtin_amdgcn_s_waitcnt(0xC07F); __builtin_amdgcn_wave_barrier();
}


struct Ctx { int tid, lane, wave, bx, G, gw, NGW, gt, NGT; unsigned char* lds; };

__device__ __forceinline__ void d_mod(const Ctx& C, const float* __restrict__ c, const float* __restrict__ cctx, const float* __restrict__ wmod,
                                      const float* __restrict__ bmod, float* __restrict__ MOD) {
    if (C.bx >= 192) return;
    float* sc = (float*)C.lds;
    float* red = sc + 9 * 1024;
    for (int i = C.tid; i < 9 * 1024; i += 512) { const int r = i >> 10, k = i & 1023; const float v = r < 8 ? c[r * 1024 + k] : cctx[k]; sc[i] = siluf(v); }
    __syncthreads();
    for (int grp = C.bx; grp < 192; grp += C.G) {
        const int col = C.tid & 31, ks = C.tid >> 5, j = grp * 32 + col;
        float acc[9];
#pragma unroll
        for (int r = 0; r < 9; ++r) acc[r] = 0.f;
        for (int k = ks * 64; k < ks * 64 + 64; ++k) { const float w = wmod[(size_t)k * 6144 + j];
#pragma unroll
            for (int r = 0; r < 9; ++r) acc[r] += sc[r * 1024 + k] * w; }
#pragma unroll
        for (int r = 0; r < 9; ++r) red[(ks * 9 + r) * 32 + col] = acc[r];
        __syncthreads();
        if (C.tid < 288) { const int r = C.tid >> 5, cc = C.tid & 31; float a = bmod[grp * 32 + cc];
#pragma unroll
            for (int s = 0; s < 16; ++s) a += red[(s * 9 + r) * 32 + cc];
            MOD[r * 6144 + grp * 32 + cc] = a; }
        __syncthreads();
    }
}

__device__ __forceinline__ void sincos_acc(float ang, float& cs, float& sn) {
    const double TWO_PI = 6.283185307179586476925286766559;
    double a = (double)ang; const double k = rint(a / TWO_PI); double r = a - k * TWO_PI;
    const double r2 = r * r;
    double s = 1.0, c = 1.0;
#pragma unroll
    for (int n = 13; n >= 1; --n) { s = 1.0 - s * r2 / (double)((2 * n) * (2 * n + 1)); c = 1.0 - c * r2 / (double)((2 * n - 1) * (2 * n)); }
    sn = (float)(r * s); cs = (float)c;
}
__device__ __forceinline__ void d_tables(const Ctx& C, const float* __restrict__ logit, const float* __restrict__ dlam, float* __restrict__ TAB, float* __restrict__ SCAL) {
    if (C.bx == C.G - 1) {
        if (C.tid < 64) { float a = dlam[C.tid] * dlam[64 + C.tid], b = dlam[128 + C.tid] * dlam[192 + C.tid];
            a = wave_sum(a); b = wave_sum(b);
            if (C.tid == 0) SCAL[0] = expf(a) - expf(b) + LAM_INIT;
        } else if (C.tid < 72) { const float x = logit[C.tid - 64]; SCAL[1 + C.tid - 64] = fminf(x, 0.f) - log1pf(expf(-fabsf(x))); }
    }
    for (int i = C.gt; i < 64 * 64 + 64 * 16; i += C.NGT) {
        if (i < 4096) { const int p = i >> 6, f = i & 63; const float inv = powf(10000.f, -((float)(2 * f) / 128.f)); float cs, sn; sincos_acc((float)p * inv, cs, sn); TAB[i] = cs; TAB[4096 + i] = sn; }
        else { const int q = i - 4096, p = q >> 4, f = q & 15; const float inv = powf(10000.f, -((float)(2 * f) / 32.f)); float cs, sn; sincos_acc((float)p * inv, cs, sn); TAB[8192 + q] = cs; TAB[8192 + 1024 + q] = sn; }
    }
}

__device__ __forceinline__ void d_lnmod(const Ctx& C, const float* __restrict__ x, const float* __restrict__ ctx, const float* __restrict__ g, const float* __restrict__ bb,
                                        const float* __restrict__ MOD, bf16_t* __restrict__ XM, float* __restrict__ STATS) {
    const int lane = C.lane;
    for (int row = C.gw; row < MA; row += C.NGW) {
        const float* src = row < ML ? x + (size_t)row * D : ctx + (size_t)(row - ML) * D;
        const int mr = row < ML ? row / SEQ : 8;
        const float* sh = MOD + mr * 6144; const float* sc = sh + 1024;
        f32x4 v[4]; float s = 0.f;
#pragma unroll
        for (int j = 0; j < 4; ++j) { v[j] = *(const f32x4*)(src + j * 256 + lane * 4); s += (v[j].x + v[j].y) + (v[j].z + v[j].w); }
        const float mean = wave_sum(s) * (1.f / D); float s2 = 0.f;
#pragma unroll
        for (int j = 0; j < 4; ++j) { v[j] = v[j] - mean; s2 += (v[j].x * v[j].x + v[j].y * v[j].y) + (v[j].z * v[j].z + v[j].w * v[j].w); }
        const float rstd = 1.f / sqrtf(wave_sum(s2) * (1.f / D) + LN_EPS);
        if (row < ML && lane == 0) { STATS[row * 2] = mean; STATS[row * 2 + 1] = rstd; }
#pragma unroll
        for (int j = 0; j < 4; ++j) { const int c0 = j * 256 + lane * 4;
            const f32x4 gg = *(const f32x4*)(g + c0), bv = *(const f32x4*)(bb + c0), s1 = *(const f32x4*)(sc + c0), h1 = *(const f32x4*)(sh + c0);
            const f32x4 xn = v[j] * rstd * gg + bv; const f32x4 o = xn * (s1 + 1.f) + h1;
            ushort4 w; w.x = f2bf(o.x); w.y = f2bf(o.y); w.z = f2bf(o.z); w.w = f2bf(o.w);
            *(ushort4*)(XM + (size_t)row * D + c0) = w; }
    }
}

template <class Epi>
__device__ __forceinline__ void d_gemm(const Ctx& C, const bf16_t* __restrict__ A, int lda, const bf16_t* __restrict__ Bt, int ldb, int M, int N, int K, const Epi& epi) {
    const int fr = C.lane & 15, fq = C.lane >> 4, ntn = N / 256, nt = (M / 128) * ntn;
    for (int t = C.bx; t < nt; t += C.G) {
        const int row0 = (t / ntn) * 128 + (C.wave >> 2) * 64, col0 = (t % ntn) * 256 + (C.wave & 3) * 64;
        f32x4 acc[4][4];
#pragma unroll
        for (int i = 0; i < 4; ++i)
#pragma unroll
            for (int j = 0; j < 4; ++j) acc[i][j] = (f32x4){0.f, 0.f, 0.f, 0.f};
        const bf16_t* Ap = A + (size_t)(row0 + fr) * lda + fq * 8;
        const bf16_t* Bp = Bt + (size_t)(col0 + fr) * ldb + fq * 8;
        for (int k0 = 0; k0 < K; k0 += 32) {
            bf16x8 a[4], b[4];
#pragma unroll
            for (int i = 0; i < 4; ++i) { a[i] = *(const bf16x8*)(Ap + (size_t)i * 16 * lda + k0); b[i] = *(const bf16x8*)(Bp + (size_t)i * 16 * ldb + k0); }
#pragma unroll
            for (int i = 0; i < 4; ++i)
#pragma unroll
                for (int j = 0; j < 4; ++j) acc[i][j] = __builtin_amdgcn_mfma_f32_16x16x32_bf16(a[i], b[j], acc[i][j], 0, 0, 0);
        }
#pragma unroll
        for (int i = 0; i < 4; ++i)
#pragma unroll
            for (int j = 0; j < 4; ++j)
#pragma unroll
                for (int r = 0; r < 4; ++r) epi(row0 + i * 16 + fq * 4 + r, col0 + j * 16 + fr, acc[i][j][r]);
    }
}

struct EpiRetQKV { bf16_t *QR, *KR, *VR;
    __device__ __forceinline__ void operator()(int r, int c, float v) const {
        if (c < 1024) { if (r < ML) QR[(size_t)r * 1024 + c] = f2bf(v); }
        else if (c < 2048) KR[(size_t)r * 1024 + (c - 1024)] = f2bf(v * 0.0625f);
        else VR[(size_t)r * 2048 + (c - 2048)] = f2bf(v); } };
struct EpiDifQKV { bf16_t *QD, *KD, *VD;
    __device__ __forceinline__ void operator()(int r, int c, float v) const {
        if (c < 1024) { if (r < ML) QD[(size_t)r * 1024 + c] = f2bf(v * 0.125f); }
        else if (c < 2048) KD[(size_t)r * 1024 + (c - 1024)] = f2bf(v);
        else VD[(size_t)r * 1024 + (c - 2048)] = f2bf(v); } };
struct EpiGr { bf16_t* YR; const float* RS;
    __device__ __forceinline__ void operator()(int r, int c, float v) const {
        const int h = c >> 9; const float mu = RS[(r * 4 + h) * 2], rs = RS[(r * 4 + h) * 2 + 1];
        const size_t o = (size_t)r * 2048 + c; const float yn = (bf2f(YR[o]) - mu) * rs; YR[o] = f2bf(siluf(v) * yn); } };
struct EpiGate { bf16_t* SG; const float* bg;
    __device__ __forceinline__ void operator()(int r, int c, float v) const { SG[(size_t)r * 2048 + c] = f2bf(sigmf(v + bg[c])); } };
struct EpiMr { float* MR; const bf16_t* SG;
    __device__ __forceinline__ void operator()(int r, int c, float v) const { MR[(size_t)r * 1024 + c] = bf2f(SG[(size_t)r * 2048 + c]) * v; } };
struct EpiMb { bf16_t* MB; const float* MR; const bf16_t* SG;
    __device__ __forceinline__ void operator()(int r, int c, float v) const { MB[(size_t)r * 1024 + c] = f2bf(MR[(size_t)r * 1024 + c] + bf2f(SG[(size_t)r * 2048 + 1024 + c]) * v); } };
struct EpiZ1 { float* Z; const float* x; const float* STATS; const float* g; const float* b; const float* MOD;
    __device__ __forceinline__ void operator()(int r, int c, float v) const {
        const float xn = (x[(size_t)r * 1024 + c] - STATS[r * 2]) * STATS[r * 2 + 1] * g[c] + b[c];
        Z[(size_t)r * 1024 + c] = ALPHA * xn + MOD[(r / SEQ) * 6144 + 2048 + c] * v; } };
struct EpiUG { bf16_t* UG;
    __device__ __forceinline__ void operator()(int r, int c, float v) const { UG[(size_t)r * 5632 + c] = f2bf(v); } };
struct EpiZ2 { float* Z; const float* MOD;
    __device__ __forceinline__ void operator()(int r, int c, float v) const { const size_t o = (size_t)r * 1024 + c; Z[o] = ALPHA * Z[o] + MOD[(r / SEQ) * 6144 + 5120 + c] * v; } };

__device__ __forceinline__ void d_rope_ret(const Ctx& C, bf16_t* __restrict__ X, const float* __restrict__ TAB) {
    for (int idx = C.gt; idx < ML * 512; idx += C.NGT) {
        const int row = idx >> 9, p = idx & 511, h = p >> 7, j = p & 127;
        const int t = row & (SEQ - 1), pr = t >> 6, pc = t & 63;
        const int ti = j < 64 ? pr * 64 + j : pc * 64 + (j - 64);
        const float cs = TAB[ti], sn = TAB[4096 + ti];
        bf16_t* a = X + (size_t)row * 1024 + h * 256 + j;
        const float x1 = bf2f(a[0]), x2 = bf2f(a[128]);
        a[0] = f2bf(x1 * cs - x2 * sn); a[128] = f2bf(x2 * cs + x1 * sn);
    }
}
__device__ __forceinline__ void d_rope_dif(const Ctx& C, bf16_t* __restrict__ X, const float* __restrict__ TAB) {
    for (int idx = C.gt; idx < ML * 512; idx += C.NGT) {
        const int row = idx >> 9, p = idx & 511, blk = p >> 5, j = p & 31;
        const int t = row & (SEQ - 1), pr = t >> 6, pc = t & 63;
        const int ti = j < 16 ? pr * 16 + j : pc * 16 + (j - 16);
        const float cs = TAB[8192 + ti], sn = TAB[8192 + 1024 + ti];
        bf16_t* a = X + (size_t)row * 1024 + blk * 64 + j;
        const float x1 = bf2f(a[0]), x2 = bf2f(a[32]);
        a[0] = f2bf(x1 * cs - x2 * sn); a[32] = f2bf(x2 * cs + x1 * sn);
    }
}

__device__ __forceinline__ void d_ret_naive(const Ctx& C, const bf16_t* __restrict__ QR, const bf16_t* __restrict__ KR, const bf16_t* __restrict__ VR,
                                            bf16_t* __restrict__ YR, float* __restrict__ Sg, const float* __restrict__ SCAL) {
    bf16_t* qs = (bf16_t*)C.lds; bf16_t* ks = qs + 128 * 256; bf16_t* vs = ks + 128 * 256; bf16_t* Ps = qs;
    const int tid = C.tid;
    for (int bid = C.bx; bid < 256; bid += C.G) {
    const int vsl = bid & 7, h = (bid >> 3) & 3, b = bid >> 5;
    float* S = Sg + (size_t)bid * 16384;
    const float lgf = SCAL[1 + h], lgb = SCAL[5 + h];
    const int c = tid & 63, g8 = tid >> 6;
    for (int pass = 0; pass < 2; ++pass) {
        const float lg = pass ? lgb : lgf;
        for (int i = 0; i < 32; ++i) S[(g8 * 32 + i) * 64 + c] = 0.f;
        __syncthreads();
        for (int step = 0; step < 34; ++step) {
            const bool lat = step >= 2;
            int tz = 0; asm volatile("" : "+v"(tz));
            int rowbase;
            if (!lat) { const int cc = pass ? 1 - step : step; rowbase = ML + b * CTX + cc * 128; }
            else { const int n = pass ? 33 - step : step - 2; rowbase = b * SEQ + n * 128; }
            for (int p = tid; p < 128 * 32; p += 512) { const int r = p >> 5, ch = p & 31;
                *(bf16x8*)(ks + r * 256 + ch * 8) = *(const bf16x8*)(KR + (size_t)(rowbase + r) * 1024 + h * 256 + ch * 8);
                if (lat) *(bf16x8*)(qs + r * 256 + ch * 8) = *(const bf16x8*)(QR + (size_t)(rowbase + r) * 1024 + h * 256 + ch * 8); }
            for (int p = tid; p < 128 * 8; p += 512) { const int r = p >> 3, ch = p & 7;
                *(bf16x8*)(vs + r * 64 + ch * 8) = *(const bf16x8*)(VR + (size_t)(rowbase + r) * 2048 + h * 512 + vsl * 64 + ch * 8); }
            __syncthreads();
            if (lat) {
                float yacc[16];
#pragma unroll
                for (int ii = 0; ii < 16; ++ii) { const int i = g8 * 16 + ii + tz; float a = 0.f;
#pragma unroll 2
                    for (int d = 0; d < 256; ++d) a += bf2f(qs[i * 256 + d]) * bf2f(f2bf(S[d * 64 + c]));
                    yacc[ii] = a * __expf(lg * (pass ? (float)(128 - i) : (float)(i + 1))); }
                if (pass == 0) {
                    const int j = (tid & 127) + tz, g4 = tid >> 7; float pv[32];
#pragma unroll
                    for (int ii = 0; ii < 32; ++ii) { const int i = g4 * 32 + ii; float a = 0.f;
#pragma unroll 2
                        for (int d = 0; d < 256; ++d) a += bf2f(qs[i * 256 + d]) * bf2f(ks[j * 256 + d]);
                        const float m = i > j ? __expf(lgf * (float)(i - j)) : (i < j ? __expf(lgb * (float)(j - i)) : 2.f);
                        pv[ii] = a * m; }
                    __syncthreads();
#pragma unroll
                    for (int ii = 0; ii < 32; ++ii) Ps[(g4 * 32 + ii) * 128 + j] = f2bf(pv[ii]);
                    __syncthreads();
#pragma unroll
                    for (int ii = 0; ii < 16; ++ii) { const int i = g8 * 16 + ii; float a = 0.f;
#pragma unroll 2
                        for (int jj = 0; jj < 128; ++jj) a += bf2f(Ps[i * 128 + jj]) * bf2f(vs[jj * 64 + c]);
                        yacc[ii] += a; }
                }
#pragma unroll
                for (int ii = 0; ii < 16; ++ii) { const int i = g8 * 16 + ii; bf16_t* yp = YR + (size_t)(rowbase + i) * 2048 + h * 512 + vsl * 64 + c;
                    if (pass == 0) *yp = f2bf(yacc[ii]); else *yp = f2bf(bf2f(*yp) + yacc[ii]); }
            }
            const float ds = __expf(lg * 128.f);
            float acc[32];
#pragma unroll
            for (int i = 0; i < 32; ++i) acc[i] = 0.f;
#pragma unroll 1
            for (int jj = 0; jj < 128; ++jj) { const float vv = bf2f(f2bf(bf2f(vs[jj * 64 + c]) * __expf(lg * (pass ? (float)(jj + tz) : (float)(127 - jj + tz)))));
#pragma unroll
                for (int i = 0; i < 32; ++i) acc[i] += bf2f(ks[jj * 256 + g8 * 32 + i]) * vv; }
            __syncthreads();
#pragma unroll
            for (int i = 0; i < 32; ++i) { float* sp = S + (g8 * 32 + i) * 64 + c; *sp = *sp * ds + acc[i]; }
            __syncthreads();
        }
    }
    }
}

constexpr int ATTN_NAIVE_LDS = 64 * 64 * 2 + 64 * 128 * 2 + 64 * 65 * 4;
__device__ __forceinline__ void d_attn_naive(const Ctx& C, const bf16_t* __restrict__ QD, const bf16_t* __restrict__ KD, const bf16_t* __restrict__ VD, bf16_t* __restrict__ OD) {
    const int half = C.tid >> 8, tid = C.tid & 255, qi = tid >> 2, part = tid & 3;
    unsigned char* base = C.lds + half * ATTN_NAIVE_LDS;
    bf16_t* Ks = (bf16_t*)base; bf16_t* Vs = Ks + 64 * 64; float* Pm = (float*)(Vs + 64 * 128);
    for (int vb2 = C.bx; vb2 < 4096; vb2 += C.G) {
        const int vb = vb2 * 2 + half;
        const int qb = vb & 63, cc = (vb >> 6) & 1, h = (vb >> 7) & 7, b = vb >> 10;
        const int qrow = b * SEQ + qb * 64 + qi;
        float q[64];
#pragma unroll
        for (int d = 0; d < 64; ++d) q[d] = bf2f(QD[(size_t)qrow * 1024 + h * 128 + cc * 64 + d]);
        float o[32];
#pragma unroll
        for (int e = 0; e < 32; ++e) o[e] = 0.f;
        float m = -1e30f, l = 0.f;
        for (int kt = 0; kt < 68; ++kt) {
            const int krow0 = kt < 64 ? b * SEQ + kt * 64 : ML + b * CTX + (kt - 64) * 64;
            for (int p = tid; p < 64 * 8; p += 256) { const int r = p >> 3, ch = p & 7; *(bf16x8*)(Ks + r * 64 + ch * 8) = *(const bf16x8*)(KD + (size_t)(krow0 + r) * 1024 + h * 128 + cc * 64 + ch * 8); }
            for (int p = tid; p < 64 * 16; p += 256) { const int r = p >> 4, ch = p & 15; *(bf16x8*)(Vs + r * 128 + ch * 8) = *(const bf16x8*)(VD + (size_t)(krow0 + r) * 1024 + h * 128 + ch * 8); }
            __syncthreads();
            float s[16]; float mx = -1e30f;
#pragma unroll
            for (int jj = 0; jj < 16; ++jj) { const int j = part * 16 + jj; float a = 0.f;
#pragma unroll
                for (int d = 0; d < 64; ++d) a += q[d] * bf2f(Ks[j * 64 + d]);
                s[jj] = a; mx = fmaxf(mx, a); }
            mx = fmaxf(mx, __shfl_xor(mx, 1)); mx = fmaxf(mx, __shfl_xor(mx, 2));
            const float mn = fmaxf(m, mx), al = __expf(m - mn); m = mn;
            float ps = 0.f;
#pragma unroll
            for (int jj = 0; jj < 16; ++jj) { const float p = __expf(s[jj] - mn); ps += p; Pm[qi * 65 + part * 16 + jj] = bf2f(f2bf(p)); }
            l = l * al + ps;
#pragma unroll
            for (int e = 0; e < 32; ++e) o[e] *= al;
            __syncthreads();
            for (int j = 0; j < 64; ++j) { const float p = Pm[qi * 65 + j];
#pragma unroll
                for (int e = 0; e < 32; ++e) o[e] += p * bf2f(Vs[j * 128 + part * 32 + e]); }
            __syncthreads();
        }
        l += __shfl_xor(l, 1); l += __shfl_xor(l, 2);
        const float il = 1.f / l;
#pragma unroll
        for (int e = 0; e < 32; ++e) OD[(size_t)qrow * 2048 + h * 256 + cc * 128 + part * 32 + e] = f2bf(o[e] * il);
    }
}

__device__ __forceinline__ void d_prep_diff(const Ctx& C, const bf16_t* __restrict__ OD, const float* __restrict__ gsub, const float* __restrict__ SCAL, bf16_t* __restrict__ AD) {
    const int t = C.tid & 255, h = t >> 5, l = t & 31; const float lam = SCAL[0];
    for (int r2 = C.bx; r2 < ML / 2; r2 += C.G) {
        const int row = r2 * 2 + (C.tid >> 8);
        float a[4]; float ss = 0.f;
#pragma unroll
        for (int i = 0; i < 4; ++i) { const int e = l * 4 + i; a[i] = bf2f(OD[(size_t)row * 2048 + h * 256 + e]) - lam * bf2f(OD[(size_t)row * 2048 + h * 256 + 128 + e]); ss += a[i] * a[i]; }
#pragma unroll
        for (int o = 1; o < 32; o <<= 1) ss += __shfl_xor(ss, o);
        const float rs = 1.f / sqrtf(ss * (1.f / 128.f) + LN_EPS);
#pragma unroll
        for (int i = 0; i < 4; ++i) { const int e = l * 4 + i; AD[(size_t)row * 1024 + h * 128 + e] = f2bf(a[i] * rs * gsub[e] * (1.f - LAM_INIT)); }
    }
}
__device__ __forceinline__ void d_ret_stats(const Ctx& C, const bf16_t* __restrict__ YR, float* __restrict__ RS) {
    for (int it = C.gw; it < ML * 4; it += C.NGW) {
        const int row = it >> 2, h = it & 3;
        float v[8]; float s = 0.f;
#pragma unroll
        for (int i = 0; i < 8; ++i) { v[i] = bf2f(YR[(size_t)row * 2048 + h * 512 + C.lane * 8 + i]); s += v[i]; }
        const float mu = wave_sum(s) * (1.f / 512.f); float s2 = 0.f;
#pragma unroll
        for (int i = 0; i < 8; ++i) { const float d = v[i] - mu; s2 += d * d; }
        const float var = wave_sum(s2) * (1.f / 512.f);
        if (C.lane == 0) { RS[it * 2] = mu; RS[it * 2 + 1] = 1.f / sqrtf(var + LN_EPS); }
    }
}

__device__ __forceinline__ void d_ln_rows(const Ctx& C, float* __restrict__ Z, const float* __restrict__ g, const float* __restrict__ bb, const float* __restrict__ MOD, bf16_t* __restrict__ XM) {
    const int lane = C.lane;
    for (int row = C.gw; row < ML; row += C.NGW) {
        float* src = Z + (size_t)row * D;
        f32x4 v[4]; float s = 0.f;
#pragma unroll
        for (int j = 0; j < 4; ++j) { v[j] = *(const f32x4*)(src + j * 256 + lane * 4); s += (v[j].x + v[j].y) + (v[j].z + v[j].w); }
        const float mean = wave_sum(s) * (1.f / D); float s2 = 0.f;
#pragma unroll
        for (int j = 0; j < 4; ++j) { v[j] = v[j] - mean; s2 += (v[j].x * v[j].x + v[j].y * v[j].y) + (v[j].z * v[j].z + v[j].w * v[j].w); }
        const float rstd = 1.f / sqrtf(wave_sum(s2) * (1.f / D) + LN_EPS);
        const float* sh = MOD + (row / SEQ) * 6144 + 3072; const float* sc = sh + 1024;
#pragma unroll
        for (int j = 0; j < 4; ++j) { const int c0 = j * 256 + lane * 4;
            const f32x4 gg = *(const f32x4*)(g + c0), bv = *(const f32x4*)(bb + c0);
            const f32x4 xn = v[j] * rstd * gg + bv; *(f32x4*)(src + c0) = xn;
            if (XM) { const f32x4 s1 = *(const f32x4*)(sc + c0), h1 = *(const f32x4*)(sh + c0); const f32x4 o = xn * (s1 + 1.f) + h1;
                ushort4 w; w.x = f2bf(o.x); w.y = f2bf(o.y); w.z = f2bf(o.z); w.w = f2bf(o.w); *(ushort4*)(XM + (size_t)row * D + c0) = w; } }
    }
}

__device__ __forceinline__ void d_convgate(const Ctx& C, const bf16_t* __restrict__ UG, int row_off, const float* __restrict__ cw, const float* __restrict__ cb, bf16_t* __restrict__ H) {
    for (int idx = C.gt; idx < (ML / 2) * DFF; idx += C.NGT) {
        const int lr = idx / DFF, f = idx % DFF, row = row_off + lr, t = row & (SEQ - 1);
        const int uc = (f >> 7) * 256 + (f & 127);
        float u = cb[f] + cw[DFF + f] * bf2f(UG[(size_t)lr * 5632 + uc]);
        if (t > 0) u += cw[f] * bf2f(UG[(size_t)(lr - 1) * 5632 + uc]);
        if (t < SEQ - 1) u += cw[2 * DFF + f] * bf2f(UG[(size_t)(lr + 1) * 5632 + uc]);
        const float ge = 0.5f * u * (1.f + erff(u * 0.70710678118654752f));
        H[(size_t)row * DFF + f] = f2bf(ge * bf2f(UG[(size_t)lr * 5632 + uc + 128]));
    }
}

namespace pg8 {
#define PG8_LAS __attribute__((address_space(3)))
typedef unsigned short bf16_t;
typedef short bf16x8 __attribute__((ext_vector_type(8)));
typedef float f32x4 __attribute__((ext_vector_type(4)));
typedef unsigned u32x4 __attribute__((ext_vector_type(4)));
constexpr int BM = 256, BK = 64, HALF = 128, HTB = HALF * BK * 2  , STAGE_BYTES = 8 * HTB, NXCD = 8, WGM = 8;

__host__ __device__ __forceinline__ int lds_byte(int r, int c) { const int st = (r >> 4) * 2 + (c >> 5), rr = r & 15, cc = c & 31, ob = rr * 64 + cc * 2; return st * 1024 + (ob ^ (((ob >> 9) & 1) << 5)); }
__host__ __device__ __forceinline__ void stage_rc(int b, int& R, int& C) { const int st = b / 1024, sb = b % 1024, swz = sb ^ (((sb >> 9) & 1) << 5); R = (st >> 1) * 16 + swz / 64; C = (st & 1) * 32 + (swz % 64) / 2; }
__host__ __device__ __forceinline__ int perm32(int rho) { const int n = rho >> 4, i = rho & 15; return 8 * (i >> 2) + 4 * n + (i & 3); }

struct Unit { int pm, pn; };
struct Gemm { const bf16_t* A; const bf16_t* Bt; int M, N, K; };

struct StaticOrder {
    int nM, nN, nwg, G, c;
    __host__ __device__ void init(int M, int N, int G_, int c_) { nM = M / BM; nN = N / BM; nwg = nM * nN; G = G_; c = c_; }
    __host__ __device__ bool next(int i, Unit& u) const {
        const long L = (long)i * G + c; if (L >= nwg) return false;
        int wgid = (int)L; { const int q = nwg / NXCD, r = nwg % NXCD, xcd = wgid % NXCD, off = wgid / NXCD; wgid = (xcd < r ? xcd * (q + 1) : r * (q + 1) + (xcd - r) * q) + off; }
        const int nig = WGM * nN, gid = wgid / nig, fm = gid * WGM, gsz = (nM - fm) < WGM ? (nM - fm) : WGM;
        u.pm = fm + ((wgid % nig) % gsz); u.pn = (wgid % nig) / gsz; return true;
    }
    __device__ __forceinline__ void a_ready(const Unit&) const {}
    __device__ __forceinline__ void done(const Unit&) const {}
};

template <class Epi, class Sched, bool ALIGN_EPI = false, bool SP2 = false>
__device__ __forceinline__ void gemm_phase(PG8_LAS unsigned char* lds, const Gemm g, const Sched& S, const Epi& E) {
    int tid_ = threadIdx.x; asm volatile("" : "+v"(tid_));
    const int tid = tid_, wid = __builtin_amdgcn_readfirstlane(tid >> 6), lane = tid & 63, wr = wid >> 2, wc = wid & 3, fr = lane & 15, fq = lane >> 4;
    const int K = g.K, nt = K / BK;
    unsigned voffA[2], voffB[2];
#pragma unroll
    for (int i = 0; i < 2; ++i) { int R, C; stage_rc(tid * 16 + i * 8192, R, C); const int Rb = Epi::PERM ? ((R & ~31) + perm32(R & 31)) : R;
        voffA[i] = (unsigned)(R * K + C) * 2u; voffB[i] = (unsigned)(Rb * K + C) * 2u; }
    const size_t kstep = (size_t)(BK * 2);
    const size_t hstep = (size_t)HALF * K * 2;
    const size_t tstep = 2 * hstep;
    const unsigned ldsw = (unsigned)wid * 1024u;
    const int aoff = lds_byte(wr * 64 + fr, fq * 8), boff = lds_byte(wc * 32 + fr, fq * 8);
#define PG8_SA(b, h) (((b) * 2 + (h)) * HTB)
#define PG8_SB(b, h) ((4 + (b) * 2 + (h)) * HTB)
#define PG8_STAGE(bufoff, gbase, voff) do { _Pragma("unroll") for (int _i = 0; _i < 2; ++_i) \
        __builtin_amdgcn_global_load_lds((const unsigned*)((const char*)(gbase) + (voff)[_i]), (PG8_LAS unsigned*)(lds + (bufoff) + ldsw + _i * 8192), 16, 0, 0); } while (0)
#define PG8_LDA(dst, b, h) do { _Pragma("unroll") for (int m = 0; m < 4; ++m) _Pragma("unroll") for (int k = 0; k < 2; ++k) dst[m][k] = *(const PG8_LAS bf16x8*)(lds + PG8_SA(b, h) + aoff + m * 2048 + k * 1024); } while (0)
#define PG8_LDB(dst, b, h) do { _Pragma("unroll") for (int n = 0; n < 2; ++n) _Pragma("unroll") for (int k = 0; k < 2; ++k) dst[n][k] = *(const PG8_LAS bf16x8*)(lds + PG8_SB(b, h) + boff + n * 2048 + k * 1024); } while (0)
#define PG8_MMA(ai, bj, At, Bt) do { __builtin_amdgcn_s_setprio(1); _Pragma("unroll") for (int m = 0; m < 4; ++m) _Pragma("unroll") for (int n = 0; n < 2; ++n) _Pragma("unroll") for (int k = 0; k < 2; ++k) \
        acc[ai][bj][m][n] = __builtin_amdgcn_mfma_f32_16x16x32_bf16(Bt[n][k], At[m][k], acc[ai][bj][m][n], 0, 0, 0); __builtin_amdgcn_s_setprio(0); } while (0)
#define PG8_WAIT_V(n) asm volatile("s_waitcnt vmcnt(" #n ")" ::: "memory")
#define PG8_WAIT_L(n) asm volatile("s_waitcnt lgkmcnt(" #n ")" ::: "memory")
#define PG8_BAR __builtin_amdgcn_s_barrier()
#define PG8_SCHED __builtin_amdgcn_sched_barrier(0)
    Unit cur, nxt; int ui = 0;
    if (!S.next(0, cur)) return;
    f32x4 acc[2][2][4][2];
#pragma unroll
    for (int a = 0; a < 2; ++a)
#pragma unroll
        for (int b = 0; b < 2; ++b)
#pragma unroll
            for (int m = 0; m < 4; ++m)
#pragma unroll
                for (int n = 0; n < 2; ++n) acc[a][b][m][n] = (f32x4){0.f, 0.f, 0.f, 0.f};
    bf16x8 At[4][2], B0[2][2], B1[2][2];
    const char* cA = (const char*)g.A + (size_t)cur.pm * tstep; const char* cB = (const char*)g.Bt + (size_t)cur.pn * tstep;
    S.a_ready(cur);
    if constexpr (SP2) {
        PG8_STAGE(PG8_SB(0, 0), cB, voffB); PG8_STAGE(PG8_SB(0, 1), cB + hstep, voffB); PG8_STAGE(PG8_SA(0, 0), cA, voffA); PG8_STAGE(PG8_SA(0, 1), cA + hstep, voffA);
        if (wr == 1) PG8_BAR;
        PG8_WAIT_V(2); PG8_BAR;
        PG8_STAGE(PG8_SB(1, 0), cB + kstep, voffB); PG8_STAGE(PG8_SA(1, 0), cA + kstep, voffA); PG8_STAGE(PG8_SB(1, 1), cB + hstep + kstep, voffB);
        PG8_WAIT_V(6); PG8_BAR;
    } else {
        PG8_STAGE(PG8_SB(0, 0), cB, voffB); PG8_STAGE(PG8_SA(0, 0), cA, voffA); PG8_STAGE(PG8_SB(0, 1), cB + hstep, voffB); PG8_STAGE(PG8_SA(0, 1), cA + hstep, voffA);
        if (wr == 1) PG8_BAR;
        PG8_WAIT_V(4); PG8_BAR;
        PG8_STAGE(PG8_SB(1, 0), cB + kstep, voffB); PG8_STAGE(PG8_SA(1, 0), cA + kstep, voffA); PG8_STAGE(PG8_SB(1, 1), cB + hstep + kstep, voffB);
        PG8_WAIT_V(6); PG8_BAR;
    }
    for (;;) {
        const bool has_next = S.next(ui + 1, nxt);
        const char* nA = has_next ? (const char*)g.A + (size_t)nxt.pm * tstep : cA; const char* nB = has_next ? (const char*)g.Bt + (size_t)nxt.pn * tstep : cB;
        for (int t = 0; t < nt; t += 2) {
            const bool last = (t == nt - 2);
            const char* a1 = cA + (size_t)(t + 1) * kstep;
            const char* a2 = last ? nA : cA + (size_t)(t + 2) * kstep; const char* b2 = last ? nB : cB + (size_t)(t + 2) * kstep;
            const char* a3 = a2 + kstep; const char* b3 = b2 + kstep;
            if (last && has_next) S.a_ready(nxt);
            if constexpr (SP2) {
            PG8_LDB(B0, 0, 0); PG8_LDB(B1, 0, 1); PG8_SCHED; PG8_LDA(At, 0, 0); PG8_STAGE(PG8_SA(1, 1), a1 + hstep, voffA);
            PG8_WAIT_V(8); PG8_WAIT_L(0); PG8_BAR; PG8_MMA(0, 0, At, B0); PG8_MMA(0, 1, At, B1); PG8_BAR; PG8_SCHED;
            PG8_LDA(At, 0, 1); PG8_STAGE(PG8_SB(0, 0), b2, voffB); PG8_STAGE(PG8_SB(0, 1), b2 + hstep, voffB); PG8_STAGE(PG8_SA(0, 0), a2, voffA);
            PG8_WAIT_V(8); PG8_WAIT_L(0); PG8_BAR; PG8_MMA(1, 0, At, B0); PG8_MMA(1, 1, At, B1); PG8_BAR; PG8_SCHED;
            PG8_LDB(B0, 1, 0); PG8_LDB(B1, 1, 1); PG8_SCHED; PG8_LDA(At, 1, 0); PG8_STAGE(PG8_SA(0, 1), a2 + hstep, voffA);
            PG8_WAIT_V(8); PG8_WAIT_L(0); PG8_BAR; PG8_MMA(0, 0, At, B0); PG8_MMA(0, 1, At, B1); PG8_BAR; PG8_SCHED;
            PG8_LDA(At, 1, 1); PG8_STAGE(PG8_SB(1, 0), b3, voffB); PG8_STAGE(PG8_SB(1, 1), b3 + hstep, voffB); PG8_STAGE(PG8_SA(1, 0), a3, voffA);
            PG8_WAIT_V(8); PG8_WAIT_L(0); PG8_BAR; PG8_MMA(1, 0, At, B0); PG8_MMA(1, 1, At, B1); PG8_BAR; PG8_SCHED;
            } else {
            PG8_LDB(B0, 0, 0); PG8_SCHED; PG8_LDA(At, 0, 0); PG8_STAGE(PG8_SA(1, 1), a1 + hstep, voffA);
            PG8_WAIT_L(8); PG8_BAR; PG8_WAIT_L(0); PG8_MMA(0, 0, At, B0); PG8_BAR; PG8_SCHED;
            PG8_LDB(B1, 0, 1); PG8_STAGE(PG8_SB(0, 0), b2, voffB);
            PG8_BAR; PG8_WAIT_L(0); PG8_MMA(0, 1, At, B1); PG8_BAR;
            PG8_LDA(At, 0, 1); PG8_STAGE(PG8_SA(0, 0), a2, voffA);
            PG8_BAR; PG8_WAIT_L(0); PG8_MMA(1, 0, At, B0); PG8_BAR; PG8_SCHED;
            PG8_STAGE(PG8_SB(0, 1), b2 + hstep, voffB);
            PG8_WAIT_V(6); PG8_BAR; PG8_MMA(1, 1, At, B1); PG8_BAR;
            PG8_LDB(B0, 1, 0); PG8_SCHED; PG8_LDA(At, 1, 0); PG8_STAGE(PG8_SA(0, 1), a2 + hstep, voffA);
            PG8_WAIT_L(8); PG8_BAR; PG8_WAIT_L(0); PG8_MMA(0, 0, At, B0); PG8_BAR; PG8_SCHED;
            PG8_LDB(B1, 1, 1); PG8_STAGE(PG8_SB(1, 0), b3, voffB);
            PG8_BAR; PG8_WAIT_L(0); PG8_MMA(0, 1, At, B1); PG8_BAR;
            PG8_LDA(At, 1, 1); PG8_STAGE(PG8_SA(1, 0), a3, voffA);
            PG8_BAR; PG8_WAIT_L(0); PG8_MMA(1, 0, At, B0); PG8_BAR; PG8_SCHED;
            PG8_STAGE(PG8_SB(1, 1), b3 + hstep, voffB);
            PG8_WAIT_V(6); PG8_BAR; PG8_MMA(1, 1, At, B1); PG8_BAR;
            }
        }
        if constexpr (ALIGN_EPI) { if (wr == 0) PG8_BAR; }
        if constexpr (!Epi::AFTER_DRAIN) { E(acc, cur, wr, wc, fr, fq); S.done(cur); }
        if (!has_next) break;
#pragma unroll
        for (int a = 0; a < 2; ++a)
#pragma unroll
            for (int b = 0; b < 2; ++b)
#pragma unroll
                for (int m = 0; m < 4; ++m)
#pragma unroll
                    for (int n = 0; n < 2; ++n) acc[a][b][m][n] = (f32x4){0.f, 0.f, 0.f, 0.f};
        cur = nxt; cA = nA; cB = nB; ++ui;
        if constexpr (ALIGN_EPI) { if (wr == 1) PG8_BAR; }
    }
    PG8_WAIT_V(0);
    if constexpr (!ALIGN_EPI) { if (wr == 0) PG8_BAR; }
    PG8_BAR;
    if constexpr (Epi::AFTER_DRAIN) { E.fused(acc, cur, wr, wc, fr, fq, lds, wid, lane); S.done(cur); }
#undef PG8_SA
#undef PG8_SB
#undef PG8_STAGE
#undef PG8_LDA
#undef PG8_LDB
#undef PG8_MMA
#undef PG8_WAIT_V
#undef PG8_WAIT_L
#undef PG8_BAR
#undef PG8_SCHED
}
}


typedef unsigned u32x4 __attribute__((ext_vector_type(4)));
typedef float f32x2_t __attribute__((ext_vector_type(2))); typedef __bf16 bf16x2_t __attribute__((ext_vector_type(2)));
__device__ __forceinline__ unsigned cvtpk(float lo, float hi) { f32x2_t v = {lo, hi}; bf16x2_t b = __builtin_convertvector(v, bf16x2_t); return __builtin_bit_cast(unsigned, b); }
__device__ __forceinline__ u32x4 pack8(const f32x4& a, const f32x4& b) { u32x4 w; w.x = cvtpk(a[0], a[1]); w.y = cvtpk(a[2], a[3]); w.z = cvtpk(b[0], b[1]); w.w = cvtpk(b[2], b[3]); return w; }
__device__ __forceinline__ void unpack8(const u32x4& w, f32x4& a, f32x4& b) {
    a[0] = __uint_as_float(w.x << 16); a[1] = __uint_as_float(w.x & 0xffff0000u); a[2] = __uint_as_float(w.y << 16); a[3] = __uint_as_float(w.y & 0xffff0000u);
    b[0] = __uint_as_float(w.z << 16); b[1] = __uint_as_float(w.z & 0xffff0000u); b[2] = __uint_as_float(w.w << 16); b[3] = __uint_as_float(w.w & 0xffff0000u); }
typedef const f32x4 (&AccT)[2][2][4][2];
#define EPI_ROWS for (int ai = 0; ai < 2; ++ai) _Pragma("unroll") for (int m = 0; m < 4; ++m)

struct FEpiRetQKV { static constexpr bool PERM = true, AFTER_DRAIN = false; bf16_t *QR, *KR, *VR; const float* TAB;
    __device__ __forceinline__ void operator()(AccT acc, const pg8::Unit& u, int wr, int wc, int fr, int fq) const {
        const int row0 = u.pm * 256 + wr * 64 + fr, j0 = wc * 32 + 8 * fq;
        if (u.pn < 8) {
            const bool isq = u.pn < 4; const int h = u.pn & 3;
            if (isq && u.pm >= ML / 256) return;
            bf16_t* dst = (isq ? QR : KR) + h * 256 + j0; const float sc = isq ? 1.f : 0.0625f;
#pragma unroll
            EPI_ROWS { const int row = row0 + ai * 128 + m * 16;
                f32x4 c0 = {1.f, 1.f, 1.f, 1.f}, c1 = c0, s0 = {0.f, 0.f, 0.f, 0.f}, s1 = s0;
                if (row < ML) { const int t = row & (SEQ - 1), p = (j0 < 64) ? (t >> 6) : (t & 63); const float* tp = TAB + p * 64 + (j0 & 63);
                    c0 = *(const f32x4*)tp; c1 = *(const f32x4*)(tp + 4); s0 = *(const f32x4*)(tp + 4096); s1 = *(const f32x4*)(tp + 4100); }
                const f32x4 x1a = acc[ai][0][m][0], x1b = acc[ai][0][m][1], x2a = acc[ai][1][m][0], x2b = acc[ai][1][m][1];
                const f32x4 o1a = (x1a * c0 - x2a * s0) * sc, o1b = (x1b * c1 - x2b * s1) * sc, o2a = (x2a * c0 + x1a * s0) * sc, o2b = (x2b * c1 + x1b * s1) * sc;
                bf16_t* rp = dst + (size_t)row * 1024; *(u32x4*)rp = pack8(o1a, o1b); *(u32x4*)(rp + 128) = pack8(o2a, o2b); }
        } else {
            bf16_t* dst = VR + (u.pn - 8) * 256 + j0;
#pragma unroll
            EPI_ROWS { bf16_t* rp = dst + (size_t)(row0 + ai * 128 + m * 16) * 2048; *(u32x4*)rp = pack8(acc[ai][0][m][0], acc[ai][0][m][1]); *(u32x4*)(rp + 128) = pack8(acc[ai][1][m][0], acc[ai][1][m][1]); }
        }
    } };
constexpr float QSCALE = 0.125f;
struct FEpiDifQKV { static constexpr bool PERM = true, AFTER_DRAIN = false; bf16_t *QD, *KD, *VD; const float* TAB;
    __device__ __forceinline__ void operator()(AccT acc, const pg8::Unit& u, int wr, int wc, int fr, int fq) const {
        const int row0 = u.pm * 256 + wr * 64 + fr, j0 = wc * 32 + 8 * fq;
        if (u.pn < 8) {
            const bool isq = u.pn < 4; const int tl = u.pn & 3;
            if (isq && u.pm >= ML / 256) return;
            const int dd0 = 8 * fq;
            bf16_t* dst = (isq ? QD : KD) + tl * 256 + wc * 64 + dd0; const float sc = isq ? QSCALE : 1.f;
#pragma unroll
            EPI_ROWS { const int row = row0 + ai * 128 + m * 16;
                f32x4 c0 = {1.f, 1.f, 1.f, 1.f}, c1 = c0, s0 = {0.f, 0.f, 0.f, 0.f}, s1 = s0;
                if (row < ML) { const int t = row & (SEQ - 1), p = (dd0 < 16) ? (t >> 6) : (t & 63); const float* tp = TAB + 8192 + p * 16 + (dd0 & 15);
                    c0 = *(const f32x4*)tp; c1 = *(const f32x4*)(tp + 4); s0 = *(const f32x4*)(tp + 1024); s1 = *(const f32x4*)(tp + 1028); }
                const f32x4 x1a = acc[ai][0][m][0], x1b = acc[ai][0][m][1], x2a = acc[ai][1][m][0], x2b = acc[ai][1][m][1];
                const f32x4 o1a = (x1a * c0 - x2a * s0) * sc, o1b = (x1b * c1 - x2b * s1) * sc, o2a = (x2a * c0 + x1a * s0) * sc, o2b = (x2b * c1 + x1b * s1) * sc;
                bf16_t* rp = dst + (size_t)row * 1024; *(u32x4*)rp = pack8(o1a, o1b); *(u32x4*)(rp + 32) = pack8(o2a, o2b); }
        } else {
            bf16_t* dst = VD + (u.pn - 8) * 256 + j0;
#pragma unroll
            EPI_ROWS { bf16_t* rp = dst + (size_t)(row0 + ai * 128 + m * 16) * 1024; *(u32x4*)rp = pack8(acc[ai][0][m][0], acc[ai][0][m][1]); *(u32x4*)(rp + 128) = pack8(acc[ai][1][m][0], acc[ai][1][m][1]); }
        }
    } };
__device__ __forceinline__ f32x4 silu4(const f32x4& v) { f32x4 r; r[0] = siluf(v[0]); r[1] = siluf(v[1]); r[2] = siluf(v[2]); r[3] = siluf(v[3]); return r; }
__device__ __forceinline__ f32x4 sigm4(const f32x4& v) { f32x4 r; r[0] = sigmf(v[0]); r[1] = sigmf(v[1]); r[2] = sigmf(v[2]); r[3] = sigmf(v[3]); return r; }
struct FEpiGr { static constexpr bool PERM = true, AFTER_DRAIN = false; bf16_t* YR; const float* RS;
    __device__ __forceinline__ void operator()(AccT acc, const pg8::Unit& u, int wr, int wc, int fr, int fq) const {
        const int row0 = u.pm * 256 + wr * 64 + fr, j0 = wc * 32 + 8 * fq, h = u.pn >> 1;
#pragma unroll
        EPI_ROWS { const int row = row0 + ai * 128 + m * 16; const float mu = RS[(row * 4 + h) * 2], rs = RS[(row * 4 + h) * 2 + 1];
            bf16_t* rp = YR + (size_t)row * 2048 + u.pn * 256 + j0;
#pragma unroll
            for (int bj = 0; bj < 2; ++bj) { f32x4 ya, yb; unpack8(*(const u32x4*)(rp + bj * 128), ya, yb);
                *(u32x4*)(rp + bj * 128) = pack8(silu4(acc[ai][bj][m][0]) * ((ya - mu) * rs), silu4(acc[ai][bj][m][1]) * ((yb - mu) * rs)); } }
    } };
struct FEpiGate { static constexpr bool PERM = true, AFTER_DRAIN = false; bf16_t* SG; const float* bg;
    __device__ __forceinline__ void operator()(AccT acc, const pg8::Unit& u, int wr, int wc, int fr, int fq) const {
        const int row0 = u.pm * 256 + wr * 64 + fr, c0 = u.pn * 256 + wc * 32 + 8 * fq;
        f32x4 bv[2][2];
#pragma unroll
        for (int bj = 0; bj < 2; ++bj) { bv[bj][0] = *(const f32x4*)(bg + c0 + bj * 128); bv[bj][1] = *(const f32x4*)(bg + c0 + bj * 128 + 4); }
#pragma unroll
        EPI_ROWS { bf16_t* rp = SG + (size_t)(row0 + ai * 128 + m * 16) * 2048 + c0;
#pragma unroll
            for (int bj = 0; bj < 2; ++bj) *(u32x4*)(rp + bj * 128) = pack8(sigm4(acc[ai][bj][m][0] + bv[bj][0]), sigm4(acc[ai][bj][m][1] + bv[bj][1])); }
    } };
struct FEpiMr { static constexpr bool PERM = true, AFTER_DRAIN = false; float* MR; const bf16_t* SG;
    __device__ __forceinline__ void operator()(AccT acc, const pg8::Unit& u, int wr, int wc, int fr, int fq) const {
        const int row0 = u.pm * 256 + wr * 64 + fr, c0 = u.pn * 256 + wc * 32 + 8 * fq;
#pragma unroll
        EPI_ROWS { const int row = row0 + ai * 128 + m * 16;
#pragma unroll
            for (int bj = 0; bj < 2; ++bj) { f32x4 ga, gb; unpack8(*(const u32x4*)(SG + (size_t)row * 2048 + c0 + bj * 128), ga, gb);
                float* op = MR + (size_t)row * 1024 + c0 + bj * 128; *(f32x4*)op = ga * acc[ai][bj][m][0]; *(f32x4*)(op + 4) = gb * acc[ai][bj][m][1]; } }
    } };
struct FEpiMb { static constexpr bool PERM = true, AFTER_DRAIN = false; bf16_t* MB; const float* MR; const bf16_t* SG;
    __device__ __forceinline__ void operator()(AccT acc, const pg8::Unit& u, int wr, int wc, int fr, int fq) const {
        const int row0 = u.pm * 256 + wr * 64 + fr, c0 = u.pn * 256 + wc * 32 + 8 * fq;
#pragma unroll
        EPI_ROWS { const int row = row0 + ai * 128 + m * 16;
#pragma unroll
            for (int bj = 0; bj < 2; ++bj) { f32x4 ga, gb; unpack8(*(const u32x4*)(SG + (size_t)row * 2048 + 1024 + c0 + bj * 128), ga, gb);
                const float* ip = MR + (size_t)row * 1024 + c0 + bj * 128;
                *(u32x4*)(MB + (size_t)row * 1024 + c0 + bj * 128) = pack8(*(const f32x4*)ip + ga * acc[ai][bj][m][0], *(const f32x4*)(ip + 4) + gb * acc[ai][bj][m][1]); } }
    } };
struct FEpiZ1 { static constexpr bool PERM = true, AFTER_DRAIN = false; float* Z; const float* x; const float* STATS; const float* g; const float* b; const float* MOD;
    __device__ __forceinline__ void operator()(AccT acc, const pg8::Unit& u, int wr, int wc, int fr, int fq) const {
        const int row0 = u.pm * 256 + wr * 64 + fr, c0 = u.pn * 256 + wc * 32 + 8 * fq;
        const float* g1 = MOD + (u.pm / (SEQ / 256)) * 6144 + 2048;
#pragma unroll
        for (int bj = 0; bj < 2; ++bj)
#pragma unroll
            for (int n = 0; n < 2; ++n) { const int c = c0 + bj * 128 + n * 4; const f32x4 gg = *(const f32x4*)(g + c), bb = *(const f32x4*)(b + c), gm = *(const f32x4*)(g1 + c);
#pragma unroll
                EPI_ROWS { const int row = row0 + ai * 128 + m * 16; const float mu = STATS[row * 2], rs = STATS[row * 2 + 1];
                    const f32x4 xv = *(const f32x4*)(x + (size_t)row * 1024 + c); const f32x4 xn = (xv - mu) * rs * gg + bb;
                    *(f32x4*)(Z + (size_t)row * 1024 + c) = xn * ALPHA + gm * acc[ai][bj][m][n]; } }
    } };
struct FEpiUG { static constexpr bool PERM = true, AFTER_DRAIN = false; bf16_t* UG;
    __device__ __forceinline__ void operator()(AccT acc, const pg8::Unit& u, int wr, int wc, int fr, int fq) const {
        const int row0 = u.pm * 256 + wr * 64 + fr, c0 = u.pn * 256 + wc * 32 + 8 * fq;
#pragma unroll
        EPI_ROWS { bf16_t* rp = UG + (size_t)(row0 + ai * 128 + m * 16) * 5632 + c0; *(u32x4*)rp = pack8(acc[ai][0][m][0], acc[ai][0][m][1]); *(u32x4*)(rp + 128) = pack8(acc[ai][1][m][0], acc[ai][1][m][1]); }
    } };
struct FEpiZ2 { static constexpr bool PERM = true, AFTER_DRAIN = false; float* Z; const float* MOD;
    __device__ __forceinline__ void operator()(AccT acc, const pg8::Unit& u, int wr, int wc, int fr, int fq) const {
        const int row0 = u.pm * 256 + wr * 64 + fr, c0 = u.pn * 256 + wc * 32 + 8 * fq;
        const float* g2 = MOD + (u.pm / (SEQ / 256)) * 6144 + 5120;
#pragma unroll
        for (int bj = 0; bj < 2; ++bj)
#pragma unroll
            for (int n = 0; n < 2; ++n) { const int c = c0 + bj * 128 + n * 4; const f32x4 gm = *(const f32x4*)(g2 + c);
#pragma unroll
                EPI_ROWS { float* zp = Z + (size_t)(row0 + ai * 128 + m * 16) * 1024 + c; *(f32x4*)zp = *(const f32x4*)zp * ALPHA + gm * acc[ai][bj][m][n]; } }
    } };
template <class Epi> __device__ __forceinline__ void fast_gemm(unsigned char* lds, const bf16_t* A, const bf16_t* Bt, int M, int N, int K, const Epi& E) {
    pg8::Gemm g{A, Bt, M, N, K}; pg8::StaticOrder S; S.init(M, N, (int)gridDim.x, (int)blockIdx.x);
    pg8::gemm_phase<Epi, pg8::StaticOrder, true, true>((PG8_LAS unsigned char*)lds, g, S, E);
    __syncthreads();
}

namespace fa {
using bf16x8 = __attribute__((ext_vector_type(8))) short;
using s16x4  = __attribute__((ext_vector_type(4))) short;
using f32x16 = __attribute__((ext_vector_type(16))) float;
using u32x4  = __attribute__((ext_vector_type(4))) unsigned;
constexpr int NW = 8, QBLK = 32, KVBLK = 64, LD = 1024, NT = 68;
constexpr float THR = 8.f;
constexpr int SHM_V = KVBLK * 128 * 2, SHM_K = KVBLK * 64 * 2;
constexpr int OFF_K = 2 * SHM_V, OFF_WS = OFF_K + 2 * SHM_K, OFF_OST = OFF_WS + NW * 64 * 4, SHM_ATTN = OFF_OST + NW * 8192;
#define KSWZ64(row, colB) ((row) * 128 + ((colB) ^ ((((row) >> 1) & 7) << 4)))
#define SBAR() __builtin_amdgcn_sched_barrier(0)
__device__ __forceinline__ int crow(int r, int hi) { return (r & 3) + 8 * (r >> 2) + 4 * hi; }
__device__ __forceinline__ unsigned cvtpk(float lo, float hi) { unsigned r; asm volatile("v_cvt_pk_bf16_f32 %0, %1, %2" : "=v"(r) : "v"(lo), "v"(hi)); return r; }
__device__ __forceinline__ void partialSM(f32x16& p0, f32x16& p1, float& m_reg, float& mn, float& alpha) {
  constexpr float C = 1.4426950408889634f;
  float pmax = p0[0];
#pragma unroll
  for (int r = 1; r < 16; ++r) pmax = fmaxf(pmax, p0[r]);
#pragma unroll
  for (int r = 0; r < 16; ++r) pmax = fmaxf(pmax, p1[r]);
  { auto rr = __builtin_amdgcn_permlane32_swap(__float_as_uint(pmax), __float_as_uint(pmax), false, false);
    pmax = fmaxf(__uint_as_float(rr[0]), __uint_as_float(rr[1])); }
  if (__builtin_expect(__all(pmax - m_reg <= THR), 1)) { mn = m_reg; alpha = 1.f; }
  else { mn = fmaxf(m_reg, pmax); alpha = __builtin_amdgcn_exp2f((m_reg - mn) * C); m_reg = mn; }
  float mnC = -mn * C;
#pragma unroll
  for (int r = 0; r < 16; ++r) p0[r] = fmaf(p0[r], C, mnC);
#pragma unroll
  for (int r = 0; r < 16; ++r) p1[r] = fmaf(p1[r], C, mnC);
#pragma unroll
  for (int r = 0; r < 16; ++r) p0[r] = __builtin_amdgcn_exp2f(p0[r]);
}
__device__ __forceinline__ void finishSM(f32x16& p0, f32x16& p1, float alpha, float& l_reg, bf16x8& pa0, bf16x8& pa1, bf16x8& pa2, bf16x8& pa3) {
#pragma unroll
  for (int r = 0; r < 16; ++r) p1[r] = __builtin_amdgcn_exp2f(p1[r]);
  float ps = 0;
#pragma unroll
  for (int r = 0; r < 16; ++r) ps += p0[r];
#pragma unroll
  for (int r = 0; r < 16; ++r) ps += p1[r];
  { auto rr = __builtin_amdgcn_permlane32_swap(__float_as_uint(ps), __float_as_uint(ps), false, false);
    ps = __uint_as_float(rr[0]) + __uint_as_float(rr[1]); }
  l_reg = l_reg * alpha + ps;
#define PK4(P, BASE, OUT) do { unsigned a0 = cvtpk(P[BASE + 0], P[BASE + 1]), a1 = cvtpk(P[BASE + 2], P[BASE + 3]);   \
    unsigned b0 = cvtpk(P[BASE + 4], P[BASE + 5]), b1 = cvtpk(P[BASE + 6], P[BASE + 7]);                              \
    auto r0 = __builtin_amdgcn_permlane32_swap(a0, b0, false, false); auto r1 = __builtin_amdgcn_permlane32_swap(a1, b1, false, false); \
    u32x4 w = {r0[0], r1[0], r0[1], r1[1]}; OUT = *reinterpret_cast<bf16x8*>(&w); } while (0)
  PK4(p0, 0, pa0); PK4(p0, 8, pa1); PK4(p1, 0, pa2); PK4(p1, 8, pa3);
#undef PK4
}
__device__ __forceinline__ void qkt(f32x16& p0, f32x16& p1, const char* Ks, const bf16x8* qr, int r32, int hi) {
  p0 = f32x16{}; p1 = f32x16{};
#pragma unroll
  for (int d0 = 0; d0 < 4; ++d0) { const int cb = (d0 * 16 + hi * 8) * 2;
    bf16x8 b0 = *reinterpret_cast<const bf16x8*>(Ks + KSWZ64(r32, cb));
    bf16x8 b1 = *reinterpret_cast<const bf16x8*>(Ks + KSWZ64(32 + r32, cb));
    p0 = __builtin_amdgcn_mfma_f32_32x32x16_bf16(b0, qr[d0], p0, 0, 0, 0);
    p1 = __builtin_amdgcn_mfma_f32_32x32x16_bf16(b1, qr[d0], p1, 0, 0, 0); }
}
__device__ __forceinline__ int v_st(int k, int c) { const int kk = (k & ~0xC) | ((k & 4) << 1) | ((k & 8) >> 1); return ((kk >> 3) * 4 + (c >> 5)) * 512 + ((kk & 7) * 32 + (c & 31)) * 2; }
__device__ __forceinline__ int v_rd_base(int lane) { return ((lane & 3) << 3) | (((lane >> 2) & 3) << 6) | (((lane >> 4) & 1) << 5) | (((lane >> 5) & 1) << 8); }
constexpr int v_rd_off(int d0, int ks, int half) { return d0 * 512 + ks * 4096 + half * 2048; }
template <int OFF> __device__ __forceinline__ s16x4 tr_read(int vb) { s16x4 r; asm volatile("ds_read_b64_tr_b16 %0, %1 offset:%2" : "=&v"(r) : "v"(vb), "i"(OFF) : "memory"); return r; }
template <int D0> __device__ __forceinline__ void pv_one(f32x16& od, int vb, bf16x8 pa0, bf16x8 pa1, bf16x8 pa2, bf16x8 pa3) {
  const s16x4 l0 = tr_read<v_rd_off(D0, 0, 0)>(vb), h0 = tr_read<v_rd_off(D0, 0, 1)>(vb), l1 = tr_read<v_rd_off(D0, 1, 0)>(vb), h1 = tr_read<v_rd_off(D0, 1, 1)>(vb);
  const s16x4 l2 = tr_read<v_rd_off(D0, 2, 0)>(vb), h2 = tr_read<v_rd_off(D0, 2, 1)>(vb), l3 = tr_read<v_rd_off(D0, 3, 0)>(vb), h3 = tr_read<v_rd_off(D0, 3, 1)>(vb);
  asm volatile("s_waitcnt lgkmcnt(0)" ::: "memory"); SBAR();
#define PK(L, H) (bf16x8){L[0], L[1], L[2], L[3], H[0], H[1], H[2], H[3]}
  od = __builtin_amdgcn_mfma_f32_32x32x16_bf16(pa0, PK(l0, h0), od, 0, 0, 0);
  od = __builtin_amdgcn_mfma_f32_32x32x16_bf16(pa1, PK(l1, h1), od, 0, 0, 0);
  od = __builtin_amdgcn_mfma_f32_32x32x16_bf16(pa2, PK(l2, h2), od, 0, 0, 0);
  od = __builtin_amdgcn_mfma_f32_32x32x16_bf16(pa3, PK(l3, h3), od, 0, 0, 0);
#undef PK
}
__device__ __forceinline__ void pv_d0(f32x16* o, int vb, bf16x8 pa0, bf16x8 pa1, bf16x8 pa2, bf16x8 pa3) {
  pv_one<0>(o[0], vb, pa0, pa1, pa2, pa3); pv_one<1>(o[1], vb, pa0, pa1, pa2, pa3); pv_one<2>(o[2], vb, pa0, pa1, pa2, pa3); pv_one<3>(o[3], vb, pa0, pa1, pa2, pa3);
}

__device__ __forceinline__ void attn_unit(int b, int h, int qb, const bf16_t* __restrict__ QD, const bf16_t* __restrict__ KD, const bf16_t* __restrict__ VD, bf16_t* __restrict__ AD,
                                          float lam, const float* __restrict__ gsub, char* lds) {
  int tid_ = threadIdx.x; asm volatile("" : "+v"(tid_));
  const int tid = tid_, wid = tid >> 6, lane = tid & 63, r32 = lane & 31, hi = lane >> 5;
  char* V_lds = lds; char* K_lds = lds + OFF_K;
  float* ws = (float*)(lds + OFF_WS) + wid * 64; float* li_l = ws; float* al_l = ws + 32;
  char* ost = lds + OFF_OST + wid * 8192;
  const long qrow0 = (long)b * SEQ + qb * 256;
  const int sr = tid >> 4, sc = (tid & 15) * 8, vst0 = v_st(sr, sc);
  const int kr = tid >> 3, kc = (tid & 7) * 8, kst = KSWZ64(kr, kc * 2);
  const int koff = kr * LD + kc, voff = sr * LD + sc;
  const int vb0 = (int)(uintptr_t)V_lds + v_rd_base(lane);
#pragma unroll 1
  for (int c = 0; c < 2; ++c) {
    float m_reg = -1e30f, l_reg = 0; f32x16 o[4] = {}; bf16x8 qr[4];
    const bf16_t* Qw = QD + (qrow0 + wid * QBLK + r32) * LD + h * 128 + c * 64 + hi * 8;
#pragma unroll
    for (int d0 = 0; d0 < 4; ++d0) qr[d0] = *reinterpret_cast<const bf16x8*>(Qw + d0 * 16);
    const bf16_t* Kl = KD + (long)b * SEQ * LD + h * 128 + c * 64;
    const bf16_t* Kc = KD + ((long)ML + b * CTX) * LD + h * 128 + c * 64;
    const bf16_t* Vl = VD + (long)b * SEQ * LD + h * 128;
    const bf16_t* Vc = VD + ((long)ML + b * CTX) * LD + h * 128;
    constexpr int SDEPTH = 1;
    struct { bf16x8 vs0, vs1, ks; } sr_[SDEPTH];
#define SLOAD(i, j) do { const long to_ = ((j) < 64) ? (long)(j) * (64 * LD) : (long)((j) - 64) * (64 * LD); const bf16_t* kp_ = ((j) < 64 ? Kl : Kc) + to_; const bf16_t* vp_ = ((j) < 64 ? Vl : Vc) + to_; \
    sr_[i].vs0 = *reinterpret_cast<const bf16x8*>(vp_ + voff); sr_[i].vs1 = *reinterpret_cast<const bf16x8*>(vp_ + voff + 32 * LD); sr_[i].ks = *reinterpret_cast<const bf16x8*>(kp_ + koff); } while (0)
#define SWRITE(bb, i) do { *(bf16x8*)(V_lds + (bb) * SHM_V + vst0) = sr_[i].vs0; *(bf16x8*)(V_lds + (bb) * SHM_V + vst0 + 8192) = sr_[i].vs1; *(bf16x8*)(K_lds + (bb) * SHM_K + kst) = sr_[i].ks; } while (0)
#define SWAIT() do { if constexpr (SDEPTH == 2) asm volatile("s_waitcnt vmcnt(3)" ::: "memory"); else asm volatile("s_waitcnt vmcnt(0)" ::: "memory"); } while (0)
#define RESC(a) do { if (__any((a) < 1.f)) { if (hi == 0) al_l[r32] = (a); asm volatile("s_waitcnt lgkmcnt(0)" ::: "memory"); \
    _Pragma("unroll") for (int d = 0; d < 4; ++d) _Pragma("unroll") for (int r = 0; r < 16; ++r) o[d][r] *= al_l[crow(r, hi)]; } } while (0)
    f32x16 pA0, pA1, pB0, pB1; float mnA, mnB, alA, alB; bf16x8 pa0, pa1, pa2, pa3;
    constexpr int SE = 0, SO = SDEPTH - 1;
    SLOAD(SE, 0); asm volatile("s_waitcnt vmcnt(0)" ::: "memory"); SWRITE(0, SE); __syncthreads();
    qkt(pA0, pA1, K_lds, qr, r32, hi); partialSM(pA0, pA1, m_reg, mnA, alA);
    SLOAD(SO, 1); if constexpr (SDEPTH == 2) SLOAD(SE, 2);
    SWAIT(); SWRITE(1, SO); __syncthreads();
    for (int j = 1; j + 1 < NT; j += 2) {
      SBAR(); qkt(pB0, pB1, K_lds + SHM_K, qr, r32, hi);
      finishSM(pA0, pA1, alA, l_reg, pa0, pa1, pa2, pa3); SBAR();
      SLOAD(SO, j + SDEPTH); SBAR();
      pv_d0(o, vb0, pa0, pa1, pa2, pa3); partialSM(pB0, pB1, m_reg, mnB, alB);
      __syncthreads(); SWAIT(); SWRITE(0, SE);
      RESC(alB); __syncthreads();
      SBAR(); qkt(pA0, pA1, K_lds, qr, r32, hi);
      finishSM(pB0, pB1, alB, l_reg, pa0, pa1, pa2, pa3); SBAR();
      if (SDEPTH == 1 || j + 3 < NT) SLOAD(SE, j + 1 + SDEPTH); SBAR();
      pv_d0(o, vb0 + SHM_V, pa0, pa1, pa2, pa3); partialSM(pA0, pA1, m_reg, mnA, alA);
      __syncthreads(); SWAIT(); SWRITE(1, SO);
      RESC(alA); __syncthreads();
    }
    SBAR(); qkt(pB0, pB1, K_lds + SHM_K, qr, r32, hi);
    finishSM(pA0, pA1, alA, l_reg, pa0, pa1, pa2, pa3); SBAR();
    pv_d0(o, vb0, pa0, pa1, pa2, pa3); partialSM(pB0, pB1, m_reg, mnB, alB);
    __syncthreads(); RESC(alB);
    finishSM(pB0, pB1, alB, l_reg, pa0, pa1, pa2, pa3); SBAR();
    pv_d0(o, vb0 + SHM_V, pa0, pa1, pa2, pa3);
#undef SLOAD
#undef SWRITE
#undef SWAIT
#undef RESC
    if (hi == 0) li_l[r32] = l_reg; asm volatile("s_waitcnt lgkmcnt(0)" ::: "memory");
    float rli[16];
#pragma unroll
    for (int r = 0; r < 16; ++r) rli[r] = __builtin_amdgcn_rcpf(li_l[crow(r, hi)]);
    unsigned* pst = (unsigned*)ost;
    if (c == 0) {
#pragma unroll
      for (int d0 = 0; d0 < 4; ++d0)
#pragma unroll
        for (int rp = 0; rp < 8; ++rp) pst[(d0 * 8 + rp) * 64 + lane] = cvtpk(o[d0][2 * rp] * rli[2 * rp], o[d0][2 * rp + 1] * rli[2 * rp + 1]);
    } else {
#pragma unroll
      for (int d0 = 0; d0 < 4; ++d0)
#pragma unroll
        for (int rp = 0; rp < 8; ++rp) { const unsigned w = pst[(d0 * 8 + rp) * 64 + lane];
          o[d0][2 * rp] = __uint_as_float(w << 16) - lam * (o[d0][2 * rp] * rli[2 * rp]); o[d0][2 * rp + 1] = __uint_as_float(w & 0xffff0000u) - lam * (o[d0][2 * rp + 1] * rli[2 * rp + 1]); }
      asm volatile("s_waitcnt lgkmcnt(0)" ::: "memory");
      float* stf = (float*)ost;
      const int ch = lane & 15, rq = lane >> 4;
      f32x4 g0 = *(const f32x4*)(gsub + ch * 8), g1 = *(const f32x4*)(gsub + ch * 8 + 4); g0 = g0 * (1.f - LAM_INIT); g1 = g1 * (1.f - LAM_INIT);
#pragma unroll
      for (int rh = 0; rh < 2; ++rh) {
#pragma unroll
        for (int rr = 0; rr < 8; ++rr) { const int lr = (rr & 3) + 8 * (rr >> 2) + 4 * hi;
#pragma unroll
          for (int d0 = 0; d0 < 4; ++d0) stf[lr * 128 + d0 * 32 + r32] = o[d0][rh * 8 + rr]; }
        asm volatile("s_waitcnt lgkmcnt(0)" ::: "memory");
#pragma unroll
        for (int i = 0; i < 4; ++i) { const int row = i * 4 + rq;
          f32x4 v0 = *(const f32x4*)(stf + row * 128 + ch * 8), v1 = *(const f32x4*)(stf + row * 128 + ch * 8 + 4);
          float ss = (v0[0] * v0[0] + v0[1] * v0[1]) + (v0[2] * v0[2] + v0[3] * v0[3]) + (v1[0] * v1[0] + v1[1] * v1[1]) + (v1[2] * v1[2] + v1[3] * v1[3]);
          ss += __shfl_xor(ss, 1); ss += __shfl_xor(ss, 2); ss += __shfl_xor(ss, 4); ss += __shfl_xor(ss, 8);
          const float rs = 1.f / sqrtf(ss * (1.f / 128.f) + LN_EPS);
          v0 = v0 * rs * g0; v1 = v1 * rs * g1;
          u32x4 w; w.x = cvtpk(v0[0], v0[1]); w.y = cvtpk(v0[2], v0[3]); w.z = cvtpk(v1[0], v1[1]); w.w = cvtpk(v1[2], v1[3]);
          *(u32x4*)(AD + (qrow0 + wid * QBLK + rh * 16 + row) * LD + h * 128 + ch * 8) = w; }
        asm volatile("s_waitcnt lgkmcnt(0)" ::: "memory");
      }
    }
    __syncthreads();
  }
}
#undef KSWZ64
#undef SBAR
}
__device__ __forceinline__ void d_attn_fast(const Ctx& C, const bf16_t* __restrict__ QD, const bf16_t* __restrict__ KD, const bf16_t* __restrict__ VD, bf16_t* __restrict__ AD,
                                            const float* __restrict__ SCAL, const float* __restrict__ gsub) {
  const float lam = SCAL[0];
  const int vcu = (C.G % 8 == 0) ? (C.bx % 8) * (C.G / 8) + C.bx / 8 : C.bx;
  for (int i = 0; (long)i * C.G + vcu < 1024; ++i) {
    int bh, qb;
    if (C.G == 256) { bh = (vcu >> 5) * 8 + i * 2 + ((vcu & 31) >> 4); qb = vcu & 15; }
    else { const int L = i * C.G + vcu; bh = L >> 4; qb = L & 15; }
    fa::attn_unit(bh >> 3, bh & 7, qb, QD, KD, VD, AD, lam, gsub, (char*)C.lds);
  }
}

namespace rt {
typedef __attribute__((address_space(3))) unsigned char* lptr;
typedef short v4i16_t __attribute__((ext_vector_type(4)));
typedef unsigned u32x2 __attribute__((ext_vector_type(2)));
constexpr int RSQ = 544, RSV = 160;
constexpr int O_Q = 0, O_K = 64 * RSQ, O_ST = 2 * 64 * RSQ, O_V = 3 * 64 * RSQ, O_VP = O_V + 64 * RSV, O_P = O_VP + 64 * RSV, O_END = O_P + 64 * RSV;
constexpr int NSTEP = 68;
__device__ __forceinline__ bf16x8 ld128(lptr p) { return *(const __attribute__((address_space(3))) bf16x8*)p; }
__device__ __forceinline__ bf16x8 trfrag(lptr lo, lptr hi) {
    const v4i16_t a = __builtin_amdgcn_ds_read_tr16_b64_v4i16((__attribute__((address_space(3))) v4i16_t*)lo), b = __builtin_amdgcn_ds_read_tr16_b64_v4i16((__attribute__((address_space(3))) v4i16_t*)hi);
    return (bf16x8){a[0], a[1], a[2], a[3], b[0], b[1], b[2], b[3]}; }
__device__ __forceinline__ u32x2 pack4(const f32x4& v) { u32x2 w; w.x = cvtpk(v[0], v[1]); w.y = cvtpk(v[2], v[3]); return w; }
#define MFMA16(a, b, c) __builtin_amdgcn_mfma_f32_16x16x32_bf16((a), (b), (c), 0, 0, 0)

__device__ __forceinline__ void ret_stream(int b, int h, int vs, const bf16_t* __restrict__ QR, const bf16_t* __restrict__ KR, const bf16_t* __restrict__ VR, bf16_t* __restrict__ YR,
                                           const float* __restrict__ SCAL, unsigned char* lds_) {
    int tid_ = threadIdx.x; asm volatile("" : "+v"(tid_));
    const int tid = tid_, w = __builtin_amdgcn_readfirstlane(tid >> 6), lane = tid & 63, fr = lane & 15, fq = lane >> 4;
    const lptr lds = (lptr)lds_;
    const float L2E = 1.4426950408889634f, lgf2 = SCAL[1 + h] * L2E, lgb2 = SCAL[5 + h] * L2E;
    const int ct = w & 3, it0 = 2 * (w >> 2), jt = w & 3;
    const int qrow = tid >> 5, qch = tid & 31, vrow = tid >> 3, vch = tid & 7;
    const int li4 = (fr >> 2), lip = (fr & 3);
    const lptr pS = lds + O_ST + (16 * ct + fr) * RSQ + 16 * fq;
    const lptr pQ0 = lds + O_Q + (16 * it0 + fr) * RSQ + 16 * fq, pQ1 = pQ0 + 16 * RSQ;
    const lptr pK = lds + O_K + (16 * jt + fr) * RSQ + 16 * fq;
    const lptr pPw = lds + O_P + (16 * it0 + fr) * RSV + (16 * jt + 4 * fq) * 2;
    const lptr pPr = lds + O_P + (16 * it0 + fr) * RSV + (4 * fq) * 2;
    const lptr pVt = lds + O_V + (4 * fq + li4) * RSV + (16 * ct + 4 * lip) * 2;
    const lptr pKt = lds + O_K + (4 * fq + li4) * RSQ + (32 * w + 4 * lip) * 2;
    const lptr pVPt = lds + O_VP + (4 * fq + li4) * RSV + (4 * lip) * 2;
    const lptr pSTw = lds + O_ST + fr * RSQ + (32 * w + 4 * fq) * 2;
#pragma unroll 1
    for (int pass = 0; pass < 2; ++pass) {
        const float lg2 = pass ? lgb2 : lgf2, ds = __builtin_amdgcn_exp2f(lg2 * 64.f);
        const float dkv = __builtin_amdgcn_exp2f(lg2 * (pass ? (float)vrow : (float)(63 - vrow)));
        float dq[2], msk[2][4];
#pragma unroll
        for (int t = 0; t < 2; ++t) { const int i = 16 * (it0 + t) + fr; dq[t] = __builtin_amdgcn_exp2f(lg2 * (pass ? (float)(64 - i) : (float)(i + 1)));
#pragma unroll
            for (int r = 0; r < 4; ++r) { const int j = 16 * jt + 4 * fq + r, dd = i - j; msk[t][r] = dd > 0 ? __builtin_amdgcn_exp2f(lgf2 * (float)dd) : (dd < 0 ? __builtin_amdgcn_exp2f(lgb2 * (float)(-dd)) : 2.f); } }
        f32x4 S[2][4];
#pragma unroll
        for (int dt = 0; dt < 2; ++dt)
#pragma unroll
            for (int c4 = 0; c4 < 4; ++c4) S[dt][c4] = (f32x4){0.f, 0.f, 0.f, 0.f};
        bf16x8 stq[4], stk[4], stv;
#define RT_ROWBASE(step, rb, lat) do { if ((step) < 4) { const int cc_ = pass ? 3 - (step) : (step); rb = ML + b * CTX + cc_ * 64; lat = false; } \
            else { const int n_ = pass ? (NSTEP - 1) - (step) : (step) - 4; rb = b * SEQ + n_ * 64; lat = true; } } while (0)
#define RT_LOAD(step) do { int rb_; bool lat_; RT_ROWBASE(step, rb_, lat_); \
            _Pragma("unroll") for (int k = 0; k < 4; ++k) { stk[k] = *(const bf16x8*)(KR + (size_t)(rb_ + qrow + 16 * k) * 1024 + h * 256 + qch * 8); \
                if (lat_) stq[k] = *(const bf16x8*)(QR + (size_t)(rb_ + qrow + 16 * k) * 1024 + h * 256 + qch * 8); } \
            stv = *(const bf16x8*)(VR + (size_t)(rb_ + vrow) * 2048 + h * 512 + vs * 64 + vch * 8); } while (0)
#define RT_WRITE(step) do { int rb_; bool lat_; RT_ROWBASE(step, rb_, lat_); (void)rb_; \
            _Pragma("unroll") for (int k = 0; k < 4; ++k) { *(__attribute__((address_space(3))) bf16x8*)(lds + O_K + (qrow + 16 * k) * RSQ + qch * 16) = stk[k]; \
                if (lat_) *(__attribute__((address_space(3))) bf16x8*)(lds + O_Q + (qrow + 16 * k) * RSQ + qch * 16) = stq[k]; } \
            *(__attribute__((address_space(3))) bf16x8*)(lds + O_V + vrow * RSV + vch * 16) = stv; \
            { f32x4 a_, b_; unpack8(__builtin_bit_cast(u32x4, stv), a_, b_); a_ = a_ * dkv; b_ = b_ * dkv; const u32x4 w_ = pack8(a_, b_); \
              *(__attribute__((address_space(3))) u32x4*)(lds + O_VP + vrow * RSV + vch * 16) = w_; } } while (0)
        RT_LOAD(0); RT_WRITE(0);
#pragma unroll 1
        for (int step = 0; step < NSTEP; ++step) {
            int rowbase; bool lat; RT_ROWBASE(step, rowbase, lat);
            __syncthreads();
            if (step + 1 < NSTEP) RT_LOAD(step + 1);
            if (lat) {
                bf16_t* yp0 = YR + (size_t)(rowbase + 16 * it0 + fr) * 2048 + h * 512 + vs * 64 + 16 * ct + 4 * fq; bf16_t* yp1 = yp0 + (size_t)16 * 2048;
                u32x2 yo0 = {0u, 0u}, yo1 = {0u, 0u};
                if (pass) { yo0 = *(const u32x2*)yp0; yo1 = *(const u32x2*)yp1; }
                f32x4 ay0 = {0.f, 0.f, 0.f, 0.f}, ay1 = ay0, ap0 = ay0, ap1 = ay0;
#pragma unroll
                for (int ks = 0; ks < 8; ++ks) {
                    const bf16x8 as = ld128(pS + 64 * ks), q0 = ld128(pQ0 + 64 * ks), q1 = ld128(pQ1 + 64 * ks);
                    ay0 = MFMA16(as, q0, ay0); ay1 = MFMA16(as, q1, ay1);
                    if (pass == 0) { const bf16x8 ak = ld128(pK + 64 * ks); ap0 = MFMA16(ak, q0, ap0); ap1 = MFMA16(ak, q1, ap1); }
                }
                ay0 = ay0 * dq[0]; ay1 = ay1 * dq[1];
                if (pass == 0) {
#pragma unroll
                    for (int r = 0; r < 4; ++r) { ap0[r] *= msk[0][r]; ap1[r] *= msk[1][r]; }
                    *(__attribute__((address_space(3))) u32x2*)(pPw) = pack4(ap0); *(__attribute__((address_space(3))) u32x2*)(pPw + 16 * RSV) = pack4(ap1);
                    __syncthreads();
#pragma unroll
                    for (int ks = 0; ks < 2; ++ks) {
                        const bf16x8 av = trfrag(pVt + ks * 32 * RSV, pVt + ks * 32 * RSV + 16 * RSV);
                        const u32x2 l0 = *(const __attribute__((address_space(3))) u32x2*)(pPr + ks * 64), h0 = *(const __attribute__((address_space(3))) u32x2*)(pPr + ks * 64 + 32);
                        const u32x2 l1 = *(const __attribute__((address_space(3))) u32x2*)(pPr + 16 * RSV + ks * 64), h1 = *(const __attribute__((address_space(3))) u32x2*)(pPr + 16 * RSV + ks * 64 + 32);
                        const u32x4 b0 = {l0.x, l0.y, h0.x, h0.y}, b1 = {l1.x, l1.y, h1.x, h1.y};
                        ay0 = MFMA16(av, __builtin_bit_cast(bf16x8, b0), ay0); ay1 = MFMA16(av, __builtin_bit_cast(bf16x8, b1), ay1);
                    }
                    *(u32x2*)yp0 = pack4(ay0); *(u32x2*)yp1 = pack4(ay1);
                } else {
                    f32x4 o0, o1;
                    o0[0] = __uint_as_float(yo0.x << 16); o0[1] = __uint_as_float(yo0.x & 0xffff0000u); o0[2] = __uint_as_float(yo0.y << 16); o0[3] = __uint_as_float(yo0.y & 0xffff0000u);
                    o1[0] = __uint_as_float(yo1.x << 16); o1[1] = __uint_as_float(yo1.x & 0xffff0000u); o1[2] = __uint_as_float(yo1.y << 16); o1[3] = __uint_as_float(yo1.y & 0xffff0000u);
                    *(u32x2*)yp0 = pack4(ay0 + o0); *(u32x2*)yp1 = pack4(ay1 + o1);
                }
            }
#pragma unroll
            for (int dt = 0; dt < 2; ++dt)
#pragma unroll
                for (int c4 = 0; c4 < 4; ++c4) S[dt][c4] = S[dt][c4] * ds;
#pragma unroll
            for (int ks = 0; ks < 2; ++ks) {
                bf16x8 ak[2], bv[4];
#pragma unroll
                for (int dt = 0; dt < 2; ++dt) ak[dt] = trfrag(pKt + dt * 32 + ks * 32 * RSQ, pKt + dt * 32 + ks * 32 * RSQ + 16 * RSQ);
#pragma unroll
                for (int c4 = 0; c4 < 4; ++c4) bv[c4] = trfrag(pVPt + c4 * 32 + ks * 32 * RSV, pVPt + c4 * 32 + ks * 32 * RSV + 16 * RSV);
#pragma unroll
                for (int dt = 0; dt < 2; ++dt)
#pragma unroll
                    for (int c4 = 0; c4 < 4; ++c4) S[dt][c4] = MFMA16(ak[dt], bv[c4], S[dt][c4]);
            }
            __syncthreads();
#pragma unroll
            for (int dt = 0; dt < 2; ++dt)
#pragma unroll
                for (int c4 = 0; c4 < 4; ++c4) *(__attribute__((address_space(3))) u32x2*)(pSTw + c4 * 16 * RSQ + dt * 32) = pack4(S[dt][c4]);
            if (step + 1 < NSTEP) RT_WRITE(step + 1);
        }
        __syncthreads();
#undef RT_ROWBASE
#undef RT_LOAD
#undef RT_WRITE
    }
}
#undef MFMA16
}
__device__ __forceinline__ void d_ret_fast(const Ctx& C, const bf16_t* __restrict__ QR, const bf16_t* __restrict__ KR, const bf16_t* __restrict__ VR, bf16_t* __restrict__ YR, const float* __restrict__ SCAL) {
    for (int sid = C.bx; sid < 256; sid += C.G) rt::ret_stream(sid >> 5, (sid >> 3) & 3, sid & 7, QR, KR, VR, YR, SCAL, C.lds);
}

constexpr int LDS_BYTES = 147456;
struct Params { const float* in[24]; float* out; unsigned char* ws; };
__global__ void __launch_bounds__(512, 2) mega(Params P) {
    extern __shared__ __attribute__((aligned(16))) unsigned char lds[];
    cg::grid_group grid = cg::this_grid();
#define CTX() Ctx C; { int t_ = threadIdx.x; asm volatile("" : "+v"(t_)); C.tid = t_; C.lane = C.tid & 63; C.wave = C.tid >> 6; C.bx = blockIdx.x; C.G = gridDim.x; \
    C.gw = C.bx * 8 + C.wave; C.NGW = C.G * 8; C.gt = C.bx * 512 + C.tid; C.NGT = C.G * 512; C.lds = lds; }
    const float* x = P.in[0]; const float* c = P.in[1]; const float* ctx = P.in[2]; const float* cctx = P.in[3];
    const float* lng = P.in[4]; const float* lnb = P.in[5]; const float* wmod = P.in[6]; const float* bmod = P.in[7];
    const float* win = P.in[8]; const float* bgate = P.in[9]; const float* logit = P.in[10]; const float* dlam = P.in[11];
    const float* gsub = P.in[12]; const float* wret = P.in[13]; const float* wdif = P.in[14]; const float* wo = P.in[15];
    const float* ln1g = P.in[16]; const float* ln1b = P.in[17]; const float* wup = P.in[18]; const float* cw = P.in[19];
    const float* cb = P.in[20]; const float* wdn = P.in[21]; const float* ln2g = P.in[22]; const float* ln2b = P.in[23];
    unsigned char* ws = P.ws; float* out = P.out;
    float* MOD = (float*)(ws + WS_MOD); float* TAB = (float*)(ws + WS_TAB); float* SCAL = (float*)(ws + WS_SCAL); float* STATS = (float*)(ws + WS_STATS); float* RS = (float*)(ws + WS_RS);
    bf16_t* WIN = (bf16_t*)(ws + WS_WIN); bf16_t* WRET = (bf16_t*)(ws + WS_WRET); bf16_t* WDIF = (bf16_t*)(ws + WS_WDIF); bf16_t* WO = (bf16_t*)(ws + WS_WO);
    bf16_t* WUP = (bf16_t*)(ws + WS_WUP); bf16_t* WDN = (bf16_t*)(ws + WS_WDN); bf16_t* XM = (bf16_t*)(ws + WS_XM);
    bf16_t* QR = (bf16_t*)(ws + WS_QR); bf16_t* KR = (bf16_t*)(ws + WS_KR); bf16_t* VR = (bf16_t*)(ws + WS_VR); float* SST = (float*)(ws + WS_SST);
    bf16_t* QD = (bf16_t*)(ws + WS_QD); bf16_t* KD = (bf16_t*)(ws + WS_KD); bf16_t* VD = (bf16_t*)(ws + WS_VD); bf16_t* OD = (bf16_t*)(ws + WS_OD); bf16_t* AD = (bf16_t*)(ws + WS_AD);
    bf16_t* SG = (bf16_t*)(ws + WS_SG); float* MR = (float*)(ws + WS_MR); bf16_t* MB = (bf16_t*)(ws + WS_MB);
    bf16_t* UG = (bf16_t*)(ws + WS_UG); bf16_t* H = (bf16_t*)(ws + WS_H);
    bf16_t* YR = (bf16_t*)out;

    {
        CTX();
        float* scr = (float*)(lds + 65536) + C.wave * (64 * 33);
        constexpr int I_IN = 16 * 352, I_RET = 32 * 32, I_DIF = 16 * 32, I_O = 16 * 32, I_UP = 16 * 176, I_DN = 44 * 32;
        constexpr int NIT = I_IN + I_RET + I_DIF + I_O + I_UP + I_DN;
        for (int it = C.gw; it < NIT; it += C.NGW) {
            int r = it;
            if (r < I_IN) { transpose_item<1>(win, 1024, NIN, WIN, scr, r, C.lane); continue; } r -= I_IN;
            if (r < I_RET) { transpose_item<0>(wret, 2048, 1024, WRET, scr, r, C.lane); continue; } r -= I_RET;
            if (r < I_DIF) { transpose_item<0>(wdif, 1024, 1024, WDIF, scr, r, C.lane); continue; } r -= I_DIF;
            if (r < I_O) { transpose_item<0>(wo, 1024, 1024, WO, scr, r, C.lane); continue; } r -= I_O;
            if (r < I_UP) { transpose_item<2>(wup, 1024, 5632, WUP, scr, r, C.lane); continue; } r -= I_UP;
            transpose_item<0>(wdn, 2816, 1024, WDN, scr, r, C.lane);
        }
        d_mod(C, c, cctx, wmod, bmod, MOD);
        d_tables(C, logit, dlam, TAB, SCAL);
    }
    grid.sync();
    { CTX(); d_lnmod(C, x, ctx, lng, lnb, MOD, XM, STATS); }
    grid.sync();
    fast_gemm(lds, XM, WIN + (size_t)C_QR * 1024, MA, 4096, 1024, FEpiRetQKV{QR, KR, VR, TAB});
    grid.sync();
    { CTX(); d_ret_fast(C, QR, KR, VR, YR, SCAL); }
    grid.sync();
    { CTX(); d_ret_stats(C, YR, RS); }
    fast_gemm(lds, XM, WIN + (size_t)C_QD * 1024, MA, 3072, 1024, FEpiDifQKV{QD, KD, VD, TAB});
    grid.sync();
    { CTX(); d_attn_fast(C, QD, KD, VD, AD, SCAL, gsub); }
    grid.sync();
    fast_gemm(lds, XM, WIN + (size_t)C_GR * 1024, ML, 2048, 1024, FEpiGr{YR, RS});
    grid.sync();
    fast_gemm(lds, XM, WIN + (size_t)C_GATE * 1024, ML, 2048, 1024, FEpiGate{SG, bgate});
    grid.sync();
    fast_gemm(lds, YR, WRET, ML, 1024, 2048, FEpiMr{MR, SG});
    grid.sync();
    fast_gemm(lds, AD, WDIF, ML, 1024, 1024, FEpiMb{MB, MR, SG});
    grid.sync();
    fast_gemm(lds, MB, WO, ML, 1024, 1024, FEpiZ1{out, x, STATS, lng, lnb, MOD});
    grid.sync();
    { CTX(); d_ln_rows(C, out, ln1g, ln1b, MOD, XM); }
    grid.sync();
    for (int hf = 0; hf < 2; ++hf) {
        const int r0 = hf * (ML / 2);
        fast_gemm(lds, XM + (size_t)r0 * 1024, WUP, ML / 2, 5632, 1024, FEpiUG{UG});
        grid.sync();
        { CTX(); d_convgate(C, UG, r0, cw, cb, H); }
        grid.sync();
    }
    fast_gemm(lds, H, WDN, ML, 1024, DFF, FEpiZ2{out, MOD});
    grid.sync();
    { CTX(); d_ln_rows(C, out, ln2g, ln2b, MOD, (bf16_t*)nullptr); }
}

extern "C" void kernel_launch(void* const* d_in, const int* in_sizes, int n_in, void* d_out, int out_size, void* d_ws, size_t ws_size, hipStream_t stream) {
    static int grid = 0;
    if (grid == 0) {
        if (n_in != 24 || ws_size < WS_NEED) { fprintf(stderr, "kernel_launch: unexpected n_in %d / ws %zu\n", n_in, ws_size); grid = -1; return; }
        int dev = 0, cus = 0, per_cu = 0;
        if (hipGetDevice(&dev) != hipSuccess || hipDeviceGetAttribute(&cus, hipDeviceAttributeMultiprocessorCount, dev) != hipSuccess) { grid = -1; return; }
        if (hipFuncSetAttribute((const void*)mega, hipFuncAttributeMaxDynamicSharedMemorySize, LDS_BYTES) != hipSuccess) { fprintf(stderr, "kernel_launch: hipFuncSetAttribute failed\n"); grid = -1; return; }
        if (hipOccupancyMaxActiveBlocksPerMultiprocessor(&per_cu, (const void*)mega, 512, LDS_BYTES) != hipSuccess || per_cu < 1) { fprintf(stderr, "kernel_launch: occupancy query failed (%d)\n", per_cu); (void)hipGetLastError(); grid = -1; return; }
        grid = cus * 1;
        fprintf(stderr, "kernel_launch: cus %d per_cu %d grid %d\n", cus, per_cu, grid);
    }
    if (grid < 0) return;
    Params p{};
    for (int i = 0; i < 24; ++i) p.in[i] = (const float*)d_in[i];
    p.out = (float*)d_out; p.ws = (unsigned char*)d_ws;
    void* args[] = {&p};
    hipError_t e = hipLaunchCooperativeKernel((const void*)mega, dim3(grid), dim3(512), args, LDS_BYTES, stream);
    if (e != hipSuccess) fprintf(stderr, "kernel_launch: cooperative launch failed: %s (grid %d)\n", hipGetErrorString(e), grid);
}
```

```cpp
#include <hip/hip_runtime.h>
#include <hip/hip_cooperative_groups.h>
namespace cg = cooperative_groups;
#include <cstdio>
#include <cstdint>
#include <cmath>

typedef unsigned short bf16_t;
typedef short bf16x8 __attribute__((ext_vector_type(8)));
typedef float f32x4 __attribute__((ext_vector_type(4)));

constexpr int D = 1024, NB = 8, SEQ = 4096, CTX = 256, ML = NB * SEQ  , MC = NB * CTX  , MA = ML + MC  ;
constexpr int NIN = 11264, DFF = 2816;
constexpr int C_QR = 0, C_KR = 1024, C_VR = 2048, C_GR = 4096, C_QD = 6144, C_KD = 7168, C_VD = 8192, C_GATE = 9216;
constexpr float LN_EPS = 1e-5f;
constexpr float ALPHA = 1.189207115002721f;
constexpr float LAM_INIT = 0.2f;

constexpr size_t MiB = 1u << 20;
constexpr size_t WS_MOD = 0;
constexpr size_t WS_TAB = 256 * 1024;
constexpr size_t WS_SCAL = 320 * 1024;
constexpr size_t WS_BAR = 384 * 1024;
constexpr size_t WS_STATS = 512 * 1024;
constexpr size_t WS_RS = 1 * MiB;
constexpr size_t WS_WIN = 2 * MiB;
constexpr size_t WS_WRET = 24 * MiB;
constexpr size_t WS_WDIF = 28 * MiB;
constexpr size_t WS_WO = 30 * MiB;
constexpr size_t WS_WUP = 32 * MiB;
constexpr size_t WS_WDN = 43 * MiB;
constexpr size_t WS_XM = 50 * MiB;
constexpr size_t WS_R = 118 * MiB;
constexpr size_t WS_QR = WS_R;
constexpr size_t WS_KR = WS_R + 64 * MiB;
constexpr size_t WS_VR = WS_R + 132 * MiB;
constexpr size_t WS_SST = WS_R + 272 * MiB;
constexpr size_t WS_QD = WS_R;
constexpr size_t WS_KD = WS_R + 64 * MiB;
constexpr size_t WS_VD = WS_R + 132 * MiB;
constexpr size_t WS_OD = WS_R + 200 * MiB;
constexpr size_t WS_AD = WS_R + 328 * MiB;
constexpr size_t WS_SG = WS_R;
constexpr size_t WS_MR = WS_R + 128 * MiB;
constexpr size_t WS_MB = WS_R + 256 * MiB;
constexpr size_t WS_UG = WS_R;
constexpr size_t WS_H = WS_R + 176 * MiB;
constexpr size_t WS_NEED = 512 * MiB;

__device__ __forceinline__ float bf2f(bf16_t v) { return __uint_as_float(((unsigned)v) << 16); }
__device__ __forceinline__ bf16_t f2bf(float f) { unsigned u = __float_as_uint(f); return (bf16_t)((u + 0x7fffu + ((u >> 16) & 1u)) >> 16); }
__device__ __forceinline__ float siluf(float x) { return x / (1.f + __expf(-x)); }
__device__ __forceinline__ float sigmf(float x) { return 1.f / (1.f + __expf(-x)); }
__device__ __forceinline__ float wave_sum(float v) {
#pragma unroll
    for (int o = 1; o < 64; o <<= 1) v += __shfl_xor(v, o);
    return v;
}

#define LAS __attribute__((address_space(3)))
__device__ __forceinline__ unsigned pk2(float lo, float hi) { return (unsigned)f2bf(lo) | ((unsigned)f2bf(hi) << 16); }
typedef unsigned v4u __attribute__((ext_vector_type(4)));
template <int MAP>
__device__ __forceinline__ void transpose_item(const float* __restrict__ W, int K, int N, bf16_t* __restrict__ WT, float* scr, int item, int lane) {
    const int nblk = N / 32, kb = item / nblk, nb = item % nblk, k0 = 64 * kb, n0 = 32 * nb;
    int s0 = n0;
    if (MAP == 1) { if (n0 >= C_QD && n0 < C_QD + 2048) { const int r = n0 - C_QD, t = r >> 8, p = r & 255, bj = p >> 7, qq = p & 127; s0 = C_QD + t * 256 + 64 * (qq >> 5) + 32 * bj; } }
    if (MAP == 2) { const int t = n0 >> 8, p = n0 & 255; s0 = p < 128 ? 128 * t + p : 2816 + 128 * t + (p - 128); }
#pragma unroll 8
    for (int i = 0; i < 32; ++i) { const int kk = 2 * i + (lane >> 5); scr[kk * 33 + (lane & 31)] = W[(size_t)(k0 + kk) * N + s0 + (lane & 31)]; }
    __builtin_amdgcn_s_waitcnt(0xC07F); __builtin_amdgcn_wave_barrier();
    const int c = lane & 7;
#pragma unroll
    for (int j = 0; j < 4; ++j) { const int n = (lane >> 3) + 8 * j; const float* s = scr + (8 * c) * 33 + n;
        v4u o; o.x = pk2(s[0 * 33], s[1 * 33]); o.y = pk2(s[2 * 33], s[3 * 33]); o.z = pk2(s[4 * 33], s[5 * 33]); o.w = pk2(s[6 * 33], s[7 * 33]);
        *(v4u*)(WT + (size_t)(n0 + n) * K + k0 + 8 * c) = o; }
    __builtin_amdgcn_s_waitcnt(0xC07F); __builtin_amdgcn_wave_barrier();
}


struct Ctx { int tid, lane, wave, bx, G, gw, NGW, gt, NGT; unsigned char* lds; };

__device__ __forceinline__ void d_mod(const Ctx& C, const float* __restrict__ c, const float* __restrict__ cctx, const float* __restrict__ wmod,
                                      const float* __restrict__ bmod, float* __restrict__ MOD) {
    if (C.bx >= 192) return;
    float* sc = (float*)C.lds;
    float* red = sc + 9 * 1024;
    for (int i = C.tid; i < 9 * 1024; i += 512) { const int r = i >> 10, k = i & 1023; const float v = r < 8 ? c[r * 1024 + k] : cctx[k]; sc[i] = siluf(v); }
    __syncthreads();
    for (int grp = C.bx; grp < 192; grp += C.G) {
        const int col = C.tid & 31, ks = C.tid >> 5, j = grp * 32 + col;
        float acc[9];
#pragma unroll
        for (int r = 0; r < 9; ++r) acc[r] = 0.f;
        for (int k = ks * 64; k < ks * 64 + 64; ++k) { const float w = wmod[(size_t)k * 6144 + j];
#pragma unroll
            for (int r = 0; r < 9; ++r) acc[r] += sc[r * 1024 + k] * w; }
#pragma unroll
        for (int r = 0; r < 9; ++r) red[(ks * 9 + r) * 32 + col] = acc[r];
        __syncthreads();
        if (C.tid < 288) { const int r = C.tid >> 5, cc = C.tid & 31; float a = bmod[grp * 32 + cc];
#pragma unroll
            for (int s = 0; s < 16; ++s) a += red[(s * 9 + r) * 32 + cc];
            MOD[r * 6144 + grp * 32 + cc] = a; }
        __syncthreads();
    }
}

__device__ __forceinline__ void sincos_acc(float ang, float& cs, float& sn) {
    const double TWO_PI = 6.283185307179586476925286766559;
    double a = (double)ang; const double k = rint(a / TWO_PI); double r = a - k * TWO_PI;
    const double r2 = r * r;
    double s = 1.0, c = 1.0;
#pragma unroll
    for (int n = 13; n >= 1; --n) { s = 1.0 - s * r2 / (double)((2 * n) * (2 * n + 1)); c = 1.0 - c * r2 / (double)((2 * n - 1) * (2 * n)); }
    sn = (float)(r * s); cs = (float)c;
}
__device__ __forceinline__ void d_tables(const Ctx& C, const float* __restrict__ logit, const float* __restrict__ dlam, float* __restrict__ TAB, float* __restrict__ SCAL) {
    if (C.bx == C.G - 1) {
        if (C.tid < 64) { float a = dlam[C.tid] * dlam[64 + C.tid], b = dlam[128 + C.tid] * dlam[192 + C.tid];
            a = wave_sum(a); b = wave_sum(b);
            if (C.tid == 0) SCAL[0] = expf(a) - expf(b) + LAM_INIT;
        } else if (C.tid < 72) { const float x = logit[C.tid - 64]; SCAL[1 + C.tid - 64] = fminf(x, 0.f) - log1pf(expf(-fabsf(x))); }
    }
    for (int i = C.gt; i < 64 * 64 + 64 * 16; i += C.NGT) {
        if (i < 4096) { const int p = i >> 6, f = i & 63; const float inv = powf(10000.f, -((float)(2 * f) / 128.f)); float cs, sn; sincos_acc((float)p * inv, cs, sn); TAB[i] = cs; TAB[4096 + i] = sn; }
        else { const int q = i - 4096, p = q >> 4, f = q & 15; const float inv = powf(10000.f, -((float)(2 * f) / 32.f)); float cs, sn; sincos_acc((float)p * inv, cs, sn); TAB[8192 + q] = cs; TAB[8192 + 1024 + q] = sn; }
    }
}

__device__ __forceinline__ void d_lnmod(const Ctx& C, const float* __restrict__ x, const float* __restrict__ ctx, const float* __restrict__ g, const float* __restrict__ bb,
                                        const float* __restrict__ MOD, bf16_t* __restrict__ XM, float* __restrict__ STATS) {
    const int lane = C.lane;
    for (int row = C.gw; row < MA; row += C.NGW) {
        const float* src = row < ML ? x + (size_t)row * D : ctx + (size_t)(row - ML) * D;
        const int mr = row < ML ? row / SEQ : 8;
        const float* sh = MOD + mr * 6144; const float* sc = sh + 1024;
        f32x4 v[4]; float s = 0.f;
#pragma unroll
        for (int j = 0; j < 4; ++j) { v[j] = *(const f32x4*)(src + j * 256 + lane * 4); s += (v[j].x + v[j].y) + (v[j].z + v[j].w); }
        const float mean = wave_sum(s) * (1.f / D); float s2 = 0.f;
#pragma unroll
        for (int j = 0; j < 4; ++j) { v[j] = v[j] - mean; s2 += (v[j].x * v[j].x + v[j].y * v[j].y) + (v[j].z * v[j].z + v[j].w * v[j].w); }
        const float rstd = 1.f / sqrtf(wave_sum(s2) * (1.f / D) + LN_EPS);
        if (row < ML && lane == 0) { STATS[row * 2] = mean; STATS[row * 2 + 1] = rstd; }
#pragma unroll
        for (int j = 0; j < 4; ++j) { const int c0 = j * 256 + lane * 4;
            const f32x4 gg = *(const f32x4*)(g + c0), bv = *(const f32x4*)(bb + c0), s1 = *(const f32x4*)(sc + c0), h1 = *(const f32x4*)(sh + c0);
            const f32x4 xn = v[j] * rstd * gg + bv; const f32x4 o = xn * (s1 + 1.f) + h1;
            ushort4 w; w.x = f2bf(o.x); w.y = f2bf(o.y); w.z = f2bf(o.z); w.w = f2bf(o.w);
            *(ushort4*)(XM + (size_t)row * D + c0) = w; }
    }
}

template <class Epi>
__device__ __forceinline__ void d_gemm(const Ctx& C, const bf16_t* __restrict__ A, int lda, const bf16_t* __restrict__ Bt, int ldb, int M, int N, int K, const Epi& epi) {
    const int fr = C.lane & 15, fq = C.lane >> 4, ntn = N / 256, nt = (M / 128) * ntn;
    for (int t = C.bx; t < nt; t += C.G) {
        const int row0 = (t / ntn) * 128 + (C.wave >> 2) * 64, col0 = (t % ntn) * 256 + (C.wave & 3) * 64;
        f32x4 acc[4][4];
#pragma unroll
        for (int i = 0; i < 4; ++i)
#pragma unroll
            for (int j = 0; j < 4; ++j) acc[i][j] = (f32x4){0.f, 0.f, 0.f, 0.f};
        const bf16_t* Ap = A + (size_t)(row0 + fr) * lda + fq * 8;
        const bf16_t* Bp = Bt + (size_t)(col0 + fr) * ldb + fq * 8;
        for (int k0 = 0; k0 < K; k0 += 32) {
            bf16x8 a[4], b[4];
#pragma unroll
            for (int i = 0; i < 4; ++i) { a[i] = *(const bf16x8*)(Ap + (size_t)i * 16 * lda + k0); b[i] = *(const bf16x8*)(Bp + (size_t)i * 16 * ldb + k0); }
#pragma unroll
            for (int i = 0; i < 4; ++i)
#pragma unroll
                for (int j = 0; j < 4; ++j) acc[i][j] = __builtin_amdgcn_mfma_f32_16x16x32_bf16(a[i], b[j], acc[i][j], 0, 0, 0);
        }
#pragma unroll
        for (int i = 0; i < 4; ++i)
#pragma unroll
            for (int j = 0; j < 4; ++j)
#pragma unroll
                for (int r = 0; r < 4; ++r) epi(row0 + i * 16 + fq * 4 + r, col0 + j * 16 + fr, acc[i][j][r]);
    }
}

struct EpiRetQKV { bf16_t *QR, *KR, *VR;
    __device__ __forceinline__ void operator()(int r, int c, float v) const {
        if (c < 1024) { if (r < ML) QR[(size_t)r * 1024 + c] = f2bf(v); }
        else if (c < 2048) KR[(size_t)r * 1024 + (c - 1024)] = f2bf(v * 0.0625f);
        else VR[(size_t)r * 2048 + (c - 2048)] = f2bf(v); } };
struct EpiDifQKV { bf16_t *QD, *KD, *VD;
    __device__ __forceinline__ void operator()(int r, int c, float v) const {
        if (c < 1024) { if (r < ML) QD[(size_t)r * 1024 + c] = f2bf(v * 0.125f); }
        else if (c < 2048) KD[(size_t)r * 1024 + (c - 1024)] = f2bf(v);
        else VD[(size_t)r * 1024 + (c - 2048)] = f2bf(v); } };
struct EpiGr { bf16_t* YR; const float* RS;
    __device__ __forceinline__ void operator()(int r, int c, float v) const {
        const int h = c >> 9; const float mu = RS[(r * 4 + h) * 2], rs = RS[(r * 4 + h) * 2 + 1];
        const size_t o = (size_t)r * 2048 + c; const float yn = (bf2f(YR[o]) - mu) * rs; YR[o] = f2bf(siluf(v) * yn); } };
struct EpiGate { bf16_t* SG; const float* bg;
    __device__ __forceinline__ void operator()(int r, int c, float v) const { SG[(size_t)r * 2048 + c] = f2bf(sigmf(v + bg[c])); } };
struct EpiMr { float* MR; const bf16_t* SG;
    __device__ __forceinline__ void operator()(int r, int c, float v) const { MR[(size_t)r * 1024 + c] = bf2f(SG[(size_t)r * 2048 + c]) * v; } };
struct EpiMb { bf16_t* MB; const float* MR; const bf16_t* SG;
    __device__ __forceinline__ void operator()(int r, int c, float v) const { MB[(size_t)r * 1024 + c] = f2bf(MR[(size_t)r * 1024 + c] + bf2f(SG[(size_t)r * 2048 + 1024 + c]) * v); } };
struct EpiZ1 { float* Z; const float* x; const float* STATS; const float* g; const float* b; const float* MOD;
    __device__ __forceinline__ void operator()(int r, int c, float v) const {
        const float xn = (x[(size_t)r * 1024 + c] - STATS[r * 2]) * STATS[r * 2 + 1] * g[c] + b[c];
        Z[(size_t)r * 1024 + c] = ALPHA * xn + MOD[(r / SEQ) * 6144 + 2048 + c] * v; } };
struct EpiUG { bf16_t* UG;
    __device__ __forceinline__ void operator()(int r, int c, float v) const { UG[(size_t)r * 5632 + c] = f2bf(v); } };
struct EpiZ2 { float* Z; const float* MOD;
    __device__ __forceinline__ void operator()(int r, int c, float v) const { const size_t o = (size_t)r * 1024 + c; Z[o] = ALPHA * Z[o] + MOD[(r / SEQ) * 6144 + 5120 + c] * v; } };

__device__ __forceinline__ void d_rope_ret(const Ctx& C, bf16_t* __restrict__ X, const float* __restrict__ TAB) {
    for (int idx = C.gt; idx < ML * 512; idx += C.NGT) {
        const int row = idx >> 9, p = idx & 511, h = p >> 7, j = p & 127;
        const int t = row & (SEQ - 1), pr = t >> 6, pc = t & 63;
        const int ti = j < 64 ? pr * 64 + j : pc * 64 + (j - 64);
        const float cs = TAB[ti], sn = TAB[4096 + ti];
        bf16_t* a = X + (size_t)row * 1024 + h * 256 + j;
        const float x1 = bf2f(a[0]), x2 = bf2f(a[128]);
        a[0] = f2bf(x1 * cs - x2 * sn); a[128] = f2bf(x2 * cs + x1 * sn);
    }
}
__device__ __forceinline__ void d_rope_dif(const Ctx& C, bf16_t* __restrict__ X, const float* __restrict__ TAB) {
    for (int idx = C.gt; idx < ML * 512; idx += C.NGT) {
        const int row = idx >> 9, p = idx & 511, blk = p >> 5, j = p & 31;
        const int t = row & (SEQ - 1), pr = t >> 6, pc = t & 63;
        const int ti = j < 16 ? pr * 16 + j : pc * 16 + (j - 16);
        const float cs = TAB[8192 + ti], sn = TAB[8192 + 1024 + ti];
        bf16_t* a = X + (size_t)row * 1024 + blk * 64 + j;
        const float x1 = bf2f(a[0]), x2 = bf2f(a[32]);
        a[0] = f2bf(x1 * cs - x2 * sn); a[32] = f2bf(x2 * cs + x1 * sn);
    }
}

__device__ __forceinline__ void d_ret_naive(const Ctx& C, const bf16_t* __restrict__ QR, const bf16_t* __restrict__ KR, const bf16_t* __restrict__ VR,
                                            bf16_t* __restrict__ YR, float* __restrict__ Sg, const float* __restrict__ SCAL) {
    bf16_t* qs = (bf16_t*)C.lds; bf16_t* ks = qs + 128 * 256; bf16_t* vs = ks + 128 * 256; bf16_t* Ps = qs;
    const int tid = C.tid;
    for (int bid = C.bx; bid < 256; bid += C.G) {
    const int vsl = bid & 7, h = (bid >> 3) & 3, b = bid >> 5;
    float* S = Sg + (size_t)bid * 16384;
    const float lgf = SCAL[1 + h], lgb = SCAL[5 + h];
    const int c = tid & 63, g8 = tid >> 6;
    for (int pass = 0; pass < 2; ++pass) {
        const float lg = pass ? lgb : lgf;
        for (int i = 0; i < 32; ++i) S[(g8 * 32 + i) * 64 + c] = 0.f;
        __syncthreads();
        for (int step = 0; step < 34; ++step) {
            const bool lat = step >= 2;
            int tz = 0; asm volatile("" : "+v"(tz));
            int rowbase;
            if (!lat) { const int cc = pass ? 1 - step : step; rowbase = ML + b * CTX + cc * 128; }
            else { const int n = pass ? 33 - step : step - 2; rowbase = b * SEQ + n * 128; }
            for (int p = tid; p < 128 * 32; p += 512) { const int r = p >> 5, ch = p & 31;
                *(bf16x8*)(ks + r * 256 + ch * 8) = *(const bf16x8*)(KR + (size_t)(rowbase + r) * 1024 + h * 256 + ch * 8);
                if (lat) *(bf16x8*)(qs + r * 256 + ch * 8) = *(const bf16x8*)(QR + (size_t)(rowbase + r) * 1024 + h * 256 + ch * 8); }
            for (int p = tid; p < 128 * 8; p += 512) { const int r = p >> 3, ch = p & 7;
                *(bf16x8*)(vs + r * 64 + ch * 8) = *(const bf16x8*)(VR + (size_t)(rowbase + r) * 2048 + h * 512 + vsl * 64 + ch * 8); }
            __syncthreads();
            if (lat) {
                float yacc[16];
#pragma unroll
                for (int ii = 0; ii < 16; ++ii) { const int i = g8 * 16 + ii + tz; float a = 0.f;
#pragma unroll 2
                    for (int d = 0; d < 256; ++d) a += bf2f(qs[i * 256 + d]) * bf2f(f2bf(S[d * 64 + c]));
                    yacc[ii] = a * __expf(lg * (pass ? (float)(128 - i) : (float)(i + 1))); }
                if (pass == 0) {
                    const int j = (tid & 127) + tz, g4 = tid >> 7; float pv[32];
#pragma unroll
                    for (int ii = 0; ii < 32; ++ii) { const int i = g4 * 32 + ii; float a = 0.f;
#pragma unroll 2
                        for (int d = 0; d < 256; ++d) a += bf2f(qs[i * 256 + d]) * bf2f(ks[j * 256 + d]);
                        const float m = i > j ? __expf(lgf * (float)(i - j)) : (i < j ? __expf(lgb * (float)(j - i)) : 2.f);
                        pv[ii] = a * m; }
                    __syncthreads();
#pragma unroll
                    for (int ii = 0; ii < 32; ++ii) Ps[(g4 * 32 + ii) * 128 + j] = f2bf(pv[ii]);
                    __syncthreads();
#pragma unroll
                    for (int ii = 0; ii < 16; ++ii) { const int i = g8 * 16 + ii; float a = 0.f;
#pragma unroll 2
                        for (int jj = 0; jj < 128; ++jj) a += bf2f(Ps[i * 128 + jj]) * bf2f(vs[jj * 64 + c]);
                        yacc[ii] += a; }
                }
#pragma unroll
                for (int ii = 0; ii < 16; ++ii) { const int i = g8 * 16 + ii; bf16_t* yp = YR + (size_t)(rowbase + i) * 2048 + h * 512 + vsl * 64 + c;
                    if (pass == 0) *yp = f2bf(yacc[ii]); else *yp = f2bf(bf2f(*yp) + yacc[ii]); }
            }
            const float ds = __expf(lg * 128.f);
            float acc[32];
#pragma unroll
            for (int i = 0; i < 32; ++i) acc[i] = 0.f;
#pragma unroll 1
            for (int jj = 0; jj < 128; ++jj) { const float vv = bf2f(f2bf(bf2f(vs[jj * 64 + c]) * __expf(lg * (pass ? (float)(jj + tz) : (float)(127 - jj + tz)))));
#pragma unroll
                for (int i = 0; i < 32; ++i) acc[i] += bf2f(ks[jj * 256 + g8 * 32 + i]) * vv; }
            __syncthreads();
#pragma unroll
            for (int i = 0; i < 32; ++i) { float* sp = S + (g8 * 32 + i) * 64 + c; *sp = *sp * ds + acc[i]; }
            __syncthreads();
        }
    }
    }
}

constexpr int ATTN_NAIVE_LDS = 64 * 64 * 2 + 64 * 128 * 2 + 64 * 65 * 4;
__device__ __forceinline__ void d_attn_naive(const Ctx& C, const bf16_t* __restrict__ QD, const bf16_t* __restrict__ KD, const bf16_t* __restrict__ VD, bf16_t* __restrict__ OD) {
    const int half = C.tid >> 8, tid = C.tid & 255, qi = tid >> 2, part = tid & 3;
    unsigned char* base = C.lds + half * ATTN_NAIVE_LDS;
    bf16_t* Ks = (bf16_t*)base; bf16_t* Vs = Ks + 64 * 64; float* Pm = (float*)(Vs + 64 * 128);
    for (int vb2 = C.bx; vb2 < 4096; vb2 += C.G) {
        const int vb = vb2 * 2 + half;
        const int qb = vb & 63, cc = (vb >> 6) & 1, h = (vb >> 7) & 7, b = vb >> 10;
        const int qrow = b * SEQ + qb * 64 + qi;
        float q[64];
#pragma unroll
        for (int d = 0; d < 64; ++d) q[d] = bf2f(QD[(size_t)qrow * 1024 + h * 128 + cc * 64 + d]);
        float o[32];
#pragma unroll
        for (int e = 0; e < 32; ++e) o[e] = 0.f;
        float m = -1e30f, l = 0.f;
        for (int kt = 0; kt < 68; ++kt) {
            const int krow0 = kt < 64 ? b * SEQ + kt * 64 : ML + b * CTX + (kt - 64) * 64;
            for (int p = tid; p < 64 * 8; p += 256) { const int r = p >> 3, ch = p & 7; *(bf16x8*)(Ks + r * 64 + ch * 8) = *(const bf16x8*)(KD + (size_t)(krow0 + r) * 1024 + h * 128 + cc * 64 + ch * 8); }
            for (int p = tid; p < 64 * 16; p += 256) { const int r = p >> 4, ch = p & 15; *(bf16x8*)(Vs + r * 128 + ch * 8) = *(const bf16x8*)(VD + (size_t)(krow0 + r) * 1024 + h * 128 + ch * 8); }
            __syncthreads();
            float s[16]; float mx = -1e30f;
#pragma unroll
            for (int jj = 0; jj < 16; ++jj) { const int j = part * 16 + jj; float a = 0.f;
#pragma unroll
                for (int d = 0; d < 64; ++d) a += q[d] * bf2f(Ks[j * 64 + d]);
                s[jj] = a; mx = fmaxf(mx, a); }
            mx = fmaxf(mx, __shfl_xor(mx, 1)); mx = fmaxf(mx, __shfl_xor(mx, 2));
            const float mn = fmaxf(m, mx), al = __expf(m - mn); m = mn;
            float ps = 0.f;
#pragma unroll
            for (int jj = 0; jj < 16; ++jj) { const float p = __expf(s[jj] - mn); ps += p; Pm[qi * 65 + part * 16 + jj] = bf2f(f2bf(p)); }
            l = l * al + ps;
#pragma unroll
            for (int e = 0; e < 32; ++e) o[e] *= al;
            __syncthreads();
            for (int j = 0; j < 64; ++j) { const float p = Pm[qi * 65 + j];
#pragma unroll
                for (int e = 0; e < 32; ++e) o[e] += p * bf2f(Vs[j * 128 + part * 32 + e]); }
            __syncthreads();
        }
        l += __shfl_xor(l, 1); l += __shfl_xor(l, 2);
        const float il = 1.f / l;
#pragma unroll
        for (int e = 0; e < 32; ++e) OD[(size_t)qrow * 2048 + h * 256 + cc * 128 + part * 32 + e] = f2bf(o[e] * il);
    }
}

__device__ __forceinline__ void d_prep_diff(const Ctx& C, const bf16_t* __restrict__ OD, const float* __restrict__ gsub, const float* __restrict__ SCAL, bf16_t* __restrict__ AD) {
    const int t = C.tid & 255, h = t >> 5, l = t & 31; const float lam = SCAL[0];
    for (int r2 = C.bx; r2 < ML / 2; r2 += C.G) {
        const int row = r2 * 2 + (C.tid >> 8);
        float a[4]; float ss = 0.f;
#pragma unroll
        for (int i = 0; i < 4; ++i) { const int e = l * 4 + i; a[i] = bf2f(OD[(size_t)row * 2048 + h * 256 + e]) - lam * bf2f(OD[(size_t)row * 2048 + h * 256 + 128 + e]); ss += a[i] * a[i]; }
#pragma unroll
        for (int o = 1; o < 32; o <<= 1) ss += __shfl_xor(ss, o);
        const float rs = 1.f / sqrtf(ss * (1.f / 128.f) + LN_EPS);
#pragma unroll
        for (int i = 0; i < 4; ++i) { const int e = l * 4 + i; AD[(size_t)row * 1024 + h * 128 + e] = f2bf(a[i] * rs * gsub[e] * (1.f - LAM_INIT)); }
    }
}
__device__ __forceinline__ void d_ret_stats(const Ctx& C, const bf16_t* __restrict__ YR, float* __restrict__ RS) {
    for (int it = C.gw; it < ML * 4; it += C.NGW) {
        const int row = it >> 2, h = it & 3;
        float v[8]; float s = 0.f;
#pragma unroll
        for (int i = 0; i < 8; ++i) { v[i] = bf2f(YR[(size_t)row * 2048 + h * 512 + C.lane * 8 + i]); s += v[i]; }
        const float mu = wave_sum(s) * (1.f / 512.f); float s2 = 0.f;
#pragma unroll
        for (int i = 0; i < 8; ++i) { const float d = v[i] - mu; s2 += d * d; }
        const float var = wave_sum(s2) * (1.f / 512.f);
        if (C.lane == 0) { RS[it * 2] = mu; RS[it * 2 + 1] = 1.f / sqrtf(var + LN_EPS); }
    }
}

__device__ __forceinline__ void d_ln_rows(const Ctx& C, float* __restrict__ Z, const float* __restrict__ g, const float* __restrict__ bb, const float* __restrict__ MOD, bf16_t* __restrict__ XM) {
    const int lane = C.lane;
    for (int row = C.gw; row < ML; row += C.NGW) {
        float* src = Z + (size_t)row * D;
        f32x4 v[4]; float s = 0.f;
#pragma unroll
        for (int j = 0; j < 4; ++j) { v[j] = *(const f32x4*)(src + j * 256 + lane * 4); s += (v[j].x + v[j].y) + (v[j].z + v[j].w); }
        const float mean = wave_sum(s) * (1.f / D); float s2 = 0.f;
#pragma unroll
        for (int j = 0; j < 4; ++j) { v[j] = v[j] - mean; s2 += (v[j].x * v[j].x + v[j].y * v[j].y) + (v[j].z * v[j].z + v[j].w * v[j].w); }
        const float rstd = 1.f / sqrtf(wave_sum(s2) * (1.f / D) + LN_EPS);
        const float* sh = MOD + (row / SEQ) * 6144 + 3072; const float* sc = sh + 1024;
#pragma unroll
        for (int j = 0; j < 4; ++j) { const int c0 = j * 256 + lane * 4;
            const f32x4 gg = *(const f32x4*)(g + c0), bv = *(const f32x4*)(bb + c0);
            const f32x4 xn = v[j] * rstd * gg + bv; *(f32x4*)(src + c0) = xn;
            if (XM) { const f32x4 s1 = *(const f32x4*)(sc + c0), h1 = *(const f32x4*)(sh + c0); const f32x4 o = xn * (s1 + 1.f) + h1;
                ushort4 w; w.x = f2bf(o.x); w.y = f2bf(o.y); w.z = f2bf(o.z); w.w = f2bf(o.w); *(ushort4*)(XM + (size_t)row * D + c0) = w; } }
    }
}

__device__ __forceinline__ void d_convgate(const Ctx& C, const bf16_t* __restrict__ UG, int row_off, const float* __restrict__ cw, const float* __restrict__ cb, bf16_t* __restrict__ H) {
    for (int idx = C.gt; idx < (ML / 2) * DFF; idx += C.NGT) {
        const int lr = idx / DFF, f = idx % DFF, row = row_off + lr, t = row & (SEQ - 1);
        const int uc = (f >> 7) * 256 + (f & 127);
        float u = cb[f] + cw[DFF + f] * bf2f(UG[(size_t)lr * 5632 + uc]);
        if (t > 0) u += cw[f] * bf2f(UG[(size_t)(lr - 1) * 5632 + uc]);
        if (t < SEQ - 1) u += cw[2 * DFF + f] * bf2f(UG[(size_t)(lr + 1) * 5632 + uc]);
        const float ge = 0.5f * u * (1.f + erff(u * 0.70710678118654752f));
        H[(size_t)row * DFF + f] = f2bf(ge * bf2f(UG[(size_t)lr * 5632 + uc + 128]));
    }
}

namespace pg8 {
#define PG8_LAS __attribute__((address_space(3)))
typedef unsigned short bf16_t;
typedef short bf16x8 __attribute__((ext_vector_type(8)));
typedef float f32x4 __attribute__((ext_vector_type(4)));
typedef unsigned u32x4 __attribute__((ext_vector_type(4)));
constexpr int BM = 256, BK = 64, HALF = 128, HTB = HALF * BK * 2  , STAGE_BYTES = 8 * HTB, NXCD = 8, WGM = 8;

__host__ __device__ __forceinline__ int lds_byte(int r, int c) { const int st = (r >> 4) * 2 + (c >> 5), rr = r & 15, cc = c & 31, ob = rr * 64 + cc * 2; return st * 1024 + (ob ^ (((ob >> 9) & 1) << 5)); }
__host__ __device__ __forceinline__ void stage_rc(int b, int& R, int& C) { const int st = b / 1024, sb = b % 1024, swz = sb ^ (((sb >> 9) & 1) << 5); R = (st >> 1) * 16 + swz / 64; C = (st & 1) * 32 + (swz % 64) / 2; }
__host__ __device__ __forceinline__ int perm32(int rho) { const int n = rho >> 4, i = rho & 15; return 8 * (i >> 2) + 4 * n + (i & 3); }

struct Unit { int pm, pn; };
struct Gemm { const bf16_t* A; const bf16_t* Bt; int M, N, K; };

struct StaticOrder {
    int nM, nN, nwg, G, c;
    __host__ __device__ void init(int M, int N, int G_, int c_) { nM = M / BM; nN = N / BM; nwg = nM * nN; G = G_; c = c_; }
    __host__ __device__ bool next(int i, Unit& u) const {
        const long L = (long)i * G + c; if (L >= nwg) return false;
        int wgid = (int)L; { const int q = nwg / NXCD, r = nwg % NXCD, xcd = wgid % NXCD, off = wgid / NXCD; wgid = (xcd < r ? xcd * (q + 1) : r * (q + 1) + (xcd - r) * q) + off; }
        const int nig = WGM * nN, gid = wgid / nig, fm = gid * WGM, gsz = (nM - fm) < WGM ? (nM - fm) : WGM;
        u.pm = fm + ((wgid % nig) % gsz); u.pn = (wgid % nig) / gsz; return true;
    }
    __device__ __forceinline__ void a_ready(const Unit&) const {}
    __device__ __forceinline__ void done(const Unit&) const {}
};

template <class Epi, class Sched, bool ALIGN_EPI = false, bool SP2 = false>
__device__ __forceinline__ void gemm_phase(PG8_LAS unsigned char* lds, const Gemm g, const Sched& S, const Epi& E) {
    int tid_ = threadIdx.x; asm volatile("" : "+v"(tid_));
    const int tid = tid_, wid = __builtin_amdgcn_readfirstlane(tid >> 6), lane = tid & 63, wr = wid >> 2, wc = wid & 3, fr = lane & 15, fq = lane >> 4;
    const int K = g.K, nt = K / BK;
    unsigned voffA[2], voffB[2];
#pragma unroll
    for (int i = 0; i < 2; ++i) { int R, C; stage_rc(tid * 16 + i * 8192, R, C); const int Rb = Epi::PERM ? ((R & ~31) + perm32(R & 31)) : R;
        voffA[i] = (unsigned)(R * K + C) * 2u; voffB[i] = (unsigned)(Rb * K + C) * 2u; }
    const size_t kstep = (size_t)(BK * 2);
    const size_t hstep = (size_t)HALF * K * 2;
    const size_t tstep = 2 * hstep;
    const unsigned ldsw = (unsigned)wid * 1024u;
    const int aoff = lds_byte(wr * 64 + fr, fq * 8), boff = lds_byte(wc * 32 + fr, fq * 8);
#define PG8_SA(b, h) (((b) * 2 + (h)) * HTB)
#define PG8_SB(b, h) ((4 + (b) * 2 + (h)) * HTB)
#define PG8_STAGE(bufoff, gbase, voff) do { _Pragma("unroll") for (int _i = 0; _i < 2; ++_i) \
        __builtin_amdgcn_global_load_lds((const unsigned*)((const char*)(gbase) + (voff)[_i]), (PG8_LAS unsigned*)(lds + (bufoff) + ldsw + _i * 8192), 16, 0, 0); } while (0)
#define PG8_LDA(dst, b, h) do { _Pragma("unroll") for (int m = 0; m < 4; ++m) _Pragma("unroll") for (int k = 0; k < 2; ++k) dst[m][k] = *(const PG8_LAS bf16x8*)(lds + PG8_SA(b, h) + aoff + m * 2048 + k * 1024); } while (0)
#define PG8_LDB(dst, b, h) do { _Pragma("unroll") for (int n = 0; n < 2; ++n) _Pragma("unroll") for (int k = 0; k < 2; ++k) dst[n][k] = *(const PG8_LAS bf16x8*)(lds + PG8_SB(b, h) + boff + n * 2048 + k * 1024); } while (0)
#define PG8_MMA(ai, bj, At, Bt) do { __builtin_amdgcn_s_setprio(1); _Pragma("unroll") for (int m = 0; m < 4; ++m) _Pragma("unroll") for (int n = 0; n < 2; ++n) _Pragma("unroll") for (int k = 0; k < 2; ++k) \
        acc[ai][bj][m][n] = __builtin_amdgcn_mfma_f32_16x16x32_bf16(Bt[n][k], At[m][k], acc[ai][bj][m][n], 0, 0, 0); __builtin_amdgcn_s_setprio(0); } while (0)
#define PG8_WAIT_V(n) asm volatile("s_waitcnt vmcnt(" #n ")" ::: "memory")
#define PG8_WAIT_L(n) asm volatile("s_waitcnt lgkmcnt(" #n ")" ::: "memory")
#define PG8_BAR __builtin_amdgcn_s_barrier()
#define PG8_SCHED __builtin_amdgcn_sched_barrier(0)
    Unit cur, nxt; int ui = 0;
    if (!S.next(0, cur)) return;
    f32x4 acc[2][2][4][2];
#pragma unroll
    for (int a = 0; a < 2; ++a)
#pragma unroll
        for (int b = 0; b < 2; ++b)
#pragma unroll
            for (int m = 0; m < 4; ++m)
#pragma unroll
                for (int n = 0; n < 2; ++n) acc[a][b][m][n] = (f32x4){0.f, 0.f, 0.f, 0.f};
    bf16x8 At[4][2], B0[2][2], B1[2][2];
    const char* cA = (const char*)g.A + (size_t)cur.pm * tstep; const char* cB = (const char*)g.Bt + (size_t)cur.pn * tstep;
    S.a_ready(cur);
    if constexpr (SP2) {
        PG8_STAGE(PG8_SB(0, 0), cB, voffB); PG8_STAGE(PG8_SB(0, 1), cB + hstep, voffB); PG8_STAGE(PG8_SA(0, 0), cA, voffA); PG8_STAGE(PG8_SA(0, 1), cA + hstep, voffA);
        if (wr == 1) PG8_BAR;
        PG8_WAIT_V(2); PG8_BAR;
        PG8_STAGE(PG8_SB(1, 0), cB + kstep, voffB); PG8_STAGE(PG8_SA(1, 0), cA + kstep, voffA); PG8_STAGE(PG8_SB(1, 1), cB + hstep + kstep, voffB);
        PG8_WAIT_V(6); PG8_BAR;
    } else {
        PG8_STAGE(PG8_SB(0, 0), cB, voffB); PG8_STAGE(PG8_SA(0, 0), cA, voffA); PG8_STAGE(PG8_SB(0, 1), cB + hstep, voffB); PG8_STAGE(PG8_SA(0, 1), cA + hstep, voffA);
        if (wr == 1) PG8_BAR;
        PG8_WAIT_V(4); PG8_BAR;
        PG8_STAGE(PG8_SB(1, 0), cB + kstep, voffB); PG8_STAGE(PG8_SA(1, 0), cA + kstep, voffA); PG8_STAGE(PG8_SB(1, 1), cB + hstep + kstep, voffB);
        PG8_WAIT_V(6); PG8_BAR;
    }
    for (;;) {
        const bool has_next = S.next(ui + 1, nxt);
        const char* nA = has_next ? (const char*)g.A + (size_t)nxt.pm * tstep : cA; const char* nB = has_next ? (const char*)g.Bt + (size_t)nxt.pn * tstep : cB;
        for (int t = 0; t < nt; t += 2) {
            const bool last = (t == nt - 2);
            const char* a1 = cA + (size_t)(t + 1) * kstep;
            const char* a2 = last ? nA : cA + (size_t)(t + 2) * kstep; const char* b2 = last ? nB : cB + (size_t)(t + 2) * kstep;
            const char* a3 = a2 + kstep; const char* b3 = b2 + kstep;
            if (last && has_next) S.a_ready(nxt);
            if constexpr (SP2) {
            PG8_LDB(B0, 0, 0); PG8_LDB(B1, 0, 1); PG8_SCHED; PG8_LDA(At, 0, 0); PG8_STAGE(PG8_SA(1, 1), a1 + hstep, voffA);
            PG8_WAIT_V(8); PG8_WAIT_L(0); PG8_BAR; PG8_MMA(0, 0, At, B0); PG8_MMA(0, 1, At, B1); PG8_BAR; PG8_SCHED;
            PG8_LDA(At, 0, 1); PG8_STAGE(PG8_SB(0, 0), b2, voffB); PG8_STAGE(PG8_SB(0, 1), b2 + hstep, voffB); PG8_STAGE(PG8_SA(0, 0), a2, voffA);
            PG8_WAIT_V(8); PG8_WAIT_L(0); PG8_BAR; PG8_MMA(1, 0, At, B0); PG8_MMA(1, 1, At, B1); PG8_BAR; PG8_SCHED;
            PG8_LDB(B0, 1, 0); PG8_LDB(B1, 1, 1); PG8_SCHED; PG8_LDA(At, 1, 0); PG8_STAGE(PG8_SA(0, 1), a2 + hstep, voffA);
            PG8_WAIT_V(8); PG8_WAIT_L(0); PG8_BAR; PG8_MMA(0, 0, At, B0); PG8_MMA(0, 1, At, B1); PG8_BAR; PG8_SCHED;
            PG8_LDA(At, 1, 1); PG8_STAGE(PG8_SB(1, 0), b3, voffB); PG8_STAGE(PG8_SB(1, 1), b3 + hstep, voffB); PG8_STAGE(PG8_SA(1, 0), a3, voffA);
            PG8_WAIT_V(8); PG8_WAIT_L(0); PG8_BAR; PG8_MMA(1, 0, At, B0); PG8_MMA(1, 1, At, B1); PG8_BAR; PG8_SCHED;
            } else {
            PG8_LDB(B0, 0, 0); PG8_SCHED; PG8_LDA(At, 0, 0); PG8_STAGE(PG8_SA(1, 1), a1 + hstep, voffA);
            PG8_WAIT_L(8); PG8_BAR; PG8_WAIT_L(0); PG8_MMA(0, 0, At, B0); PG8_BAR; PG8_SCHED;
            PG8_LDB(B1, 0, 1); PG8_STAGE(PG8_SB(0, 0), b2, voffB);
            PG8_BAR; PG8_WAIT_L(0); PG8_MMA(0, 1, At, B1); PG8_BAR;
            PG8_LDA(At, 0, 1); PG8_STAGE(PG8_SA(0, 0), a2, voffA);
            PG8_BAR; PG8_WAIT_L(0); PG8_MMA(1, 0, At, B0); PG8_BAR; PG8_SCHED;
            PG8_STAGE(PG8_SB(0, 1), b2 + hstep, voffB);
            PG8_WAIT_V(6); PG8_BAR; PG8_MMA(1, 1, At, B1); PG8_BAR;
            PG8_LDB(B0, 1, 0); PG8_SCHED; PG8_LDA(At, 1, 0); PG8_STAGE(PG8_SA(0, 1), a2 + hstep, voffA);
            PG8_WAIT_L(8); PG8_BAR; PG8_WAIT_L(0); PG8_MMA(0, 0, At, B0); PG8_BAR; PG8_SCHED;
            PG8_LDB(B1, 1, 1); PG8_STAGE(PG8_SB(1, 0), b3, voffB);
            PG8_BAR; PG8_WAIT_L(0); PG8_MMA(0, 1, At, B1); PG8_BAR;
            PG8_LDA(At, 1, 1); PG8_STAGE(PG8_SA(1, 0), a3, voffA);
            PG8_BAR; PG8_WAIT_L(0); PG8_MMA(1, 0, At, B0); PG8_BAR; PG8_SCHED;
            PG8_STAGE(PG8_SB(1, 1), b3 + hstep, voffB);
            PG8_WAIT_V(6); PG8_BAR; PG8_MMA(1, 1, At, B1); PG8_BAR;
            }
        }
        if constexpr (ALIGN_EPI) { if (wr == 0) PG8_BAR; }
        if constexpr (!Epi::AFTER_DRAIN) { E(acc, cur, wr, wc, fr, fq); S.done(cur); }
        if (!has_next) break;
#pragma unroll
        for (int a = 0; a < 2; ++a)
#pragma unroll
            for (int b = 0; b < 2; ++b)
#pragma unroll
                for (int m = 0; m < 4; ++m)
#pragma unroll
                    for (int n = 0; n < 2; ++n) acc[a][b][m][n] = (f32x4){0.f, 0.f, 0.f, 0.f};
        cur = nxt; cA = nA; cB = nB; ++ui;
        if constexpr (ALIGN_EPI) { if (wr == 1) PG8_BAR; }
    }
    PG8_WAIT_V(0);
    if constexpr (!ALIGN_EPI) { if (wr == 0) PG8_BAR; }
    PG8_BAR;
    if constexpr (Epi::AFTER_DRAIN) { E.fused(acc, cur, wr, wc, fr, fq, lds, wid, lane); S.done(cur); }
#undef PG8_SA
#undef PG8_SB
#undef PG8_STAGE
#undef PG8_LDA
#undef PG8_LDB
#undef PG8_MMA
#undef PG8_WAIT_V
#undef PG8_WAIT_L
#undef PG8_BAR
#undef PG8_SCHED
}
}


typedef unsigned u32x4 __attribute__((ext_vector_type(4)));
typedef float f32x2_t __attribute__((ext_vector_type(2))); typedef __bf16 bf16x2_t __attribute__((ext_vector_type(2)));
__device__ __forceinline__ unsigned cvtpk(float lo, float hi) { f32x2_t v = {lo, hi}; bf16x2_t b = __builtin_convertvector(v, bf16x2_t); return __builtin_bit_cast(unsigned, b); }
__device__ __forceinline__ u32x4 pack8(const f32x4& a, const f32x4& b) { u32x4 w; w.x = cvtpk(a[0], a[1]); w.y = cvtpk(a[2], a[3]); w.z = cvtpk(b[0], b[1]); w.w = cvtpk(b[2], b[3]); return w; }
__device__ __forceinline__ void unpack8(const u32x4& w, f32x4& a, f32x4& b) {
    a[0] = __uint_as_float(w.x << 16); a[1] = __uint_as_float(w.x & 0xffff0000u); a[2] = __uint_as_float(w.y << 16); a[3] = __uint_as_float(w.y & 0xffff0000u);
    b[0] = __uint_as_float(w.z << 16); b[1] = __uint_as_float(w.z & 0xffff0000u); b[2] = __uint_as_float(w.w << 16); b[3] = __uint_as_float(w.w & 0xffff0000u); }
typedef const f32x4 (&AccT)[2][2][4][2];
#define EPI_ROWS for (int ai = 0; ai < 2; ++ai) _Pragma("unroll") for (int m = 0; m < 4; ++m)

struct FEpiRetQKV { static constexpr bool PERM = true, AFTER_DRAIN = false; bf16_t *QR, *KR, *VR; const float* TAB;
    __device__ __forceinline__ void operator()(AccT acc, const pg8::Unit& u, int wr, int wc, int fr, int fq) const {
        const int row0 = u.pm * 256 + wr * 64 + fr, j0 = wc * 32 + 8 * fq;
        if (u.pn < 8) {
            const bool isq = u.pn < 4; const int h = u.pn & 3;
            if (isq && u.pm >= ML / 256) return;
            bf16_t* dst = (isq ? QR : KR) + h * 256 + j0; const float sc = isq ? 1.f : 0.0625f;
#pragma unroll
            EPI_ROWS { const int row = row0 + ai * 128 + m * 16;
                f32x4 c0 = {1.f, 1.f, 1.f, 1.f}, c1 = c0, s0 = {0.f, 0.f, 0.f, 0.f}, s1 = s0;
                if (row < ML) { const int t = row & (SEQ - 1), p = (j0 < 64) ? (t >> 6) : (t & 63); const float* tp = TAB + p * 64 + (j0 & 63);
                    c0 = *(const f32x4*)tp; c1 = *(const f32x4*)(tp + 4); s0 = *(const f32x4*)(tp + 4096); s1 = *(const f32x4*)(tp + 4100); }
                const f32x4 x1a = acc[ai][0][m][0], x1b = acc[ai][0][m][1], x2a = acc[ai][1][m][0], x2b = acc[ai][1][m][1];
                const f32x4 o1a = (x1a * c0 - x2a * s0) * sc, o1b = (x1b * c1 - x2b * s1) * sc, o2a = (x2a * c0 + x1a * s0) * sc, o2b = (x2b * c1 + x1b * s1) * sc;
                bf16_t* rp = dst + (size_t)row * 1024; *(u32x4*)rp = pack8(o1a, o1b); *(u32x4*)(rp + 128) = pack8(o2a, o2b); }
        } else {
            bf16_t* dst = VR + (u.pn - 8) * 256 + j0;
#pragma unroll
            EPI_ROWS { bf16_t* rp = dst + (size_t)(row0 + ai * 128 + m * 16) * 2048; *(u32x4*)rp = pack8(acc[ai][0][m][0], acc[ai][0][m][1]); *(u32x4*)(rp + 128) = pack8(acc[ai][1][m][0], acc[ai][1][m][1]); }
        }
    } };
constexpr float QSCALE = 0.125f;
struct FEpiDifQKV { static constexpr bool PERM = true, AFTER_DRAIN = false; bf16_t *QD, *KD, *VD; const float* TAB;
    __device__ __forceinline__ void operator()(AccT acc, const pg8::Unit& u, int wr, int wc, int fr, int fq) const {
        const int row0 = u.pm * 256 + wr * 64 + fr, j0 = wc * 32 + 8 * fq;
        if (u.pn < 8) {
            const bool isq = u.pn < 4; const int tl = u.pn & 3;
            if (isq && u.pm >= ML / 256) return;
            const int dd0 = 8 * fq;
            bf16_t* dst = (isq ? QD : KD) + tl * 256 + wc * 64 + dd0; const float sc = isq ? QSCALE : 1.f;
#pragma unroll
            EPI_ROWS { const int row = row0 + ai * 128 + m * 16;
                f32x4 c0 = {1.f, 1.f, 1.f, 1.f}, c1 = c0, s0 = {0.f, 0.f, 0.f, 0.f}, s1 = s0;
                if (row < ML) { const int t = row & (SEQ - 1), p = (dd0 < 16) ? (t >> 6) : (t & 63); const float* tp = TAB + 8192 + p * 16 + (dd0 & 15);
                    c0 = *(const f32x4*)tp; c1 = *(const f32x4*)(tp + 4); s0 = *(const f32x4*)(tp + 1024); s1 = *(const f32x4*)(tp + 1028); }
                const f32x4 x1a = acc[ai][0][m][0], x1b = acc[ai][0][m][1], x2a = acc[ai][1][m][0], x2b = acc[ai][1][m][1];
                const f32x4 o1a = (x1a * c0 - x2a * s0) * sc, o1b = (x1b * c1 - x2b * s1) * sc, o2a = (x2a * c0 + x1a * s0) * sc, o2b = (x2b * c1 + x1b * s1) * sc;
                bf16_t* rp = dst + (size_t)row * 1024; *(u32x4*)rp = pack8(o1a, o1b); *(u32x4*)(rp + 32) = pack8(o2a, o2b); }
        } else {
            bf16_t* dst = VD + (u.pn - 8) * 256 + j0;
#pragma unroll
            EPI_ROWS { bf16_t* rp = dst + (size_t)(row0 + ai * 128 + m * 16) * 1024; *(u32x4*)rp = pack8(acc[ai][0][m][0], acc[ai][0][m][1]); *(u32x4*)(rp + 128) = pack8(acc[ai][1][m][0], acc[ai][1][m][1]); }
        }
    } };
__device__ __forceinline__ f32x4 silu4(const f32x4& v) { f32x4 r; r[0] = siluf(v[0]); r[1] = siluf(v[1]); r[2] = siluf(v[2]); r[3] = siluf(v[3]); return r; }
__device__ __forceinline__ f32x4 sigm4(const f32x4& v) { f32x4 r; r[0] = sigmf(v[0]); r[1] = sigmf(v[1]); r[2] = sigmf(v[2]); r[3] = sigmf(v[3]); return r; }
struct FEpiGr { static constexpr bool PERM = true, AFTER_DRAIN = false; bf16_t* YR; const float* RS;
    __device__ __forceinline__ void operator()(AccT acc, const pg8::Unit& u, int wr, int wc, int fr, int fq) const {
        const int row0 = u.pm * 256 + wr * 64 + fr, j0 = wc * 32 + 8 * fq, h = u.pn >> 1;
#pragma unroll
        EPI_ROWS { const int row = row0 + ai * 128 + m * 16; const float mu = RS[(row * 4 + h) * 2], rs = RS[(row * 4 + h) * 2 + 1];
            bf16_t* rp = YR + (size_t)row * 2048 + u.pn * 256 + j0;
#pragma unroll
            for (int bj = 0; bj < 2; ++bj) { f32x4 ya, yb; unpack8(*(const u32x4*)(rp + bj * 128), ya, yb);
                *(u32x4*)(rp + bj * 128) = pack8(silu4(acc[ai][bj][m][0]) * ((ya - mu) * rs), silu4(acc[ai][bj][m][1]) * ((yb - mu) * rs)); } }
    } };
struct FEpiGate { static constexpr bool PERM = true, AFTER_DRAIN = false; bf16_t* SG; const float* bg;
    __device__ __forceinline__ void operator()(AccT acc, const pg8::Unit& u, int wr, int wc, int fr, int fq) const {
        const int row0 = u.pm * 256 + wr * 64 + fr, c0 = u.pn * 256 + wc * 32 + 8 * fq;
        f32x4 bv[2][2];
#pragma unroll
        for (int bj = 0; bj < 2; ++bj) { bv[bj][0] = *(const f32x4*)(bg + c0 + bj * 128); bv[bj][1] = *(const f32x4*)(bg + c0 + bj * 128 + 4); }
#pragma unroll
        EPI_ROWS { bf16_t* rp = SG + (size_t)(row0 + ai * 128 + m * 16) * 2048 + c0;
#pragma unroll
            for (int bj = 0; bj < 2; ++bj) *(u32x4*)(rp + bj * 128) = pack8(sigm4(acc[ai][bj][m][0] + bv[bj][0]), sigm4(acc[ai][bj][m][1] + bv[bj][1])); }
    } };
struct FEpiMr { static constexpr bool PERM = true, AFTER_DRAIN = false; float* MR; const bf16_t* SG;
    __device__ __forceinline__ void operator()(AccT acc, const pg8::Unit& u, int wr, int wc, int fr, int fq) const {
        const int row0 = u.pm * 256 + wr * 64 + fr, c0 = u.pn * 256 + wc * 32 + 8 * fq;
#pragma unroll
        EPI_ROWS { const int row = row0 + ai * 128 + m * 16;
#pragma unroll
            for (int bj = 0; bj < 2; ++bj) { f32x4 ga, gb; unpack8(*(const u32x4*)(SG + (size_t)row * 2048 + c0 + bj * 128), ga, gb);
                float* op = MR + (size_t)row * 1024 + c0 + bj * 128; *(f32x4*)op = ga * acc[ai][bj][m][0]; *(f32x4*)(op + 4) = gb * acc[ai][bj][m][1]; } }
    } };
struct FEpiMb { static constexpr bool PERM = true, AFTER_DRAIN = false; bf16_t* MB; const float* MR; const bf16_t* SG;
    __device__ __forceinline__ void operator()(AccT acc, const pg8::Unit& u, int wr, int wc, int fr, int fq) const {
        const int row0 = u.pm * 256 + wr * 64 + fr, c0 = u.pn * 256 + wc * 32 + 8 * fq;
#pragma unroll
        EPI_ROWS { const int row = row0 + ai * 128 + m * 16;
#pragma unroll
            for (int bj = 0; bj < 2; ++bj) { f32x4 ga, gb; unpack8(*(const u32x4*)(SG + (size_t)row * 2048 + 1024 + c0 + bj * 128), ga, gb);
                const float* ip = MR + (size_t)row * 1024 + c0 + bj * 128;
                *(u32x4*)(MB + (size_t)row * 1024 + c0 + bj * 128) = pack8(*(const f32x4*)ip + ga * acc[ai][bj][m][0], *(const f32x4*)(ip + 4) + gb * acc[ai][bj][m][1]); } }
    } };
struct FEpiZ1 { static constexpr bool PERM = true, AFTER_DRAIN = false; float* Z; const float* x; const float* STATS; const float* g; const float* b; const float* MOD;
    __device__ __forceinline__ void operator()(AccT acc, const pg8::Unit& u, int wr, int wc, int fr, int fq) const {
        const int row0 = u.pm * 256 + wr * 64 + fr, c0 = u.pn * 256 + wc * 32 + 8 * fq;
        const float* g1 = MOD + (u.pm / (SEQ / 256)) * 6144 + 2048;
#pragma unroll
        for (int bj = 0; bj < 2; ++bj)
#pragma unroll
            for (int n = 0; n < 2; ++n) { const int c = c0 + bj * 128 + n * 4; const f32x4 gg = *(const f32x4*)(g + c), bb = *(const f32x4*)(b + c), gm = *(const f32x4*)(g1 + c);
#pragma unroll
                EPI_ROWS { const int row = row0 + ai * 128 + m * 16; const float mu = STATS[row * 2], rs = STATS[row * 2 + 1];
                    const f32x4 xv = *(const f32x4*)(x + (size_t)row * 1024 + c); const f32x4 xn = (xv - mu) * rs * gg + bb;
                    *(f32x4*)(Z + (size_t)row * 1024 + c) = xn * ALPHA + gm * acc[ai][bj][m][n]; } }
    } };
struct FEpiUG { static constexpr bool PERM = true, AFTER_DRAIN = false; bf16_t* UG;
    __device__ __forceinline__ void operator()(AccT acc, const pg8::Unit& u, int wr, int wc, int fr, int fq) const {
        const int row0 = u.pm * 256 + wr * 64 + fr, c0 = u.pn * 256 + wc * 32 + 8 * fq;
#pragma unroll
        EPI_ROWS { bf16_t* rp = UG + (size_t)(row0 + ai * 128 + m * 16) * 5632 + c0; *(u32x4*)rp = pack8(acc[ai][0][m][0], acc[ai][0][m][1]); *(u32x4*)(rp + 128) = pack8(acc[ai][1][m][0], acc[ai][1][m][1]); }
    } };
struct FEpiZ2 { static constexpr bool PERM = true, AFTER_DRAIN = false; float* Z; const float* MOD;
    __device__ __forceinline__ void operator()(AccT acc, const pg8::Unit& u, int wr, int wc, int fr, int fq) const {
        const int row0 = u.pm * 256 + wr * 64 + fr, c0 = u.pn * 256 + wc * 32 + 8 * fq;
        const float* g2 = MOD + (u.pm / (SEQ / 256)) * 6144 + 5120;
#pragma unroll
        for (int bj = 0; bj < 2; ++bj)
#pragma unroll
            for (int n = 0; n < 2; ++n) { const int c = c0 + bj * 128 + n * 4; const f32x4 gm = *(const f32x4*)(g2 + c);
#pragma unroll
                EPI_ROWS { float* zp = Z + (size_t)(row0 + ai * 128 + m * 16) * 1024 + c; *(f32x4*)zp = *(const f32x4*)zp * ALPHA + gm * acc[ai][bj][m][n]; } }
    } };
template <class Epi> __device__ __forceinline__ void fast_gemm(unsigned char* lds, const bf16_t* A, const bf16_t* Bt, int M, int N, int K, const Epi& E) {
    pg8::Gemm g{A, Bt, M, N, K}; pg8::StaticOrder S; S.init(M, N, (int)gridDim.x, (int)blockIdx.x);
    pg8::gemm_phase<Epi, pg8::StaticOrder, true, true>((PG8_LAS unsigned char*)lds, g, S, E);
    __syncthreads();
}

namespace fa {
using bf16x8 = __attribute__((ext_vector_type(8))) short;
using s16x4  = __attribute__((ext_vector_type(4))) short;
using f32x16 = __attribute__((ext_vector_type(16))) float;
using u32x4  = __attribute__((ext_vector_type(4))) unsigned;
constexpr int NW = 8, QBLK = 32, KVBLK = 64, LD = 1024, NT = 68;
constexpr float THR = 8.f;
constexpr int SHM_V = KVBLK * 128 * 2, SHM_K = KVBLK * 64 * 2;
constexpr int OFF_K = 2 * SHM_V, OFF_WS = OFF_K + 2 * SHM_K, OFF_OST = OFF_WS + NW * 64 * 4, SHM_ATTN = OFF_OST + NW * 8192;
#define KSWZ64(row, colB) ((row) * 128 + ((colB) ^ ((((row) >> 1) & 7) << 4)))
#define SBAR() __builtin_amdgcn_sched_barrier(0)
__device__ __forceinline__ int crow(int r, int hi) { return (r & 3) + 8 * (r >> 2) + 4 * hi; }
__device__ __forceinline__ unsigned cvtpk(float lo, float hi) { unsigned r; asm volatile("v_cvt_pk_bf16_f32 %0, %1, %2" : "=v"(r) : "v"(lo), "v"(hi)); return r; }
__device__ __forceinline__ void partialSM(f32x16& p0, f32x16& p1, float& m_reg, float& mn, float& alpha) {
  constexpr float C = 1.4426950408889634f;
  float pmax = p0[0];
#pragma unroll
  for (int r = 1; r < 16; ++r) pmax = fmaxf(pmax, p0[r]);
#pragma unroll
  for (int r = 0; r < 16; ++r) pmax = fmaxf(pmax, p1[r]);
  { auto rr = __builtin_amdgcn_permlane32_swap(__float_as_uint(pmax), __float_as_uint(pmax), false, false);
    pmax = fmaxf(__uint_as_float(rr[0]), __uint_as_float(rr[1])); }
  if (__builtin_expect(__all(pmax - m_reg <= THR), 1)) { mn = m_reg; alpha = 1.f; }
  else { mn = fmaxf(m_reg, pmax); alpha = __builtin_amdgcn_exp2f((m_reg - mn) * C); m_reg = mn; }
  float mnC = -mn * C;
#pragma unroll
  for (int r = 0; r < 16; ++r) p0[r] = fmaf(p0[r], C, mnC);
#pragma unroll
  for (int r = 0; r < 16; ++r) p1[r] = fmaf(p1[r], C, mnC);
#pragma unroll
  for (int r = 0; r < 16; ++r) p0[r] = __builtin_amdgcn_exp2f(p0[r]);
}
__device__ __forceinline__ void finishSM(f32x16& p0, f32x16& p1, float alpha, float& l_reg, bf16x8& pa0, bf16x8& pa1, bf16x8& pa2, bf16x8& pa3) {
#pragma unroll
  for (int r = 0; r < 16; ++r) p1[r] = __builtin_amdgcn_exp2f(p1[r]);
  float ps = 0;
#pragma unroll
  for (int r = 0; r < 16; ++r) ps += p0[r];
#pragma unroll
  for (int r = 0; r < 16; ++r) ps += p1[r];
  { auto rr = __builtin_amdgcn_permlane32_swap(__float_as_uint(ps), __float_as_uint(ps), false, false);
    ps = __uint_as_float(rr[0]) + __uint_as_float(rr[1]); }
  l_reg = l_reg * alpha + ps;
#define PK4(P, BASE, OUT) do { unsigned a0 = cvtpk(P[BASE + 0], P[BASE + 1]), a1 = cvtpk(P[BASE + 2], P[BASE + 3]);   \
    unsigned b0 = cvtpk(P[BASE + 4], P[BASE + 5]), b1 = cvtpk(P[BASE + 6], P[BASE + 7]);                              \
    auto r0 = __builtin_amdgcn_permlane32_swap(a0, b0, false, false); auto r1 = __builtin_amdgcn_permlane32_swap(a1, b1, false, false); \
    u32x4 w = {r0[0], r1[0], r0[1], r1[1]}; OUT = *reinterpret_cast<bf16x8*>(&w); } while (0)
  PK4(p0, 0, pa0); PK4(p0, 8, pa1); PK4(p1, 0, pa2); PK4(p1, 8, pa3);
#undef PK4
}
__device__ __forceinline__ void qkt(f32x16& p0, f32x16& p1, const char* Ks, const bf16x8* qr, int r32, int hi) {
  p0 = f32x16{}; p1 = f32x16{};
#pragma unroll
  for (int d0 = 0; d0 < 4; ++d0) { const int cb = (d0 * 16 + hi * 8) * 2;
    bf16x8 b0 = *reinterpret_cast<const bf16x8*>(Ks + KSWZ64(r32, cb));
    bf16x8 b1 = *reinterpret_cast<const bf16x8*>(Ks + KSWZ64(32 + r32, cb));
    p0 = __builtin_amdgcn_mfma_f32_32x32x16_bf16(b0, qr[d0], p0, 0, 0, 0);
    p1 = __builtin_amdgcn_mfma_f32_32x32x16_bf16(b1, qr[d0], p1, 0, 0, 0); }
}
__device__ __forceinline__ int v_st(int k, int c) { const int kk = (k & ~0xC) | ((k & 4) << 1) | ((k & 8) >> 1); return ((kk >> 3) * 4 + (c >> 5)) * 512 + ((kk & 7) * 32 + (c & 31)) * 2; }
__device__ __forceinline__ int v_rd_base(int lane) { return ((lane & 3) << 3) | (((lane >> 2) & 3) << 6) | (((lane >> 4) & 1) << 5) | (((lane >> 5) & 1) << 8); }
constexpr int v_rd_off(int d0, int ks, int half) { return d0 * 512 + ks * 4096 + half * 2048; }
template <int OFF> __device__ __forceinline__ s16x4 tr_read(int vb) { s16x4 r; asm volatile("ds_read_b64_tr_b16 %0, %1 offset:%2" : "=&v"(r) : "v"(vb), "i"(OFF) : "memory"); return r; }
template <int D0> __device__ __forceinline__ void pv_one(f32x16& od, int vb, bf16x8 pa0, bf16x8 pa1, bf16x8 pa2, bf16x8 pa3) {
  const s16x4 l0 = tr_read<v_rd_off(D0, 0, 0)>(vb), h0 = tr_read<v_rd_off(D0, 0, 1)>(vb), l1 = tr_read<v_rd_off(D0, 1, 0)>(vb), h1 = tr_read<v_rd_off(D0, 1, 1)>(vb);
  const s16x4 l2 = tr_read<v_rd_off(D0, 2, 0)>(vb), h2 = tr_read<v_rd_off(D0, 2, 1)>(vb), l3 = tr_read<v_rd_off(D0, 3, 0)>(vb), h3 = tr_read<v_rd_off(D0, 3, 1)>(vb);
  asm volatile("s_waitcnt lgkmcnt(0)" ::: "memory"); SBAR();
#define PK(L, H) (bf16x8){L[0], L[1], L[2], L[3], H[0], H[1], H[2], H[3]}
  od = __builtin_amdgcn_mfma_f32_32x32x16_bf16(pa0, PK(l0, h0), od, 0, 0, 0);
  od = __builtin_amdgcn_mfma_f32_32x32x16_bf16(pa1, PK(l1, h1), od, 0, 0, 0);
  od = __builtin_amdgcn_mfma_f32_32x32x16_bf16(pa2, PK(l2, h2), od, 0, 0, 0);
  od = __builtin_amdgcn_mfma_f32_32x32x16_bf16(pa3, PK(l3, h3), od, 0, 0, 0);
#undef PK
}
__device__ __forceinline__ void pv_d0(f32x16* o, int vb, bf16x8 pa0, bf16x8 pa1, bf16x8 pa2, bf16x8 pa3) {
  pv_one<0>(o[0], vb, pa0, pa1, pa2, pa3); pv_one<1>(o[1], vb, pa0, pa1, pa2, pa3); pv_one<2>(o[2], vb, pa0, pa1, pa2, pa3); pv_one<3>(o[3], vb, pa0, pa1, pa2, pa3);
}

__device__ __forceinline__ void attn_unit(int b, int h, int qb, const bf16_t* __restrict__ QD, const bf16_t* __restrict__ KD, const bf16_t* __restrict__ VD, bf16_t* __restrict__ AD,
                                          float lam, const float* __restrict__ gsub, char* lds) {
  int tid_ = threadIdx.x; asm volatile("" : "+v"(tid_));
  const int tid = tid_, wid = tid >> 6, lane = tid & 63, r32 = lane & 31, hi = lane >> 5;
  char* V_lds = lds; char* K_lds = lds + OFF_K;
  float* ws = (float*)(lds + OFF_WS) + wid * 64; float* li_l = ws; float* al_l = ws + 32;
  char* ost = lds + OFF_OST + wid * 8192;
  const long qrow0 = (long)b * SEQ + qb * 256;
  const int sr = tid >> 4, sc = (tid & 15) * 8, vst0 = v_st(sr, sc);
  const int kr = tid >> 3, kc = (tid & 7) * 8, kst = KSWZ64(kr, kc * 2);
  const int koff = kr * LD + kc, voff = sr * LD + sc;
  const int vb0 = (int)(uintptr_t)V_lds + v_rd_base(lane);
#pragma unroll 1
  for (int c = 0; c < 2; ++c) {
    float m_reg = -1e30f, l_reg = 0; f32x16 o[4] = {}; bf16x8 qr[4];
    const bf16_t* Qw = QD + (qrow0 + wid * QBLK + r32) * LD + h * 128 + c * 64 + hi * 8;
#pragma unroll
    for (int d0 = 0; d0 < 4; ++d0) qr[d0] = *reinterpret_cast<const bf16x8*>(Qw + d0 * 16);
    const bf16_t* Kl = KD + (long)b * SEQ * LD + h * 128 + c * 64;
    const bf16_t* Kc = KD + ((long)ML + b * CTX) * LD + h * 128 + c * 64;
    const bf16_t* Vl = VD + (long)b * SEQ * LD + h * 128;
    const bf16_t* Vc = VD + ((long)ML + b * CTX) * LD + h * 128;
    constexpr int SDEPTH = 1;
    struct { bf16x8 vs0, vs1, ks; } sr_[SDEPTH];
#define SLOAD(i, j) do { const long to_ = ((j) < 64) ? (long)(j) * (64 * LD) : (long)((j) - 64) * (64 * LD); const bf16_t* kp_ = ((j) < 64 ? Kl : Kc) + to_; const bf16_t* vp_ = ((j) < 64 ? Vl : Vc) + to_; \
    sr_[i].vs0 = *reinterpret_cast<const bf16x8*>(vp_ + voff); sr_[i].vs1 = *reinterpret_cast<const bf16x8*>(vp_ + voff + 32 * LD); sr_[i].ks = *reinterpret_cast<const bf16x8*>(kp_ + koff); } while (0)
#define SWRITE(bb, i) do { *(bf16x8*)(V_lds + (bb) * SHM_V + vst0) = sr_[i].vs0; *(bf16x8*)(V_lds + (bb) * SHM_V + vst0 + 8192) = sr_[i].vs1; *(bf16x8*)(K_lds + (bb) * SHM_K + kst) = sr_[i].ks; } while (0)
#define SWAIT() do { if constexpr (SDEPTH == 2) asm volatile("s_waitcnt vmcnt(3)" ::: "memory"); else asm volatile("s_waitcnt vmcnt(0)" ::: "memory"); } while (0)
#define RESC(a) do { if (__any((a) < 1.f)) { if (hi == 0) al_l[r32] = (a); asm volatile("s_waitcnt lgkmcnt(0)" ::: "memory"); \
    _Pragma("unroll") for (int d = 0; d < 4; ++d) _Pragma("unroll") for (int r = 0; r < 16; ++r) o[d][r] *= al_l[crow(r, hi)]; } } while (0)
    f32x16 pA0, pA1, pB0, pB1; float mnA, mnB, alA, alB; bf16x8 pa0, pa1, pa2, pa3;
    constexpr int SE = 0, SO = SDEPTH - 1;
    SLOAD(SE, 0); asm volatile("s_waitcnt vmcnt(0)" ::: "memory"); SWRITE(0, SE); __syncthreads();
    qkt(pA0, pA1, K_lds, qr, r32, hi); partialSM(pA0, pA1, m_reg, mnA, alA);
    SLOAD(SO, 1); if constexpr (SDEPTH == 2) SLOAD(SE, 2);
    SWAIT(); SWRITE(1, SO); __syncthreads();
    for (int j = 1; j + 1 < NT; j += 2) {
      SBAR(); qkt(pB0, pB1, K_lds + SHM_K, qr, r32, hi);
      finishSM(pA0, pA1, alA, l_reg, pa0, pa1, pa2, pa3); SBAR();
      SLOAD(SO, j + SDEPTH); SBAR();
      pv_d0(o, vb0, pa0, pa1, pa2, pa3); partialSM(pB0, pB1, m_reg, mnB, alB);
      __syncthreads(); SWAIT(); SWRITE(0, SE);
      RESC(alB); __syncthreads();
      SBAR(); qkt(pA0, pA1, K_lds, qr, r32, hi);
      finishSM(pB0, pB1, alB, l_reg, pa0, pa1, pa2, pa3); SBAR();
      if (SDEPTH == 1 || j + 3 < NT) SLOAD(SE, j + 1 + SDEPTH); SBAR();
      pv_d0(o, vb0 + SHM_V, pa0, pa1, pa2, pa3); partialSM(pA0, pA1, m_reg, mnA, alA);
      __syncthreads(); SWAIT(); SWRITE(1, SO);
      RESC(alA); __syncthreads();
    }
    SBAR(); qkt(pB0, pB1, K_lds + SHM_K, qr, r32, hi);
    finishSM(pA0, pA1, alA, l_reg, pa0, pa1, pa2, pa3); SBAR();
    pv_d0(o, vb0, pa0, pa1, pa2, pa3); partialSM(pB0, pB1, m_reg, mnB, alB);
    __syncthreads(); RESC(alB);
    finishSM(pB0, pB1, alB, l_reg, pa0, pa1, pa2, pa3); SBAR();
    pv_d0(o, vb0 + SHM_V, pa0, pa1, pa2, pa3);
#undef SLOAD
#undef SWRITE
#undef SWAIT
#undef RESC
    if (hi == 0) li_l[r32] = l_reg; asm volatile("s_waitcnt lgkmcnt(0)" ::: "memory");
    float rli[16];
#pragma unroll
    for (int r = 0; r < 16; ++r) rli[r] = __builtin_amdgcn_rcpf(li_l[crow(r, hi)]);
    unsigned* pst = (unsigned*)ost;
    if (c == 0) {
#pragma unroll
      for (int d0 = 0; d0 < 4; ++d0)
#pragma unroll
        for (int rp = 0; rp < 8; ++rp) pst[(d0 * 8 + rp) * 64 + lane] = cvtpk(o[d0][2 * rp] * rli[2 * rp], o[d0][2 * rp + 1] * rli[2 * rp + 1]);
    } else {
#pragma unroll
      for (int d0 = 0; d0 < 4; ++d0)
#pragma unroll
        for (int rp = 0; rp < 8; ++rp) { const unsigned w = pst[(d0 * 8 + rp) * 64 + lane];
          o[d0][2 * rp] = __uint_as_float(w << 16) - lam * (o[d0][2 * rp] * rli[2 * rp]); o[d0][2 * rp + 1] = __uint_as_float(w & 0xffff0000u) - lam * (o[d0][2 * rp + 1] * rli[2 * rp + 1]); }
      asm volatile("s_waitcnt lgkmcnt(0)" ::: "memory");
      float* stf = (float*)ost;
      const int ch = lane & 15, rq = lane >> 4;
      f32x4 g0 = *(const f32x4*)(gsub + ch * 8), g1 = *(const f32x4*)(gsub + ch * 8 + 4); g0 = g0 * (1.f - LAM_INIT); g1 = g1 * (1.f - LAM_INIT);
#pragma unroll
      for (int rh = 0; rh < 2; ++rh) {
#pragma unroll
        for (int rr = 0; rr < 8; ++rr) { const int lr = (rr & 3) + 8 * (rr >> 2) + 4 * hi;
#pragma unroll
          for (int d0 = 0; d0 < 4; ++d0) stf[lr * 128 + d0 * 32 + r32] = o[d0][rh * 8 + rr]; }
        asm volatile("s_waitcnt lgkmcnt(0)" ::: "memory");
#pragma unroll
        for (int i = 0; i < 4; ++i) { const int row = i * 4 + rq;
          f32x4 v0 = *(const f32x4*)(stf + row * 128 + ch * 8), v1 = *(const f32x4*)(stf + row * 128 + ch * 8 + 4);
          float ss = (v0[0] * v0[0] + v0[1] * v0[1]) + (v0[2] * v0[2] + v0[3] * v0[3]) + (v1[0] * v1[0] + v1[1] * v1[1]) + (v1[2] * v1[2] + v1[3] * v1[3]);
          ss += __shfl_xor(ss, 1); ss += __shfl_xor(ss, 2); ss += __shfl_xor(ss, 4); ss += __shfl_xor(ss, 8);
          const float rs = 1.f / sqrtf(ss * (1.f / 128.f) + LN_EPS);
          v0 = v0 * rs * g0; v1 = v1 * rs * g1;
          u32x4 w; w.x = cvtpk(v0[0], v0[1]); w.y = cvtpk(v0[2], v0[3]); w.z = cvtpk(v1[0], v1[1]); w.w = cvtpk(v1[2], v1[3]);
          *(u32x4*)(AD + (qrow0 + wid * QBLK + rh * 16 + row) * LD + h * 128 + ch * 8) = w; }
        asm volatile("s_waitcnt lgkmcnt(0)" ::: "memory");
      }
    }
    __syncthreads();
  }
}
#undef KSWZ64
#undef SBAR
}
__device__ __forceinline__ void d_attn_fast(const Ctx& C, const bf16_t* __restrict__ QD, const bf16_t* __restrict__ KD, const bf16_t* __restrict__ VD, bf16_t* __restrict__ AD,
                                            const float* __restrict__ SCAL, const float* __restrict__ gsub) {
  const float lam = SCAL[0];
  const int vcu = (C.G % 8 == 0) ? (C.bx % 8) * (C.G / 8) + C.bx / 8 : C.bx;
  for (int i = 0; (long)i * C.G + vcu < 1024; ++i) {
    int bh, qb;
    if (C.G == 256) { bh = (vcu >> 5) * 8 + i * 2 + ((vcu & 31) >> 4); qb = vcu & 15; }
    else { const int L = i * C.G + vcu; bh = L >> 4; qb = L & 15; }
    fa::attn_unit(bh >> 3, bh & 7, qb, QD, KD, VD, AD, lam, gsub, (char*)C.lds);
  }
}

namespace rt {
typedef __attribute__((address_space(3))) unsigned char* lptr;
typedef short v4i16_t __attribute__((ext_vector_type(4)));
typedef unsigned u32x2 __attribute__((ext_vector_type(2)));
constexpr int RSQ = 544, RSV = 160;
constexpr int O_Q = 0, O_K = 64 * RSQ, O_ST = 2 * 64 * RSQ, O_V = 3 * 64 * RSQ, O_VP = O_V + 64 * RSV, O_P = O_VP + 64 * RSV, O_END = O_P + 64 * RSV;
constexpr int NSTEP = 68;
__device__ __forceinline__ bf16x8 ld128(lptr p) { return *(const __attribute__((address_space(3))) bf16x8*)p; }
__device__ __forceinline__ bf16x8 trfrag(lptr lo, lptr hi) {
    const v4i16_t a = __builtin_amdgcn_ds_read_tr16_b64_v4i16((__attribute__((address_space(3))) v4i16_t*)lo), b = __builtin_amdgcn_ds_read_tr16_b64_v4i16((__attribute__((address_space(3))) v4i16_t*)hi);
    return (bf16x8){a[0], a[1], a[2], a[3], b[0], b[1], b[2], b[3]}; }
__device__ __forceinline__ u32x2 pack4(const f32x4& v) { u32x2 w; w.x = cvtpk(v[0], v[1]); w.y = cvtpk(v[2], v[3]); return w; }
#define MFMA16(a, b, c) __builtin_amdgcn_mfma_f32_16x16x32_bf16((a), (b), (c), 0, 0, 0)

__device__ __forceinline__ void ret_stream(int b, int h, int vs, const bf16_t* __restrict__ QR, const bf16_t* __restrict__ KR, const bf16_t* __restrict__ VR, bf16_t* __restrict__ YR,
                                           const float* __restrict__ SCAL, unsigned char* lds_) {
    int tid_ = threadIdx.x; asm volatile("" : "+v"(tid_));
    const int tid = tid_, w = __builtin_amdgcn_readfirstlane(tid >> 6), lane = tid & 63, fr = lane & 15, fq = lane >> 4;
    const lptr lds = (lptr)lds_;
    const float L2E = 1.4426950408889634f, lgf2 = SCAL[1 + h] * L2E, lgb2 = SCAL[5 + h] * L2E;
    const int ct = w & 3, it0 = 2 * (w >> 2), jt = w & 3;
    const int qrow = tid >> 5, qch = tid & 31, vrow = tid >> 3, vch = tid & 7;
    const int li4 = (fr >> 2), lip = (fr & 3);
    const lptr pS = lds + O_ST + (16 * ct + fr) * RSQ + 16 * fq;
    const lptr pQ0 = lds + O_Q + (16 * it0 + fr) * RSQ + 16 * fq, pQ1 = pQ0 + 16 * RSQ;
    const lptr pK = lds + O_K + (16 * jt + fr) * RSQ + 16 * fq;
    const lptr pPw = lds + O_P + (16 * it0 + fr) * RSV + (16 * jt + 4 * fq) * 2;
    const lptr pPr = lds + O_P + (16 * it0 + fr) * RSV + (4 * fq) * 2;
    const lptr pVt = lds + O_V + (4 * fq + li4) * RSV + (16 * ct + 4 * lip) * 2;
    const lptr pKt = lds + O_K + (4 * fq + li4) * RSQ + (32 * w + 4 * lip) * 2;
    const lptr pVPt = lds + O_VP + (4 * fq + li4) * RSV + (4 * lip) * 2;
    const lptr pSTw = lds + O_ST + fr * RSQ + (32 * w + 4 * fq) * 2;
#pragma unroll 1
    for (int pass = 0; pass < 2; ++pass) {
        const float lg2 = pass ? lgb2 : lgf2, ds = __builtin_amdgcn_exp2f(lg2 * 64.f);
        const float dkv = __builtin_amdgcn_exp2f(lg2 * (pass ? (float)vrow : (float)(63 - vrow)));
        float dq[2], msk[2][4];
#pragma unroll
        for (int t = 0; t < 2; ++t) { const int i = 16 * (it0 + t) + fr; dq[t] = __builtin_amdgcn_exp2f(lg2 * (pass ? (float)(64 - i) : (float)(i + 1)));
#pragma unroll
            for (int r = 0; r < 4; ++r) { const int j = 16 * jt + 4 * fq + r, dd = i - j; msk[t][r] = dd > 0 ? __builtin_amdgcn_exp2f(lgf2 * (float)dd) : (dd < 0 ? __builtin_amdgcn_exp2f(lgb2 * (float)(-dd)) : 2.f); } }
        f32x4 S[2][4];
#pragma unroll
        for (int dt = 0; dt < 2; ++dt)
#pragma unroll
            for (int c4 = 0; c4 < 4; ++c4) S[dt][c4] = (f32x4){0.f, 0.f, 0.f, 0.f};
        bf16x8 stq[4], stk[4], stv;
#define RT_ROWBASE(step, rb, lat) do { if ((step) < 4) { const int cc_ = pass ? 3 - (step) : (step); rb = ML + b * CTX + cc_ * 64; lat = false; } \
            else { const int n_ = pass ? (NSTEP - 1) - (step) : (step) - 4; rb = b * SEQ + n_ * 64; lat = true; } } while (0)
#define RT_LOAD(step) do { int rb_; bool lat_; RT_ROWBASE(step, rb_, lat_); \
            _Pragma("unroll") for (int k = 0; k < 4; ++k) { stk[k] = *(const bf16x8*)(KR + (size_t)(rb_ + qrow + 16 * k) * 1024 + h * 256 + qch * 8); \
                if (lat_) stq[k] = *(const bf16x8*)(QR + (size_t)(rb_ + qrow + 16 * k) * 1024 + h * 256 + qch * 8); } \
            stv = *(const bf16x8*)(VR + (size_t)(rb_ + vrow) * 2048 + h * 512 + vs * 64 + vch * 8); } while (0)
#define RT_WRITE(step) do { int rb_; bool lat_; RT_ROWBASE(step, rb_, lat_); (void)rb_; \
            _Pragma("unroll") for (int k = 0; k < 4; ++k) { *(__attribute__((address_space(3))) bf16x8*)(lds + O_K + (qrow + 16 * k) * RSQ + qch * 16) = stk[k]; \
                if (lat_) *(__attribute__((address_space(3))) bf16x8*)(lds + O_Q + (qrow + 16 * k) * RSQ + qch * 16) = stq[k]; } \
            *(__attribute__((address_space(3))) bf16x8*)(lds + O_V + vrow * RSV + vch * 16) = stv; \
            { f32x4 a_, b_; unpack8(__builtin_bit_cast(u32x4, stv), a_, b_); a_ = a_ * dkv; b_ = b_ * dkv; const u32x4 w_ = pack8(a_, b_); \
              *(__attribute__((address_space(3))) u32x4*)(lds + O_VP + vrow * RSV + vch * 16) = w_; } } while (0)
        RT_LOAD(0); RT_WRITE(0);
#pragma unroll 1
        for (int step = 0; step < NSTEP; ++step) {
            int rowbase; bool lat; RT_ROWBASE(step, rowbase, lat);
            __syncthreads();
            if (step + 1 < NSTEP) RT_LOAD(step + 1);
            if (lat) {
                bf16_t* yp0 = YR + (size_t)(rowbase + 16 * it0 + fr) * 2048 + h * 512 + vs * 64 + 16 * ct + 4 * fq; bf16_t* yp1 = yp0 + (size_t)16 * 2048;
                u32x2 yo0 = {0u, 0u}, yo1 = {0u, 0u};
                if (pass) { yo0 = *(const u32x2*)yp0; yo1 = *(const u32x2*)yp1; }
                f32x4 ay0 = {0.f, 0.f, 0.f, 0.f}, ay1 = ay0, ap0 = ay0, ap1 = ay0;
#pragma unroll
                for (int ks = 0; ks < 8; ++ks) {
                    const bf16x8 as = ld128(pS + 64 * ks), q0 = ld128(pQ0 + 64 * ks), q1 = ld128(pQ1 + 64 * ks);
                    ay0 = MFMA16(as, q0, ay0); ay1 = MFMA16(as, q1, ay1);
                    if (pass == 0) { const bf16x8 ak = ld128(pK + 64 * ks); ap0 = MFMA16(ak, q0, ap0); ap1 = MFMA16(ak, q1, ap1); }
                }
                ay0 = ay0 * dq[0]; ay1 = ay1 * dq[1];
                if (pass == 0) {
#pragma unroll
                    for (int r = 0; r < 4; ++r) { ap0[r] *= msk[0][r]; ap1[r] *= msk[1][r]; }
                    *(__attribute__((address_space(3))) u32x2*)(pPw) = pack4(ap0); *(__attribute__((address_space(3))) u32x2*)(pPw + 16 * RSV) = pack4(ap1);
                    __syncthreads();
#pragma unroll
                    for (int ks = 0; ks < 2; ++ks) {
                        const bf16x8 av = trfrag(pVt + ks * 32 * RSV, pVt + ks * 32 * RSV + 16 * RSV);
                        const u32x2 l0 = *(const __attribute__((address_space(3))) u32x2*)(pPr + ks * 64), h0 = *(const __attribute__((address_space(3))) u32x2*)(pPr + ks * 64 + 32);
                        const u32x2 l1 = *(const __attribute__((address_space(3))) u32x2*)(pPr + 16 * RSV + ks * 64), h1 = *(const __attribute__((address_space(3))) u32x2*)(pPr + 16 * RSV + ks * 64 + 32);
                        const u32x4 b0 = {l0.x, l0.y, h0.x, h0.y}, b1 = {l1.x, l1.y, h1.x, h1.y};
                        ay0 = MFMA16(av, __builtin_bit_cast(bf16x8, b0), ay0); ay1 = MFMA16(av, __builtin_bit_cast(bf16x8, b1), ay1);
                    }
                    *(u32x2*)yp0 = pack4(ay0); *(u32x2*)yp1 = pack4(ay1);
                } else {
                    f32x4 o0, o1;
                    o0[0] = __uint_as_float(yo0.x << 16); o0[1] = __uint_as_float(yo0.x & 0xffff0000u); o0[2] = __uint_as_float(yo0.y << 16); o0[3] = __uint_as_float(yo0.y & 0xffff0000u);
                    o1[0] = __uint_as_float(yo1.x << 16); o1[1] = __uint_as_float(yo1.x & 0xffff0000u); o1[2] = __uint_as_float(yo1.y << 16); o1[3] = __uint_as_float(yo1.y & 0xffff0000u);
                    *(u32x2*)yp0 = pack4(ay0 + o0); *(u32x2*)yp1 = pack4(ay1 + o1);
                }
            }
#pragma unroll
            for (int dt = 0; dt < 2; ++dt)
#pragma unroll
                for (int c4 = 0; c4 < 4; ++c4) S[dt][c4] = S[dt][c4] * ds;
#pragma unroll
            for (int ks = 0; ks < 2; ++ks) {
                bf16x8 ak[2], bv[4];
#pragma unroll
                for (int dt = 0; dt < 2; ++dt) ak[dt] = trfrag(pKt + dt * 32 + ks * 32 * RSQ, pKt + dt * 32 + ks * 32 * RSQ + 16 * RSQ);
#pragma unroll
                for (int c4 = 0; c4 < 4; ++c4) bv[c4] = trfrag(pVPt + c4 * 32 + ks * 32 * RSV, pVPt + c4 * 32 + ks * 32 * RSV + 16 * RSV);
#pragma unroll
                for (int dt = 0; dt < 2; ++dt)
#pragma unroll
                    for (int c4 = 0; c4 < 4; ++c4) S[dt][c4] = MFMA16(ak[dt], bv[c4], S[dt][c4]);
            }
            __syncthreads();
#pragma unroll
            for (int dt = 0; dt < 2; ++dt)
#pragma unroll
                for (int c4 = 0; c4 < 4; ++c4) *(__attribute__((address_space(3))) u32x2*)(pSTw + c4 * 16 * RSQ + dt * 32) = pack4(S[dt][c4]);
            if (step + 1 < NSTEP) RT_WRITE(step + 1);
        }
        __syncthreads();
#undef RT_ROWBASE
#undef RT_LOAD
#undef RT_WRITE
    }
}
#undef MFMA16
}
__device__ __forceinline__ void d_ret_fast(const Ctx& C, const bf16_t* __restrict__ QR, const bf16_t* __restrict__ KR, const bf16_t* __restrict__ VR, bf16_t* __restrict__ YR, const float* __restrict__ SCAL) {
    for (int sid = C.bx; sid < 256; sid += C.G) rt::ret_stream(sid >> 5, (sid >> 3) & 3, sid & 7, QR, KR, VR, YR, SCAL, C.lds);
}


typedef __attribute__((address_space(1))) unsigned gu32;
#define RLX_AGENT __ATOMIC_RELAXED, __HIP_MEMORY_SCOPE_AGENT
#define XB_TMO      128
#define XB_XCNT(j)  (256  + 64 * (j))
#define XB_XSUB(j)  (1280 + 64 * (j))
#define XB_XGEN(j)  (2304 + 64 * (j))
#define XB_TOP      3328
#define XB_TOPGEN   3392
#define XCD_BAR_WORDS 3456
#define XB_SPIN_CAP (1u << 18)

__device__ __forceinline__ unsigned xb_ld(unsigned* p)              { return __hip_atomic_load(p, __ATOMIC_RELAXED, __HIP_MEMORY_SCOPE_AGENT); }
__device__ __forceinline__ unsigned xb_add(unsigned* p, unsigned v) { return __hip_atomic_fetch_add(p, v, __ATOMIC_RELAXED, __HIP_MEMORY_SCOPE_AGENT); }
__device__ __forceinline__ unsigned xb_xcc_id() { return (unsigned)__builtin_amdgcn_s_getreg((3 << 11) | 20) & 0xFu; }
#define XB_SPIN(cond, bar) do { unsigned _sp = 0; while (cond) { __builtin_amdgcn_s_sleep(1); \
    if ((++_sp & 255u) == 0u) { if (xb_ld(&(bar)[XB_TMO])) break; if (_sp > XB_SPIN_CAP) { atomicAdd(&(bar)[XB_TMO], 1u); break; } } } } while (0)

struct XcdBarrier {
    unsigned* bar; unsigned x;
    volatile LAS unsigned* st;
};

__device__ __forceinline__ XcdBarrier xcd_barrier_post(unsigned* bar, volatile LAS unsigned* st) {
    XcdBarrier b; b.bar = bar; b.x = xb_xcc_id(); b.st = st;
    if (threadIdx.x == 0) (void)xb_add(&bar[XB_XCNT(b.x)], 1u);
    return b;
}
__device__ __forceinline__ void xcd_barrier_complete(unsigned* bar, unsigned x, unsigned& nloc, unsigned& nx) {
    const unsigned G = gridDim.x * gridDim.y * gridDim.z;
    unsigned sum, cnt, mine, sp = 0u;
    for (;;) {
        sum = 0u; cnt = 0u; mine = 0u;
#pragma unroll
        for (unsigned j = 0; j < 16; ++j) { const unsigned c = xb_ld(&bar[XB_XCNT(j)]); sum += c; cnt += (c > 0u) ? 1u : 0u; mine = (j == x) ? c : mine; }
        if (sum == G) break;
        __builtin_amdgcn_s_sleep(1);
        if ((++sp & 255u) == 0u) { if (xb_ld(&bar[XB_TMO])) break; if (sp > XB_SPIN_CAP) { atomicAdd(&bar[XB_TMO], 1u); break; } }
    }
    nloc = mine > 0u ? mine : 1u; nx = cnt > 0u ? cnt : 1u;
}

__device__ __forceinline__ void xcd_barrier(const XcdBarrier& b) {
    asm volatile("s_waitcnt vmcnt(0)" ::: "memory");
    __syncthreads();
    if (threadIdx.x == 0) {
        unsigned* bar = b.bar;
        __builtin_amdgcn_s_waitcnt(0);
        unsigned nloc = b.st[0], nx = b.st[1];
        if (nloc == 0u) { xcd_barrier_complete(bar, b.x, nloc, nx); b.st[0] = nloc; b.st[1] = nx; }
        const unsigned old = xb_add(&bar[XB_XSUB(b.x)], 1u);
        const unsigned gen = old / nloc;
        if (old + 1u == (gen + 1u) * nloc) {
            __builtin_amdgcn_fence(__ATOMIC_RELEASE, "agent");
            asm volatile("s_waitcnt vmcnt(0)" ::: "memory");
            const unsigned og = xb_add(&bar[XB_TOP], 1u);
            const unsigned tg = og / nx;
            if (og + 1u == (tg + 1u) * nx) xb_add(&bar[XB_TOPGEN], 1u);
            else XB_SPIN(xb_ld(&bar[XB_TOPGEN]) == tg, bar);
            __builtin_amdgcn_fence(__ATOMIC_ACQUIRE, "agent");
            xb_add(&bar[XB_XGEN(b.x)], 1u);
            asm volatile("s_waitcnt vmcnt(0)" ::: "memory");
        } else {
            XB_SPIN(xb_ld(&bar[XB_XGEN(b.x)]) == gen, bar);
            __builtin_amdgcn_fence(__ATOMIC_ACQUIRE, "agent");
            asm volatile("s_waitcnt vmcnt(0)" ::: "memory");
        }
    }
    __syncthreads();
}


__device__ __forceinline__ f32x4 gelu4(const f32x4& u) { f32x4 r;
#pragma unroll
    for (int i = 0; i < 4; ++i) r[i] = 0.5f * u[i] * (1.f + erff(u[i] * 0.70710678118654752f));
    return r; }
__device__ __forceinline__ void d_convgate_v(const Ctx& C, const bf16_t* __restrict__ UG, int row_off, const float* __restrict__ cw, const float* __restrict__ cb, bf16_t* __restrict__ H) {
    constexpr int NFG = DFF / 8, RB = 8, NIT = NFG * ((ML / 2) / RB);
    for (int it = C.gt; it < NIT; it += C.NGT) {
        const int fg = it % NFG, rb = it / NFG, f = fg * 8, uc = (f >> 7) * 256 + (f & 127), lr0 = rb * RB;
        const f32x4 w0a = *(const f32x4*)(cw + f), w0b = *(const f32x4*)(cw + f + 4), w1a = *(const f32x4*)(cw + DFF + f), w1b = *(const f32x4*)(cw + DFF + f + 4);
        const f32x4 w2a = *(const f32x4*)(cw + 2 * DFF + f), w2b = *(const f32x4*)(cw + 2 * DFF + f + 4), ba = *(const f32x4*)(cb + f), bb = *(const f32x4*)(cb + f + 4);
        const int t0 = (row_off + lr0) & (SEQ - 1);
        f32x4 pa = {0.f, 0.f, 0.f, 0.f}, pb = pa, ca, cbv, na, nb;
        if (t0 > 0) unpack8(*(const u32x4*)(UG + (size_t)(lr0 - 1) * 5632 + uc), pa, pb);
        unpack8(*(const u32x4*)(UG + (size_t)lr0 * 5632 + uc), ca, cbv);
#pragma unroll
        for (int r = 0; r < RB; ++r) { const int lr = lr0 + r, t = t0 + r;
            if (t < SEQ - 1) unpack8(*(const u32x4*)(UG + (size_t)(lr + 1) * 5632 + uc), na, nb); else { na = (f32x4){0.f, 0.f, 0.f, 0.f}; nb = na; }
            f32x4 ga, gb; unpack8(*(const u32x4*)(UG + (size_t)lr * 5632 + uc + 128), ga, gb);
            const f32x4 ua = ba + w0a * pa + w1a * ca + w2a * na, ub = bb + w0b * pb + w1b * cbv + w2b * nb;
            *(u32x4*)(H + (size_t)(row_off + lr) * DFF + f) = pack8(gelu4(ua) * ga, gelu4(ub) * gb);
            pa = ca; pb = cbv; ca = na; cbv = nb; }
    }
}

constexpr int LDS_BYTES = 147456;
constexpr int LDS_MISC = 147456 - 64;
struct Params { const float* in[24]; float* out; unsigned char* ws; };
__global__ void __launch_bounds__(512, 2) mega(Params P) {
    extern __shared__ __attribute__((aligned(16))) unsigned char lds[];
    cg::grid_group grid = cg::this_grid();
    { volatile LAS unsigned* m_ = (volatile LAS unsigned*)((LAS unsigned char*)lds + LDS_MISC); if (threadIdx.x < 16) m_[threadIdx.x] = 0u; }
    __syncthreads();
    XcdBarrier bar = xcd_barrier_post((unsigned*)(P.ws + WS_BAR), (volatile LAS unsigned*)((LAS unsigned char*)lds + LDS_MISC));
#define GSYNC() xcd_barrier(bar)
#define CTX() Ctx C; { int t_ = threadIdx.x; asm volatile("" : "+v"(t_)); C.tid = t_; C.lane = C.tid & 63; C.wave = C.tid >> 6; C.bx = blockIdx.x; C.G = gridDim.x; \
    C.gw = C.bx * 8 + C.wave; C.NGW = C.G * 8; C.gt = C.bx * 512 + C.tid; C.NGT = C.G * 512; C.lds = lds; }
    const float* x = P.in[0]; const float* c = P.in[1]; const float* ctx = P.in[2]; const float* cctx = P.in[3];
    const float* lng = P.in[4]; const float* lnb = P.in[5]; const float* wmod = P.in[6]; const float* bmod = P.in[7];
    const float* win = P.in[8]; const float* bgate = P.in[9]; const float* logit = P.in[10]; const float* dlam = P.in[11];
    const float* gsub = P.in[12]; const float* wret = P.in[13]; const float* wdif = P.in[14]; const float* wo = P.in[15];
    const float* ln1g = P.in[16]; const float* ln1b = P.in[17]; const float* wup = P.in[18]; const float* cw = P.in[19];
    const float* cb = P.in[20]; const float* wdn = P.in[21]; const float* ln2g = P.in[22]; const float* ln2b = P.in[23];
    unsigned char* ws = P.ws; float* out = P.out;
    float* MOD = (float*)(ws + WS_MOD); float* TAB = (float*)(ws + WS_TAB); float* SCAL = (float*)(ws + WS_SCAL); float* STATS = (float*)(ws + WS_STATS); float* RS = (float*)(ws + WS_RS);
    bf16_t* WIN = (bf16_t*)(ws + WS_WIN); bf16_t* WRET = (bf16_t*)(ws + WS_WRET); bf16_t* WDIF = (bf16_t*)(ws + WS_WDIF); bf16_t* WO = (bf16_t*)(ws + WS_WO);
    bf16_t* WUP = (bf16_t*)(ws + WS_WUP); bf16_t* WDN = (bf16_t*)(ws + WS_WDN); bf16_t* XM = (bf16_t*)(ws + WS_XM);
    bf16_t* QR = (bf16_t*)(ws + WS_QR); bf16_t* KR = (bf16_t*)(ws + WS_KR); bf16_t* VR = (bf16_t*)(ws + WS_VR); float* SST = (float*)(ws + WS_SST);
    bf16_t* QD = (bf16_t*)(ws + WS_QD); bf16_t* KD = (bf16_t*)(ws + WS_KD); bf16_t* VD = (bf16_t*)(ws + WS_VD); bf16_t* OD = (bf16_t*)(ws + WS_OD); bf16_t* AD = (bf16_t*)(ws + WS_AD);
    bf16_t* SG = (bf16_t*)(ws + WS_SG); float* MR = (float*)(ws + WS_MR); bf16_t* MB = (bf16_t*)(ws + WS_MB);
    bf16_t* UG = (bf16_t*)(ws + WS_UG); bf16_t* H = (bf16_t*)(ws + WS_H);
    bf16_t* YR = (bf16_t*)out;

    {
        CTX();
        float* scr = (float*)(lds + 65536) + C.wave * (64 * 33);
        constexpr int I_IN = 16 * 352, I_RET = 32 * 32, I_DIF = 16 * 32, I_O = 16 * 32, I_UP = 16 * 176, I_DN = 44 * 32;
        constexpr int NIT = I_IN + I_RET + I_DIF + I_O + I_UP + I_DN;
        for (int it = C.gw; it < NIT; it += C.NGW) {
            int r = it;
            if (r < I_IN) { transpose_item<1>(win, 1024, NIN, WIN, scr, r, C.lane); continue; } r -= I_IN;
            if (r < I_RET) { transpose_item<0>(wret, 2048, 1024, WRET, scr, r, C.lane); continue; } r -= I_RET;
            if (r < I_DIF) { transpose_item<0>(wdif, 1024, 1024, WDIF, scr, r, C.lane); continue; } r -= I_DIF;
            if (r < I_O) { transpose_item<0>(wo, 1024, 1024, WO, scr, r, C.lane); continue; } r -= I_O;
            if (r < I_UP) { transpose_item<2>(wup, 1024, 5632, WUP, scr, r, C.lane); continue; } r -= I_UP;
            transpose_item<0>(wdn, 2816, 1024, WDN, scr, r, C.lane);
        }
        d_mod(C, c, cctx, wmod, bmod, MOD);
        d_tables(C, logit, dlam, TAB, SCAL);
    }
    grid.sync();
    { CTX(); d_lnmod(C, x, ctx, lng, lnb, MOD, XM, STATS); }
    GSYNC();
    fast_gemm(lds, XM, WIN + (size_t)C_QR * 1024, MA, 4096, 1024, FEpiRetQKV{QR, KR, VR, TAB});
    GSYNC();
    { CTX(); d_ret_fast(C, QR, KR, VR, YR, SCAL); }
    GSYNC();
    { CTX(); d_ret_stats(C, YR, RS); }
    fast_gemm(lds, XM, WIN + (size_t)C_QD * 1024, MA, 3072, 1024, FEpiDifQKV{QD, KD, VD, TAB});
    GSYNC();
    { CTX(); d_attn_fast(C, QD, KD, VD, AD, SCAL, gsub); }
    GSYNC();
    fast_gemm(lds, XM, WIN + (size_t)C_GR * 1024, ML, 2048, 1024, FEpiGr{YR, RS});
    GSYNC();
    fast_gemm(lds, XM, WIN + (size_t)C_GATE * 1024, ML, 2048, 1024, FEpiGate{SG, bgate});
    GSYNC();
    fast_gemm(lds, YR, WRET, ML, 1024, 2048, FEpiMr{MR, SG});
    GSYNC();
    fast_gemm(lds, AD, WDIF, ML, 1024, 1024, FEpiMb{MB, MR, SG});
    GSYNC();
    fast_gemm(lds, MB, WO, ML, 1024, 1024, FEpiZ1{out, x, STATS, lng, lnb, MOD});
    GSYNC();
    { CTX(); d_ln_rows(C, out, ln1g, ln1b, MOD, XM); }
    GSYNC();
    for (int hf = 0; hf < 2; ++hf) {
        const int r0 = hf * (ML / 2);
        fast_gemm(lds, XM + (size_t)r0 * 1024, WUP, ML / 2, 5632, 1024, FEpiUG{UG});
        GSYNC();
        { CTX(); d_convgate_v(C, UG, r0, cw, cb, H); }
        GSYNC();
    }
    fast_gemm(lds, H, WDN, ML, 1024, DFF, FEpiZ2{out, MOD});
    GSYNC();
    { CTX(); d_ln_rows(C, out, ln2g, ln2b, MOD, (bf16_t*)nullptr); }
}

extern "C" void kernel_launch(void* const* d_in, const int* in_sizes, int n_in, void* d_out, int out_size, void* d_ws, size_t ws_size, hipStream_t stream) {
    static int grid = 0;
    if (grid == 0) {
        if (n_in != 24 || ws_size < WS_NEED) { fprintf(stderr, "kernel_launch: unexpected n_in %d / ws %zu\n", n_in, ws_size); grid = -1; return; }
        int dev = 0, cus = 0, per_cu = 0;
        if (hipGetDevice(&dev) != hipSuccess || hipDeviceGetAttribute(&cus, hipDeviceAttributeMultiprocessorCount, dev) != hipSuccess) { grid = -1; return; }
        if (hipFuncSetAttribute((const void*)mega, hipFuncAttributeMaxDynamicSharedMemorySize, LDS_BYTES) != hipSuccess) { fprintf(stderr, "kernel_launch: hipFuncSetAttribute failed\n"); grid = -1; return; }
        if (hipOccupancyMaxActiveBlocksPerMultiprocessor(&per_cu, (const void*)mega, 512, LDS_BYTES) != hipSuccess || per_cu < 1) { fprintf(stderr, "kernel_launch: occupancy query failed (%d)\n", per_cu); (void)hipGetLastError(); grid = -1; return; }
        grid = cus * 1;
        fprintf(stderr, "kernel_launch: cus %d per_cu %d grid %d\n", cus, per_cu, grid);
    }
    if (grid < 0) return;
    if (hipMemsetAsync((char*)d_ws + WS_BAR, 0, 16384, stream) != hipSuccess) { fprintf(stderr, "kernel_launch: memset failed\n"); return; }
    Params p{};
    for (int i = 0; i < 24; ++i) p.in[i] = (const float*)d_in[i];
    p.out = (float*)d_out; p.ws = (unsigned char*)d_ws;
    void* args[] = {&p};
    hipError_t e = hipLaunchCooperativeKernel((const void*)mega, dim3(grid), dim3(512), args, LDS_BYTES, stream);
    if (e != hipSuccess) fprintf(stderr, "kernel_launch: cooperative launch failed: %s (grid %d)\n", hipGetErrorString(e), grid);
}
```

```cpp
#include <hip/hip_runtime.h>
#include <hip/hip_cooperative_groups.h>
namespace cg = cooperative_groups;
#include <cstdio>
#include <cstdint>
#include <cmath>

typedef unsigned short bf16_t;
typedef short bf16x8 __attribute__((ext_vector_type(8)));
typedef float f32x4 __attribute__((ext_vector_type(4)));

constexpr int D = 1024, NB = 8, SEQ = 4096, CTX = 256, ML = NB * SEQ  , MC = NB * CTX  , MA = ML + MC  ;
constexpr int NIN = 11264, DFF = 2816;
constexpr int C_QR = 0, C_KR = 1024, C_VR = 2048, C_GR = 4096, C_QD = 6144, C_KD = 7168, C_VD = 8192, C_GATE = 9216;
constexpr float LN_EPS = 1e-5f;
constexpr float ALPHA = 1.189207115002721f;
constexpr float LAM_INIT = 0.2f;

constexpr size_t MiB = 1u << 20;
constexpr size_t WS_MOD = 0;
constexpr size_t WS_TAB = 256 * 1024;
constexpr size_t WS_SCAL = 320 * 1024;
constexpr size_t WS_BAR = 384 * 1024;
constexpr size_t WS_STATS = 512 * 1024;
constexpr size_t WS_RS = 1 * MiB;
constexpr size_t WS_WIN = 2 * MiB;
constexpr size_t WS_WRET = 24 * MiB;
constexpr size_t WS_WDIF = 28 * MiB;
constexpr size_t WS_WO = 30 * MiB;
constexpr size_t WS_WUP = 32 * MiB;
constexpr size_t WS_WDN = 43 * MiB;
constexpr size_t WS_XM = 50 * MiB;
constexpr size_t WS_R = 118 * MiB;
constexpr size_t WS_QR = WS_R;
constexpr size_t WS_KR = WS_R + 64 * MiB;
constexpr size_t WS_VR = WS_R + 132 * MiB;
constexpr size_t WS_SST = WS_R + 272 * MiB;
constexpr size_t WS_QD = WS_R;
constexpr size_t WS_KD = WS_R + 64 * MiB;
constexpr size_t WS_VD = WS_R + 132 * MiB;
constexpr size_t WS_OD = WS_R + 200 * MiB;
constexpr size_t WS_AD = WS_R + 328 * MiB;
constexpr size_t WS_SG = WS_R;
constexpr size_t WS_MR = WS_R + 128 * MiB;
constexpr size_t WS_MB = WS_R + 256 * MiB;
constexpr size_t WS_U = WS_R;
constexpr size_t WS_H = WS_R + 176 * MiB;
constexpr size_t WS_NEED = 512 * MiB;

__device__ __forceinline__ float bf2f(bf16_t v) { return __uint_as_float(((unsigned)v) << 16); }
__device__ __forceinline__ bf16_t f2bf(float f) { unsigned u = __float_as_uint(f); return (bf16_t)((u + 0x7fffu + ((u >> 16) & 1u)) >> 16); }
__device__ __forceinline__ float siluf(float x) { return x / (1.f + __expf(-x)); }
__device__ __forceinline__ float sigmf(float x) { return 1.f / (1.f + __expf(-x)); }
__device__ __forceinline__ float wave_sum(float v) {
#pragma unroll
    for (int o = 1; o < 64; o <<= 1) v += __shfl_xor(v, o);
    return v;
}

#define LAS __attribute__((address_space(3)))
__device__ __forceinline__ unsigned pk2(float lo, float hi) { return (unsigned)f2bf(lo) | ((unsigned)f2bf(hi) << 16); }
typedef unsigned v4u __attribute__((ext_vector_type(4)));
template <int MAP>
__device__ __forceinline__ void transpose_item(const float* __restrict__ W, int K, int N, bf16_t* __restrict__ WT, float* scr, int item, int lane) {
    const int nblk = N / 32, kb = item / nblk, nb = item % nblk, k0 = 64 * kb, n0 = 32 * nb;
    int s0 = n0;
    if (MAP == 1) { if (n0 >= C_QD && n0 < C_QD + 2048) { const int r = n0 - C_QD, t = r >> 8, p = r & 255, bj = p >> 7, qq = p & 127; s0 = C_QD + t * 256 + 64 * (qq >> 5) + 32 * bj; } }
    if (MAP == 2) { const int t = n0 >> 8, p = n0 & 255; s0 = p < 128 ? 128 * t + p : 2816 + 128 * t + (p - 128); }
#pragma unroll 8
    for (int i = 0; i < 32; ++i) { const int kk = 2 * i + (lane >> 5); scr[kk * 33 + (lane & 31)] = W[(size_t)(k0 + kk) * N + s0 + (lane & 31)]; }
    __builtin_amdgcn_s_waitcnt(0xC07F); __builtin_amdgcn_wave_barrier();
    const int c = lane & 7;
#pragma unroll
    for (int j = 0; j < 4; ++j) { const int n = (lane >> 3) + 8 * j; const float* s = scr + (8 * c) * 33 + n;
        v4u o; o.x = pk2(s[0 * 33], s[1 * 33]); o.y = pk2(s[2 * 33], s[3 * 33]); o.z = pk2(s[4 * 33], s[5 * 33]); o.w = pk2(s[6 * 33], s[7 * 33]);
        *(v4u*)(WT + (size_t)(n0 + n) * K + k0 + 8 * c) = o; }
    __builtin_amdgcn_s_waitcnt(0xC07F); __builtin_amdgcn_wave_barrier();
}


struct Ctx { int tid, lane, wave, bx, G, gw, NGW, gt, NGT; unsigned char* lds; };

__device__ __forceinline__ void d_mod(const Ctx& C, const float* __restrict__ c, const float* __restrict__ cctx, const float* __restrict__ wmod,
                                      const float* __restrict__ bmod, float* __restrict__ MOD) {
    if (C.bx >= 192) return;
    float* sc = (float*)C.lds;
    float* red = sc + 9 * 1024;
    for (int i = C.tid; i < 9 * 1024; i += 512) { const int r = i >> 10, k = i & 1023; const float v = r < 8 ? c[r * 1024 + k] : cctx[k]; sc[i] = siluf(v); }
    __syncthreads();
    for (int grp = C.bx; grp < 192; grp += C.G) {
        const int col = C.tid & 31, ks = C.tid >> 5, j = grp * 32 + col;
        float acc[9];
#pragma unroll
        for (int r = 0; r < 9; ++r) acc[r] = 0.f;
        for (int k = ks * 64; k < ks * 64 + 64; ++k) { const float w = wmod[(size_t)k * 6144 + j];
#pragma unroll
            for (int r = 0; r < 9; ++r) acc[r] += sc[r * 1024 + k] * w; }
#pragma unroll
        for (int r = 0; r < 9; ++r) red[(ks * 9 + r) * 32 + col] = acc[r];
        __syncthreads();
        if (C.tid < 288) { const int r = C.tid >> 5, cc = C.tid & 31; float a = bmod[grp * 32 + cc];
#pragma unroll
            for (int s = 0; s < 16; ++s) a += red[(s * 9 + r) * 32 + cc];
            MOD[r * 6144 + grp * 32 + cc] = a; }
        __syncthreads();
    }
}

__device__ __forceinline__ void sincos_acc(float ang, float& cs, float& sn) {
    const double TWO_PI = 6.283185307179586476925286766559;
    double a = (double)ang; const double k = rint(a / TWO_PI); double r = a - k * TWO_PI;
    const double r2 = r * r;
    double s = 1.0, c = 1.0;
#pragma unroll
    for (int n = 13; n >= 1; --n) { s = 1.0 - s * r2 / (double)((2 * n) * (2 * n + 1)); c = 1.0 - c * r2 / (double)((2 * n - 1) * (2 * n)); }
    sn = (float)(r * s); cs = (float)c;
}
__device__ __forceinline__ void d_tables(const Ctx& C, const float* __restrict__ logit, const float* __restrict__ dlam, float* __restrict__ TAB, float* __restrict__ SCAL) {
    if (C.bx == C.G - 1) {
        if (C.tid < 64) { float a = dlam[C.tid] * dlam[64 + C.tid], b = dlam[128 + C.tid] * dlam[192 + C.tid];
            a = wave_sum(a); b = wave_sum(b);
            if (C.tid == 0) SCAL[0] = expf(a) - expf(b) + LAM_INIT;
        } else if (C.tid < 72) { const float x = logit[C.tid - 64]; SCAL[1 + C.tid - 64] = fminf(x, 0.f) - log1pf(expf(-fabsf(x))); }
    }
    for (int i = C.gt; i < 64 * 64 + 64 * 16; i += C.NGT) {
        if (i < 4096) { const int p = i >> 6, f = i & 63; const float inv = powf(10000.f, -((float)(2 * f) / 128.f)); float cs, sn; sincos_acc((float)p * inv, cs, sn); TAB[i] = cs; TAB[4096 + i] = sn; }
        else { const int q = i - 4096, p = q >> 4, f = q & 15; const float inv = powf(10000.f, -((float)(2 * f) / 32.f)); float cs, sn; sincos_acc((float)p * inv, cs, sn); TAB[8192 + q] = cs; TAB[8192 + 1024 + q] = sn; }
    }
}

__device__ __forceinline__ void d_lnmod(const Ctx& C, const float* __restrict__ x, const float* __restrict__ ctx, const float* __restrict__ g, const float* __restrict__ bb,
                                        const float* __restrict__ MOD, bf16_t* __restrict__ XM, float* __restrict__ STATS) {
    const int lane = C.lane;
    for (int row = C.gw; row < MA; row += C.NGW) {
        const float* src = row < ML ? x + (size_t)row * D : ctx + (size_t)(row - ML) * D;
        const int mr = row < ML ? row / SEQ : 8;
        const float* sh = MOD + mr * 6144; const float* sc = sh + 1024;
        f32x4 v[4]; float s = 0.f;
#pragma unroll
        for (int j = 0; j < 4; ++j) { v[j] = *(const f32x4*)(src + j * 256 + lane * 4); s += (v[j].x + v[j].y) + (v[j].z + v[j].w); }
        const float mean = wave_sum(s) * (1.f / D); float s2 = 0.f;
#pragma unroll
        for (int j = 0; j < 4; ++j) { v[j] = v[j] - mean; s2 += (v[j].x * v[j].x + v[j].y * v[j].y) + (v[j].z * v[j].z + v[j].w * v[j].w); }
        const float rstd = 1.f / sqrtf(wave_sum(s2) * (1.f / D) + LN_EPS);
        if (row < ML && lane == 0) { STATS[row * 2] = mean; STATS[row * 2 + 1] = rstd; }
#pragma unroll
        for (int j = 0; j < 4; ++j) { const int c0 = j * 256 + lane * 4;
            const f32x4 gg = *(const f32x4*)(g + c0), bv = *(const f32x4*)(bb + c0), s1 = *(const f32x4*)(sc + c0), h1 = *(const f32x4*)(sh + c0);
            const f32x4 xn = v[j] * rstd * gg + bv; const f32x4 o = xn * (s1 + 1.f) + h1;
            ushort4 w; w.x = f2bf(o.x); w.y = f2bf(o.y); w.z = f2bf(o.z); w.w = f2bf(o.w);
            *(ushort4*)(XM + (size_t)row * D + c0) = w; }
    }
}

template <class Epi>
__device__ __forceinline__ void d_gemm(const Ctx& C, const bf16_t* __restrict__ A, int lda, const bf16_t* __restrict__ Bt, int ldb, int M, int N, int K, const Epi& epi) {
    const int fr = C.lane & 15, fq = C.lane >> 4, ntn = N / 256, nt = (M / 128) * ntn;
    for (int t = C.bx; t < nt; t += C.G) {
        const int row0 = (t / ntn) * 128 + (C.wave >> 2) * 64, col0 = (t % ntn) * 256 + (C.wave & 3) * 64;
        f32x4 acc[4][4];
#pragma unroll
        for (int i = 0; i < 4; ++i)
#pragma unroll
            for (int j = 0; j < 4; ++j) acc[i][j] = (f32x4){0.f, 0.f, 0.f, 0.f};
        const bf16_t* Ap = A + (size_t)(row0 + fr) * lda + fq * 8;
        const bf16_t* Bp = Bt + (size_t)(col0 + fr) * ldb + fq * 8;
        for (int k0 = 0; k0 < K; k0 += 32) {
            bf16x8 a[4], b[4];
#pragma unroll
            for (int i = 0; i < 4; ++i) { a[i] = *(const bf16x8*)(Ap + (size_t)i * 16 * lda + k0); b[i] = *(const bf16x8*)(Bp + (size_t)i * 16 * ldb + k0); }
#pragma unroll
            for (int i = 0; i < 4; ++i)
#pragma unroll
                for (int j = 0; j < 4; ++j) acc[i][j] = __builtin_amdgcn_mfma_f32_16x16x32_bf16(a[i], b[j], acc[i][j], 0, 0, 0);
        }
#pragma unroll
        for (int i = 0; i < 4; ++i)
#pragma unroll
            for (int j = 0; j < 4; ++j)
#pragma unroll
                for (int r = 0; r < 4; ++r) epi(row0 + i * 16 + fq * 4 + r, col0 + j * 16 + fr, acc[i][j][r]);
    }
}

struct EpiRetQKV { bf16_t *QR, *KR, *VR;
    __device__ __forceinline__ void operator()(int r, int c, float v) const {
        if (c < 1024) { if (r < ML) QR[(size_t)r * 1024 + c] = f2bf(v); }
        else if (c < 2048) KR[(size_t)r * 1024 + (c - 1024)] = f2bf(v * 0.0625f);
        else VR[(size_t)r * 2048 + (c - 2048)] = f2bf(v); } };
struct EpiDifQKV { bf16_t *QD, *KD, *VD;
    __device__ __forceinline__ void operator()(int r, int c, float v) const {
        if (c < 1024) { if (r < ML) QD[(size_t)r * 1024 + c] = f2bf(v * 0.125f); }
        else if (c < 2048) KD[(size_t)r * 1024 + (c - 1024)] = f2bf(v);
        else VD[(size_t)r * 1024 + (c - 2048)] = f2bf(v); } };
struct EpiGr { bf16_t* YR; const float* RS;
    __device__ __forceinline__ void operator()(int r, int c, float v) const {
        const int h = c >> 9; const float mu = RS[(r * 4 + h) * 2], rs = RS[(r * 4 + h) * 2 + 1];
        const size_t o = (size_t)r * 2048 + c; const float yn = (bf2f(YR[o]) - mu) * rs; YR[o] = f2bf(siluf(v) * yn); } };
struct EpiGate { bf16_t* SG; const float* bg;
    __device__ __forceinline__ void operator()(int r, int c, float v) const { SG[(size_t)r * 2048 + c] = f2bf(sigmf(v + bg[c])); } };
struct EpiMr { float* MR; const bf16_t* SG;
    __device__ __forceinline__ void operator()(int r, int c, float v) const { MR[(size_t)r * 1024 + c] = bf2f(SG[(size_t)r * 2048 + c]) * v; } };
struct EpiMb { bf16_t* MB; const float* MR; const bf16_t* SG;
    __device__ __forceinline__ void operator()(int r, int c, float v) const { MB[(size_t)r * 1024 + c] = f2bf(MR[(size_t)r * 1024 + c] + bf2f(SG[(size_t)r * 2048 + 1024 + c]) * v); } };
struct EpiZ1 { float* Z; const float* x; const float* STATS; const float* g; const float* b; const float* MOD;
    __device__ __forceinline__ void operator()(int r, int c, float v) const {
        const float xn = (x[(size_t)r * 1024 + c] - STATS[r * 2]) * STATS[r * 2 + 1] * g[c] + b[c];
        Z[(size_t)r * 1024 + c] = ALPHA * xn + MOD[(r / SEQ) * 6144 + 2048 + c] * v; } };
struct EpiUG { bf16_t* UG;
    __device__ __forceinline__ void operator()(int r, int c, float v) const { UG[(size_t)r * 5632 + c] = f2bf(v); } };
struct EpiZ2 { float* Z; const float* MOD;
    __device__ __forceinline__ void operator()(int r, int c, float v) const { const size_t o = (size_t)r * 1024 + c; Z[o] = ALPHA * Z[o] + MOD[(r / SEQ) * 6144 + 5120 + c] * v; } };

__device__ __forceinline__ void d_rope_ret(const Ctx& C, bf16_t* __restrict__ X, const float* __restrict__ TAB) {
    for (int idx = C.gt; idx < ML * 512; idx += C.NGT) {
        const int row = idx >> 9, p = idx & 511, h = p >> 7, j = p & 127;
        const int t = row & (SEQ - 1), pr = t >> 6, pc = t & 63;
        const int ti = j < 64 ? pr * 64 + j : pc * 64 + (j - 64);
        const float cs = TAB[ti], sn = TAB[4096 + ti];
        bf16_t* a = X + (size_t)row * 1024 + h * 256 + j;
        const float x1 = bf2f(a[0]), x2 = bf2f(a[128]);
        a[0] = f2bf(x1 * cs - x2 * sn); a[128] = f2bf(x2 * cs + x1 * sn);
    }
}
__device__ __forceinline__ void d_rope_dif(const Ctx& C, bf16_t* __restrict__ X, const float* __restrict__ TAB) {
    for (int idx = C.gt; idx < ML * 512; idx += C.NGT) {
        const int row = idx >> 9, p = idx & 511, blk = p >> 5, j = p & 31;
        const int t = row & (SEQ - 1), pr = t >> 6, pc = t & 63;
        const int ti = j < 16 ? pr * 16 + j : pc * 16 + (j - 16);
        const float cs = TAB[8192 + ti], sn = TAB[8192 + 1024 + ti];
        bf16_t* a = X + (size_t)row * 1024 + blk * 64 + j;
        const float x1 = bf2f(a[0]), x2 = bf2f(a[32]);
        a[0] = f2bf(x1 * cs - x2 * sn); a[32] = f2bf(x2 * cs + x1 * sn);
    }
}

__device__ __forceinline__ void d_ret_naive(const Ctx& C, const bf16_t* __restrict__ QR, const bf16_t* __restrict__ KR, const bf16_t* __restrict__ VR,
                                            bf16_t* __restrict__ YR, float* __restrict__ Sg, const float* __restrict__ SCAL) {
    bf16_t* qs = (bf16_t*)C.lds; bf16_t* ks = qs + 128 * 256; bf16_t* vs = ks + 128 * 256; bf16_t* Ps = qs;
    const int tid = C.tid;
    for (int bid = C.bx; bid < 256; bid += C.G) {
    const int vsl = bid & 7, h = (bid >> 3) & 3, b = bid >> 5;
    float* S = Sg + (size_t)bid * 16384;
    const float lgf = SCAL[1 + h], lgb = SCAL[5 + h];
    const int c = tid & 63, g8 = tid >> 6;
    for (int pass = 0; pass < 2; ++pass) {
        const float lg = pass ? lgb : lgf;
        for (int i = 0; i < 32; ++i) S[(g8 * 32 + i) * 64 + c] = 0.f;
        __syncthreads();
        for (int step = 0; step < 34; ++step) {
            const bool lat = step >= 2;
            int tz = 0; asm volatile("" : "+v"(tz));
            int rowbase;
            if (!lat) { const int cc = pass ? 1 - step : step; rowbase = ML + b * CTX + cc * 128; }
            else { const int n = pass ? 33 - step : step - 2; rowbase = b * SEQ + n * 128; }
            for (int p = tid; p < 128 * 32; p += 512) { const int r = p >> 5, ch = p & 31;
                *(bf16x8*)(ks + r * 256 + ch * 8) = *(const bf16x8*)(KR + (size_t)(rowbase + r) * 1024 + h * 256 + ch * 8);
                if (lat) *(bf16x8*)(qs + r * 256 + ch * 8) = *(const bf16x8*)(QR + (size_t)(rowbase + r) * 1024 + h * 256 + ch * 8); }
            for (int p = tid; p < 128 * 8; p += 512) { const int r = p >> 3, ch = p & 7;
                *(bf16x8*)(vs + r * 64 + ch * 8) = *(const bf16x8*)(VR + (size_t)(rowbase + r) * 2048 + h * 512 + vsl * 64 + ch * 8); }
            __syncthreads();
            if (lat) {
                float yacc[16];
#pragma unroll
                for (int ii = 0; ii < 16; ++ii) { const int i = g8 * 16 + ii + tz; float a = 0.f;
#pragma unroll 2
                    for (int d = 0; d < 256; ++d) a += bf2f(qs[i * 256 + d]) * bf2f(f2bf(S[d * 64 + c]));
                    yacc[ii] = a * __expf(lg * (pass ? (float)(128 - i) : (float)(i + 1))); }
                if (pass == 0) {
                    const int j = (tid & 127) + tz, g4 = tid >> 7; float pv[32];
#pragma unroll
                    for (int ii = 0; ii < 32; ++ii) { const int i = g4 * 32 + ii; float a = 0.f;
#pragma unroll 2
                        for (int d = 0; d < 256; ++d) a += bf2f(qs[i * 256 + d]) * bf2f(ks[j * 256 + d]);
                        const float m = i > j ? __expf(lgf * (float)(i - j)) : (i < j ? __expf(lgb * (float)(j - i)) : 2.f);
                        pv[ii] = a * m; }
                    __syncthreads();
#pragma unroll
                    for (int ii = 0; ii < 32; ++ii) Ps[(g4 * 32 + ii) * 128 + j] = f2bf(pv[ii]);
                    __syncthreads();
#pragma unroll
                    for (int ii = 0; ii < 16; ++ii) { const int i = g8 * 16 + ii; float a = 0.f;
#pragma unroll 2
                        for (int jj = 0; jj < 128; ++jj) a += bf2f(Ps[i * 128 + jj]) * bf2f(vs[jj * 64 + c]);
                        yacc[ii] += a; }
                }
#pragma unroll
                for (int ii = 0; ii < 16; ++ii) { const int i = g8 * 16 + ii; bf16_t* yp = YR + (size_t)(rowbase + i) * 2048 + h * 512 + vsl * 64 + c;
                    if (pass == 0) *yp = f2bf(yacc[ii]); else *yp = f2bf(bf2f(*yp) + yacc[ii]); }
            }
            const float ds = __expf(lg * 128.f);
            float acc[32];
#pragma unroll
            for (int i = 0; i < 32; ++i) acc[i] = 0.f;
#pragma unroll 1
            for (int jj = 0; jj < 128; ++jj) { const float vv = bf2f(f2bf(bf2f(vs[jj * 64 + c]) * __expf(lg * (pass ? (float)(jj + tz) : (float)(127 - jj + tz)))));
#pragma unroll
                for (int i = 0; i < 32; ++i) acc[i] += bf2f(ks[jj * 256 + g8 * 32 + i]) * vv; }
            __syncthreads();
#pragma unroll
            for (int i = 0; i < 32; ++i) { float* sp = S + (g8 * 32 + i) * 64 + c; *sp = *sp * ds + acc[i]; }
            __syncthreads();
        }
    }
    }
}

constexpr int ATTN_NAIVE_LDS = 64 * 64 * 2 + 64 * 128 * 2 + 64 * 65 * 4;
__device__ __forceinline__ void d_attn_naive(const Ctx& C, const bf16_t* __restrict__ QD, const bf16_t* __restrict__ KD, const bf16_t* __restrict__ VD, bf16_t* __restrict__ OD) {
    const int half = C.tid >> 8, tid = C.tid & 255, qi = tid >> 2, part = tid & 3;
    unsigned char* base = C.lds + half * ATTN_NAIVE_LDS;
    bf16_t* Ks = (bf16_t*)base; bf16_t* Vs = Ks + 64 * 64; float* Pm = (float*)(Vs + 64 * 128);
    for (int vb2 = C.bx; vb2 < 4096; vb2 += C.G) {
        const int vb = vb2 * 2 + half;
        const int qb = vb & 63, cc = (vb >> 6) & 1, h = (vb >> 7) & 7, b = vb >> 10;
        const int qrow = b * SEQ + qb * 64 + qi;
        float q[64];
#pragma unroll
        for (int d = 0; d < 64; ++d) q[d] = bf2f(QD[(size_t)qrow * 1024 + h * 128 + cc * 64 + d]);
        float o[32];
#pragma unroll
        for (int e = 0; e < 32; ++e) o[e] = 0.f;
        float m = -1e30f, l = 0.f;
        for (int kt = 0; kt < 68; ++kt) {
            const int krow0 = kt < 64 ? b * SEQ + kt * 64 : ML + b * CTX + (kt - 64) * 64;
            for (int p = tid; p < 64 * 8; p += 256) { const int r = p >> 3, ch = p & 7; *(bf16x8*)(Ks + r * 64 + ch * 8) = *(const bf16x8*)(KD + (size_t)(krow0 + r) * 1024 + h * 128 + cc * 64 + ch * 8); }
            for (int p = tid; p < 64 * 16; p += 256) { const int r = p >> 4, ch = p & 15; *(bf16x8*)(Vs + r * 128 + ch * 8) = *(const bf16x8*)(VD + (size_t)(krow0 + r) * 1024 + h * 128 + ch * 8); }
            __syncthreads();
            float s[16]; float mx = -1e30f;
#pragma unroll
            for (int jj = 0; jj < 16; ++jj) { const int j = part * 16 + jj; float a = 0.f;
#pragma unroll
                for (int d = 0; d < 64; ++d) a += q[d] * bf2f(Ks[j * 64 + d]);
                s[jj] = a; mx = fmaxf(mx, a); }
            mx = fmaxf(mx, __shfl_xor(mx, 1)); mx = fmaxf(mx, __shfl_xor(mx, 2));
            const float mn = fmaxf(m, mx), al = __expf(m - mn); m = mn;
            float ps = 0.f;
#pragma unroll
            for (int jj = 0; jj < 16; ++jj) { const float p = __expf(s[jj] - mn); ps += p; Pm[qi * 65 + part * 16 + jj] = bf2f(f2bf(p)); }
            l = l * al + ps;
#pragma unroll
            for (int e = 0; e < 32; ++e) o[e] *= al;
            __syncthreads();
            for (int j = 0; j < 64; ++j) { const float p = Pm[qi * 65 + j];
#pragma unroll
                for (int e = 0; e < 32; ++e) o[e] += p * bf2f(Vs[j * 128 + part * 32 + e]); }
            __syncthreads();
        }
        l += __shfl_xor(l, 1); l += __shfl_xor(l, 2);
        const float il = 1.f / l;
#pragma unroll
        for (int e = 0; e < 32; ++e) OD[(size_t)qrow * 2048 + h * 256 + cc * 128 + part * 32 + e] = f2bf(o[e] * il);
    }
}

__device__ __forceinline__ void d_prep_diff(const Ctx& C, const bf16_t* __restrict__ OD, const float* __restrict__ gsub, const float* __restrict__ SCAL, bf16_t* __restrict__ AD) {
    const int t = C.tid & 255, h = t >> 5, l = t & 31; const float lam = SCAL[0];
    for (int r2 = C.bx; r2 < ML / 2; r2 += C.G) {
        const int row = r2 * 2 + (C.tid >> 8);
        float a[4]; float ss = 0.f;
#pragma unroll
        for (int i = 0; i < 4; ++i) { const int e = l * 4 + i; a[i] = bf2f(OD[(size_t)row * 2048 + h * 256 + e]) - lam * bf2f(OD[(size_t)row * 2048 + h * 256 + 128 + e]); ss += a[i] * a[i]; }
#pragma unroll
        for (int o = 1; o < 32; o <<= 1) ss += __shfl_xor(ss, o);
        const float rs = 1.f / sqrtf(ss * (1.f / 128.f) + LN_EPS);
#pragma unroll
        for (int i = 0; i < 4; ++i) { const int e = l * 4 + i; AD[(size_t)row * 1024 + h * 128 + e] = f2bf(a[i] * rs * gsub[e] * (1.f - LAM_INIT)); }
    }
}
__device__ __forceinline__ void d_ret_stats(const Ctx& C, const bf16_t* __restrict__ YR, float* __restrict__ RS) {
    for (int it = C.gw; it < ML * 4; it += C.NGW) {
        const int row = it >> 2, h = it & 3;
        float v[8]; float s = 0.f;
#pragma unroll
        for (int i = 0; i < 8; ++i) { v[i] = bf2f(YR[(size_t)row * 2048 + h * 512 + C.lane * 8 + i]); s += v[i]; }
        const float mu = wave_sum(s) * (1.f / 512.f); float s2 = 0.f;
#pragma unroll
        for (int i = 0; i < 8; ++i) { const float d = v[i] - mu; s2 += d * d; }
        const float var = wave_sum(s2) * (1.f / 512.f);
        if (C.lane == 0) { RS[it * 2] = mu; RS[it * 2 + 1] = 1.f / sqrtf(var + LN_EPS); }
    }
}

__device__ __forceinline__ void d_ln_rows(const Ctx& C, float* __restrict__ Z, const float* __restrict__ g, const float* __restrict__ bb, const float* __restrict__ MOD, bf16_t* __restrict__ XM) {
    const int lane = C.lane;
    for (int row = C.gw; row < ML; row += C.NGW) {
        float* src = Z + (size_t)row * D;
        f32x4 v[4]; float s = 0.f;
#pragma unroll
        for (int j = 0; j < 4; ++j) { v[j] = *(const f32x4*)(src + j * 256 + lane * 4); s += (v[j].x + v[j].y) + (v[j].z + v[j].w); }
        const float mean = wave_sum(s) * (1.f / D); float s2 = 0.f;
#pragma unroll
        for (int j = 0; j < 4; ++j) { v[j] = v[j] - mean; s2 += (v[j].x * v[j].x + v[j].y * v[j].y) + (v[j].z * v[j].z + v[j].w * v[j].w); }
        const float rstd = 1.f / sqrtf(wave_sum(s2) * (1.f / D) + LN_EPS);
        const float* sh = MOD + (row / SEQ) * 6144 + 3072; const float* sc = sh + 1024;
#pragma unroll
        for (int j = 0; j < 4; ++j) { const int c0 = j * 256 + lane * 4;
            const f32x4 gg = *(const f32x4*)(g + c0), bv = *(const f32x4*)(bb + c0);
            const f32x4 xn = v[j] * rstd * gg + bv; *(f32x4*)(src + c0) = xn;
            if (XM) { const f32x4 s1 = *(const f32x4*)(sc + c0), h1 = *(const f32x4*)(sh + c0); const f32x4 o = xn * (s1 + 1.f) + h1;
                ushort4 w; w.x = f2bf(o.x); w.y = f2bf(o.y); w.z = f2bf(o.z); w.w = f2bf(o.w); *(ushort4*)(XM + (size_t)row * D + c0) = w; } }
    }
}

__device__ __forceinline__ void d_convgate(const Ctx& C, const bf16_t* __restrict__ UG, int row_off, const float* __restrict__ cw, const float* __restrict__ cb, bf16_t* __restrict__ H) {
    for (int idx = C.gt; idx < (ML / 2) * DFF; idx += C.NGT) {
        const int lr = idx / DFF, f = idx % DFF, row = row_off + lr, t = row & (SEQ - 1);
        const int uc = (f >> 7) * 256 + (f & 127);
        float u = cb[f] + cw[DFF + f] * bf2f(UG[(size_t)lr * 5632 + uc]);
        if (t > 0) u += cw[f] * bf2f(UG[(size_t)(lr - 1) * 5632 + uc]);
        if (t < SEQ - 1) u += cw[2 * DFF + f] * bf2f(UG[(size_t)(lr + 1) * 5632 + uc]);
        const float ge = 0.5f * u * (1.f + erff(u * 0.70710678118654752f));
        H[(size_t)row * DFF + f] = f2bf(ge * bf2f(UG[(size_t)lr * 5632 + uc + 128]));
    }
}

namespace pg8 {
#define PG8_LAS __attribute__((address_space(3)))
typedef unsigned short bf16_t;
typedef short bf16x8 __attribute__((ext_vector_type(8)));
typedef float f32x4 __attribute__((ext_vector_type(4)));
typedef unsigned u32x4 __attribute__((ext_vector_type(4)));
constexpr int BM = 256, BK = 64, HALF = 128, HTB = HALF * BK * 2  , STAGE_BYTES = 8 * HTB, NXCD = 8, WGM = 8;

__host__ __device__ __forceinline__ int lds_byte(int r, int c) { const int st = (r >> 4) * 2 + (c >> 5), rr = r & 15, cc = c & 31, ob = rr * 64 + cc * 2; return st * 1024 + (ob ^ (((ob >> 9) & 1) << 5)); }
__host__ __device__ __forceinline__ void stage_rc(int b, int& R, int& C) { const int st = b / 1024, sb = b % 1024, swz = sb ^ (((sb >> 9) & 1) << 5); R = (st >> 1) * 16 + swz / 64; C = (st & 1) * 32 + (swz % 64) / 2; }
__host__ __device__ __forceinline__ int perm32(int rho) { const int n = rho >> 4, i = rho & 15; return 8 * (i >> 2) + 4 * n + (i & 3); }

struct Unit { int pm, pn; };
struct Gemm { const bf16_t* A; const bf16_t* Bt; int M, N, K; };

struct StaticOrder {
    int nM, nN, nwg, G, c;
    __host__ __device__ void init(int M, int N, int G_, int c_) { nM = M / BM; nN = N / BM; nwg = nM * nN; G = G_; c = c_; }
    __host__ __device__ bool next(int i, Unit& u) const {
        const long L = (long)i * G + c; if (L >= nwg) return false;
        int wgid = (int)L; { const int q = nwg / NXCD, r = nwg % NXCD, xcd = wgid % NXCD, off = wgid / NXCD; wgid = (xcd < r ? xcd * (q + 1) : r * (q + 1) + (xcd - r) * q) + off; }
        const int nig = WGM * nN, gid = wgid / nig, fm = gid * WGM, gsz = (nM - fm) < WGM ? (nM - fm) : WGM;
        u.pm = fm + ((wgid % nig) % gsz); u.pn = (wgid % nig) / gsz; return true;
    }
    __device__ __forceinline__ void a_ready(const Unit&) const {}
    __device__ __forceinline__ void done(const Unit&) const {}
};

template <class Epi, class Sched, bool ALIGN_EPI = false, bool SP2 = false>
__device__ __forceinline__ void gemm_phase(PG8_LAS unsigned char* lds, const Gemm g, const Sched& S, const Epi& E) {
    int tid_ = threadIdx.x; asm volatile("" : "+v"(tid_));
    const int tid = tid_, wid = __builtin_amdgcn_readfirstlane(tid >> 6), lane = tid & 63, wr = wid >> 2, wc = wid & 3, fr = lane & 15, fq = lane >> 4;
    const int K = g.K, nt = K / BK;
    unsigned voffA[2], voffB[2];
#pragma unroll
    for (int i = 0; i < 2; ++i) { int R, C; stage_rc(tid * 16 + i * 8192, R, C); const int Rb = Epi::PERM ? ((R & ~31) + perm32(R & 31)) : R;
        voffA[i] = (unsigned)(R * K + C) * 2u; voffB[i] = (unsigned)(Rb * K + C) * 2u; }
    const size_t kstep = (size_t)(BK * 2);
    const size_t hstep = (size_t)HALF * K * 2;
    const size_t tstep = 2 * hstep;
    const unsigned ldsw = (unsigned)wid * 1024u;
    const int aoff = lds_byte(wr * 64 + fr, fq * 8), boff = lds_byte(wc * 32 + fr, fq * 8);
#define PG8_SA(b, h) (((b) * 2 + (h)) * HTB)
#define PG8_SB(b, h) ((4 + (b) * 2 + (h)) * HTB)
#define PG8_STAGE(bufoff, gbase, voff) do { _Pragma("unroll") for (int _i = 0; _i < 2; ++_i) \
        __builtin_amdgcn_global_load_lds((const unsigned*)((const char*)(gbase) + (voff)[_i]), (PG8_LAS unsigned*)(lds + (bufoff) + ldsw + _i * 8192), 16, 0, 0); } while (0)
#define PG8_LDA(dst, b, h) do { _Pragma("unroll") for (int m = 0; m < 4; ++m) _Pragma("unroll") for (int k = 0; k < 2; ++k) dst[m][k] = *(const PG8_LAS bf16x8*)(lds + PG8_SA(b, h) + aoff + m * 2048 + k * 1024); } while (0)
#define PG8_LDB(dst, b, h) do { _Pragma("unroll") for (int n = 0; n < 2; ++n) _Pragma("unroll") for (int k = 0; k < 2; ++k) dst[n][k] = *(const PG8_LAS bf16x8*)(lds + PG8_SB(b, h) + boff + n * 2048 + k * 1024); } while (0)
#define PG8_MMA(ai, bj, At, Bt) do { __builtin_amdgcn_s_setprio(1); _Pragma("unroll") for (int m = 0; m < 4; ++m) _Pragma("unroll") for (int n = 0; n < 2; ++n) _Pragma("unroll") for (int k = 0; k < 2; ++k) \
        acc[ai][bj][m][n] = __builtin_amdgcn_mfma_f32_16x16x32_bf16(Bt[n][k], At[m][k], acc[ai][bj][m][n], 0, 0, 0); __builtin_amdgcn_s_setprio(0); } while (0)
#define PG8_WAIT_V(n) asm volatile("s_waitcnt vmcnt(" #n ")" ::: "memory")
#define PG8_WAIT_L(n) asm volatile("s_waitcnt lgkmcnt(" #n ")" ::: "memory")
#define PG8_BAR __builtin_amdgcn_s_barrier()
#define PG8_SCHED __builtin_amdgcn_sched_barrier(0)
    Unit cur, nxt; int ui = 0;
    if (!S.next(0, cur)) return;
    f32x4 acc[2][2][4][2];
#pragma unroll
    for (int a = 0; a < 2; ++a)
#pragma unroll
        for (int b = 0; b < 2; ++b)
#pragma unroll
            for (int m = 0; m < 4; ++m)
#pragma unroll
                for (int n = 0; n < 2; ++n) acc[a][b][m][n] = (f32x4){0.f, 0.f, 0.f, 0.f};
    bf16x8 At[4][2], B0[2][2], B1[2][2];
    const char* cA = (const char*)g.A + (size_t)cur.pm * tstep; const char* cB = (const char*)g.Bt + (size_t)cur.pn * tstep;
    S.a_ready(cur);
    if constexpr (SP2) {
        PG8_STAGE(PG8_SB(0, 0), cB, voffB); PG8_STAGE(PG8_SB(0, 1), cB + hstep, voffB); PG8_STAGE(PG8_SA(0, 0), cA, voffA); PG8_STAGE(PG8_SA(0, 1), cA + hstep, voffA);
        if (wr == 1) PG8_BAR;
        PG8_WAIT_V(2); PG8_BAR;
        PG8_STAGE(PG8_SB(1, 0), cB + kstep, voffB); PG8_STAGE(PG8_SA(1, 0), cA + kstep, voffA); PG8_STAGE(PG8_SB(1, 1), cB + hstep + kstep, voffB);
        PG8_WAIT_V(6); PG8_BAR;
    } else {
        PG8_STAGE(PG8_SB(0, 0), cB, voffB); PG8_STAGE(PG8_SA(0, 0), cA, voffA); PG8_STAGE(PG8_SB(0, 1), cB + hstep, voffB); PG8_STAGE(PG8_SA(0, 1), cA + hstep, voffA);
        if (wr == 1) PG8_BAR;
        PG8_WAIT_V(4); PG8_BAR;
        PG8_STAGE(PG8_SB(1, 0), cB + kstep, voffB); PG8_STAGE(PG8_SA(1, 0), cA + kstep, voffA); PG8_STAGE(PG8_SB(1, 1), cB + hstep + kstep, voffB);
        PG8_WAIT_V(6); PG8_BAR;
    }
    for (;;) {
        const bool has_next = S.next(ui + 1, nxt);
        const char* nA = has_next ? (const char*)g.A + (size_t)nxt.pm * tstep : cA; const char* nB = has_next ? (const char*)g.Bt + (size_t)nxt.pn * tstep : cB;
        for (int t = 0; t < nt; t += 2) {
            const bool last = (t == nt - 2);
            const char* a1 = cA + (size_t)(t + 1) * kstep;
            const char* a2 = last ? nA : cA + (size_t)(t + 2) * kstep; const char* b2 = last ? nB : cB + (size_t)(t + 2) * kstep;
            const char* a3 = a2 + kstep; const char* b3 = b2 + kstep;
            if (last && has_next) S.a_ready(nxt);
            if constexpr (SP2) {
            PG8_LDB(B0, 0, 0); PG8_LDB(B1, 0, 1); PG8_SCHED; PG8_LDA(At, 0, 0); PG8_STAGE(PG8_SA(1, 1), a1 + hstep, voffA);
            PG8_WAIT_V(8); PG8_WAIT_L(0); PG8_BAR; PG8_MMA(0, 0, At, B0); PG8_MMA(0, 1, At, B1); PG8_BAR; PG8_SCHED;
            PG8_LDA(At, 0, 1); PG8_STAGE(PG8_SB(0, 0), b2, voffB); PG8_STAGE(PG8_SB(0, 1), b2 + hstep, voffB); PG8_STAGE(PG8_SA(0, 0), a2, voffA);
            PG8_WAIT_V(8); PG8_WAIT_L(0); PG8_BAR; PG8_MMA(1, 0, At, B0); PG8_MMA(1, 1, At, B1); PG8_BAR; PG8_SCHED;
            PG8_LDB(B0, 1, 0); PG8_LDB(B1, 1, 1); PG8_SCHED; PG8_LDA(At, 1, 0); PG8_STAGE(PG8_SA(0, 1), a2 + hstep, voffA);
            PG8_WAIT_V(8); PG8_WAIT_L(0); PG8_BAR; PG8_MMA(0, 0, At, B0); PG8_MMA(0, 1, At, B1); PG8_BAR; PG8_SCHED;
            PG8_LDA(At, 1, 1); PG8_STAGE(PG8_SB(1, 0), b3, voffB); PG8_STAGE(PG8_SB(1, 1), b3 + hstep, voffB); PG8_STAGE(PG8_SA(1, 0), a3, voffA);
            PG8_WAIT_V(8); PG8_WAIT_L(0); PG8_BAR; PG8_MMA(1, 0, At, B0); PG8_MMA(1, 1, At, B1); PG8_BAR; PG8_SCHED;
            } else {
            PG8_LDB(B0, 0, 0); PG8_SCHED; PG8_LDA(At, 0, 0); PG8_STAGE(PG8_SA(1, 1), a1 + hstep, voffA);
            PG8_WAIT_L(8); PG8_BAR; PG8_WAIT_L(0); PG8_MMA(0, 0, At, B0); PG8_BAR; PG8_SCHED;
            PG8_LDB(B1, 0, 1); PG8_STAGE(PG8_SB(0, 0), b2, voffB);
            PG8_BAR; PG8_WAIT_L(0); PG8_MMA(0, 1, At, B1); PG8_BAR;
            PG8_LDA(At, 0, 1); PG8_STAGE(PG8_SA(0, 0), a2, voffA);
            PG8_BAR; PG8_WAIT_L(0); PG8_MMA(1, 0, At, B0); PG8_BAR; PG8_SCHED;
            PG8_STAGE(PG8_SB(0, 1), b2 + hstep, voffB);
            PG8_WAIT_V(6); PG8_BAR; PG8_MMA(1, 1, At, B1); PG8_BAR;
            PG8_LDB(B0, 1, 0); PG8_SCHED; PG8_LDA(At, 1, 0); PG8_STAGE(PG8_SA(0, 1), a2 + hstep, voffA);
            PG8_WAIT_L(8); PG8_BAR; PG8_WAIT_L(0); PG8_MMA(0, 0, At, B0); PG8_BAR; PG8_SCHED;
            PG8_LDB(B1, 1, 1); PG8_STAGE(PG8_SB(1, 0), b3, voffB);
            PG8_BAR; PG8_WAIT_L(0); PG8_MMA(0, 1, At, B1); PG8_BAR;
            PG8_LDA(At, 1, 1); PG8_STAGE(PG8_SA(1, 0), a3, voffA);
            PG8_BAR; PG8_WAIT_L(0); PG8_MMA(1, 0, At, B0); PG8_BAR; PG8_SCHED;
            PG8_STAGE(PG8_SB(1, 1), b3 + hstep, voffB);
            PG8_WAIT_V(6); PG8_BAR; PG8_MMA(1, 1, At, B1); PG8_BAR;
            }
        }
        if constexpr (ALIGN_EPI) { if (wr == 0) PG8_BAR; }
        if constexpr (!Epi::AFTER_DRAIN) { E(acc, cur, wr, wc, fr, fq); S.done(cur); }
        if (!has_next) break;
#pragma unroll
        for (int a = 0; a < 2; ++a)
#pragma unroll
            for (int b = 0; b < 2; ++b)
#pragma unroll
                for (int m = 0; m < 4; ++m)
#pragma unroll
                    for (int n = 0; n < 2; ++n) acc[a][b][m][n] = (f32x4){0.f, 0.f, 0.f, 0.f};
        cur = nxt; cA = nA; cB = nB; ++ui;
        if constexpr (ALIGN_EPI) { if (wr == 1) PG8_BAR; }
    }
    PG8_WAIT_V(0);
    if constexpr (!ALIGN_EPI) { if (wr == 0) PG8_BAR; }
    PG8_BAR;
    if constexpr (Epi::AFTER_DRAIN) { E.fused(acc, cur, wr, wc, fr, fq, lds, wid, lane); S.done(cur); }
#undef PG8_SA
#undef PG8_SB
#undef PG8_STAGE
#undef PG8_LDA
#undef PG8_LDB
#undef PG8_MMA
#undef PG8_WAIT_V
#undef PG8_WAIT_L
#undef PG8_BAR
#undef PG8_SCHED
}
}


typedef unsigned u32x4 __attribute__((ext_vector_type(4)));
typedef float f32x2_t __attribute__((ext_vector_type(2))); typedef __bf16 bf16x2_t __attribute__((ext_vector_type(2)));
__device__ __forceinline__ unsigned cvtpk(float lo, float hi) { f32x2_t v = {lo, hi}; bf16x2_t b = __builtin_convertvector(v, bf16x2_t); return __builtin_bit_cast(unsigned, b); }
__device__ __forceinline__ u32x4 pack8(const f32x4& a, const f32x4& b) { u32x4 w; w.x = cvtpk(a[0], a[1]); w.y = cvtpk(a[2], a[3]); w.z = cvtpk(b[0], b[1]); w.w = cvtpk(b[2], b[3]); return w; }
__device__ __forceinline__ void unpack8(const u32x4& w, f32x4& a, f32x4& b) {
    a[0] = __uint_as_float(w.x << 16); a[1] = __uint_as_float(w.x & 0xffff0000u); a[2] = __uint_as_float(w.y << 16); a[3] = __uint_as_float(w.y & 0xffff0000u);
    b[0] = __uint_as_float(w.z << 16); b[1] = __uint_as_float(w.z & 0xffff0000u); b[2] = __uint_as_float(w.w << 16); b[3] = __uint_as_float(w.w & 0xffff0000u); }
typedef const f32x4 (&AccT)[2][2][4][2];
#define EPI_ROWS for (int ai = 0; ai < 2; ++ai) _Pragma("unroll") for (int m = 0; m < 4; ++m)

struct FEpiRetQKV { static constexpr bool PERM = true, AFTER_DRAIN = false; bf16_t *QR, *KR, *VR; const float* TAB;
    __device__ __forceinline__ void operator()(AccT acc, const pg8::Unit& u, int wr, int wc, int fr, int fq) const {
        const int row0 = u.pm * 256 + wr * 64 + fr, j0 = wc * 32 + 8 * fq;
        if (u.pn < 8) {
            const bool isq = u.pn < 4; const int h = u.pn & 3;
            if (isq && u.pm >= ML / 256) return;
            bf16_t* dst = (isq ? QR : KR) + h * 256 + j0; const float sc = isq ? 1.f : 0.0625f;
            const bool lat = u.pm < ML / 256, byrow = j0 < 64;
#define ROPE_ROW(ai, m) do { const int row = row0 + (ai) * 128 + (m) * 16; \
                const f32x4 x1a = acc[ai][0][m][0], x1b = acc[ai][0][m][1], x2a = acc[ai][1][m][0], x2b = acc[ai][1][m][1]; \
                const f32x4 o1a = (x1a * c0 - x2a * s0) * sc, o1b = (x1b * c1 - x2b * s1) * sc, o2a = (x2a * c0 + x1a * s0) * sc, o2b = (x2b * c1 + x1b * s1) * sc; \
                bf16_t* rp = dst + (size_t)row * 1024; *(u32x4*)rp = pack8(o1a, o1b); *(u32x4*)(rp + PAIRD) = pack8(o2a, o2b); } while (0)
#define ROPE_TAB(t_) f32x4 c0 = {1.f, 1.f, 1.f, 1.f}, c1 = c0, s0 = {0.f, 0.f, 0.f, 0.f}, s1 = s0; \
                if (lat) { const int t = (t_) & (SEQ - 1), p = byrow ? (t >> 6) : (t & 63); const float* tp = TBASE + p * TSTR + TOFF; \
                    c0 = *(const f32x4*)tp; c1 = *(const f32x4*)(tp + 4); s0 = *(const f32x4*)(tp + TSIN); s1 = *(const f32x4*)(tp + TSIN + 4); }
#define PAIRD 128
#define TBASE TAB
#define TSTR 64
#define TOFF (j0 & 63)
#define TSIN 4096
            if (byrow) {
#pragma unroll
                for (int ai = 0; ai < 2; ++ai) { ROPE_TAB(row0 + ai * 128)
#pragma unroll
                    for (int m = 0; m < 4; ++m) ROPE_ROW(ai, m); }
            } else {
#pragma unroll
                for (int m = 0; m < 4; ++m) { ROPE_TAB(row0 + m * 16)
#pragma unroll
                    for (int ai = 0; ai < 2; ++ai) ROPE_ROW(ai, m); }
            }
#undef PAIRD
#undef TBASE
#undef TSTR
#undef TOFF
#undef TSIN
        } else {
            bf16_t* dst = VR + (u.pn - 8) * 256 + j0;
#pragma unroll
            EPI_ROWS { bf16_t* rp = dst + (size_t)(row0 + ai * 128 + m * 16) * 2048; *(u32x4*)rp = pack8(acc[ai][0][m][0], acc[ai][0][m][1]); *(u32x4*)(rp + 128) = pack8(acc[ai][1][m][0], acc[ai][1][m][1]); }
        }
    } };
constexpr float QSCALE = 0.125f;
struct FEpiDifQKV { static constexpr bool PERM = true, AFTER_DRAIN = false; bf16_t *QD, *KD, *VD; const float* TAB;
    __device__ __forceinline__ void operator()(AccT acc, const pg8::Unit& u, int wr, int wc, int fr, int fq) const {
        const int row0 = u.pm * 256 + wr * 64 + fr, j0 = wc * 32 + 8 * fq;
        if (u.pn < 8) {
            const bool isq = u.pn < 4; const int tl = u.pn & 3;
            if (isq && u.pm >= ML / 256) return;
            const int dd0 = 8 * fq;
            bf16_t* dst = (isq ? QD : KD) + tl * 256 + wc * 64 + dd0; const float sc = isq ? QSCALE : 1.f;
            const bool lat = u.pm < ML / 256, byrow = dd0 < 16;
#define PAIRD 32
#define TBASE (TAB + 8192)
#define TSTR 16
#define TOFF (dd0 & 15)
#define TSIN 1024
            if (byrow) {
#pragma unroll
                for (int ai = 0; ai < 2; ++ai) { ROPE_TAB(row0 + ai * 128)
#pragma unroll
                    for (int m = 0; m < 4; ++m) ROPE_ROW(ai, m); }
            } else {
#pragma unroll
                for (int m = 0; m < 4; ++m) { ROPE_TAB(row0 + m * 16)
#pragma unroll
                    for (int ai = 0; ai < 2; ++ai) ROPE_ROW(ai, m); }
            }
#undef PAIRD
#undef TBASE
#undef TSTR
#undef TOFF
#undef TSIN
        } else {
            bf16_t* dst = VD + (u.pn - 8) * 256 + j0;
#pragma unroll
            EPI_ROWS { bf16_t* rp = dst + (size_t)(row0 + ai * 128 + m * 16) * 1024; *(u32x4*)rp = pack8(acc[ai][0][m][0], acc[ai][0][m][1]); *(u32x4*)(rp + 128) = pack8(acc[ai][1][m][0], acc[ai][1][m][1]); }
        }
    } };
__device__ __forceinline__ f32x4 silu4(const f32x4& v) { f32x4 r; r[0] = siluf(v[0]); r[1] = siluf(v[1]); r[2] = siluf(v[2]); r[3] = siluf(v[3]); return r; }
__device__ __forceinline__ f32x4 sigm4(const f32x4& v) { f32x4 r; r[0] = sigmf(v[0]); r[1] = sigmf(v[1]); r[2] = sigmf(v[2]); r[3] = sigmf(v[3]); return r; }
struct FEpiGr { static constexpr bool PERM = true, AFTER_DRAIN = false; bf16_t* YR; const float* RS;
    __device__ __forceinline__ void operator()(AccT acc, const pg8::Unit& u, int wr, int wc, int fr, int fq) const {
        const int row0 = u.pm * 256 + wr * 64 + fr, j0 = wc * 32 + 8 * fq, h = u.pn >> 1;
#pragma unroll
        EPI_ROWS { const int row = row0 + ai * 128 + m * 16; const float mu = RS[(row * 4 + h) * 2], rs = RS[(row * 4 + h) * 2 + 1];
            bf16_t* rp = YR + (size_t)row * 2048 + u.pn * 256 + j0;
#pragma unroll
            for (int bj = 0; bj < 2; ++bj) { f32x4 ya, yb; unpack8(*(const u32x4*)(rp + bj * 128), ya, yb);
                *(u32x4*)(rp + bj * 128) = pack8(silu4(acc[ai][bj][m][0]) * ((ya - mu) * rs), silu4(acc[ai][bj][m][1]) * ((yb - mu) * rs)); } }
    } };
struct FEpiGate { static constexpr bool PERM = true, AFTER_DRAIN = false; bf16_t* SG; const float* bg;
    __device__ __forceinline__ void operator()(AccT acc, const pg8::Unit& u, int wr, int wc, int fr, int fq) const {
        const int row0 = u.pm * 256 + wr * 64 + fr, c0 = u.pn * 256 + wc * 32 + 8 * fq;
        f32x4 bv[2][2];
#pragma unroll
        for (int bj = 0; bj < 2; ++bj) { bv[bj][0] = *(const f32x4*)(bg + c0 + bj * 128); bv[bj][1] = *(const f32x4*)(bg + c0 + bj * 128 + 4); }
#pragma unroll
        EPI_ROWS { bf16_t* rp = SG + (size_t)(row0 + ai * 128 + m * 16) * 2048 + c0;
#pragma unroll
            for (int bj = 0; bj < 2; ++bj) *(u32x4*)(rp + bj * 128) = pack8(sigm4(acc[ai][bj][m][0] + bv[bj][0]), sigm4(acc[ai][bj][m][1] + bv[bj][1])); }
    } };
struct FEpiMr { static constexpr bool PERM = true, AFTER_DRAIN = false; float* MR; const bf16_t* SG;
    __device__ __forceinline__ void operator()(AccT acc, const pg8::Unit& u, int wr, int wc, int fr, int fq) const {
        const int row0 = u.pm * 256 + wr * 64 + fr, c0 = u.pn * 256 + wc * 32 + 8 * fq;
#pragma unroll
        EPI_ROWS { const int row = row0 + ai * 128 + m * 16;
#pragma unroll
            for (int bj = 0; bj < 2; ++bj) { f32x4 ga, gb; unpack8(*(const u32x4*)(SG + (size_t)row * 2048 + c0 + bj * 128), ga, gb);
                float* op = MR + (size_t)row * 1024 + c0 + bj * 128; *(f32x4*)op = ga * acc[ai][bj][m][0]; *(f32x4*)(op + 4) = gb * acc[ai][bj][m][1]; } }
    } };
struct FEpiMb { static constexpr bool PERM = true, AFTER_DRAIN = false; bf16_t* MB; const float* MR; const bf16_t* SG;
    __device__ __forceinline__ void operator()(AccT acc, const pg8::Unit& u, int wr, int wc, int fr, int fq) const {
        const int row0 = u.pm * 256 + wr * 64 + fr, c0 = u.pn * 256 + wc * 32 + 8 * fq;
#pragma unroll
        EPI_ROWS { const int row = row0 + ai * 128 + m * 16;
#pragma unroll
            for (int bj = 0; bj < 2; ++bj) { f32x4 ga, gb; unpack8(*(const u32x4*)(SG + (size_t)row * 2048 + 1024 + c0 + bj * 128), ga, gb);
                const float* ip = MR + (size_t)row * 1024 + c0 + bj * 128;
                *(u32x4*)(MB + (size_t)row * 1024 + c0 + bj * 128) = pack8(*(const f32x4*)ip + ga * acc[ai][bj][m][0], *(const f32x4*)(ip + 4) + gb * acc[ai][bj][m][1]); } }
    } };
struct FEpiZ1 { static constexpr bool PERM = true, AFTER_DRAIN = false; float* Z; const float* x; const float* STATS; const float* g; const float* b; const float* MOD;
    __device__ __forceinline__ void operator()(AccT acc, const pg8::Unit& u, int wr, int wc, int fr, int fq) const {
        const int row0 = u.pm * 256 + wr * 64 + fr, c0 = u.pn * 256 + wc * 32 + 8 * fq;
        const float* g1 = MOD + (u.pm / (SEQ / 256)) * 6144 + 2048;
#pragma unroll
        for (int bj = 0; bj < 2; ++bj)
#pragma unroll
            for (int n = 0; n < 2; ++n) { const int c = c0 + bj * 128 + n * 4; const f32x4 gg = *(const f32x4*)(g + c), bb = *(const f32x4*)(b + c), gm = *(const f32x4*)(g1 + c);
#pragma unroll
                EPI_ROWS { const int row = row0 + ai * 128 + m * 16; const float mu = STATS[row * 2], rs = STATS[row * 2 + 1];
                    const f32x4 xv = *(const f32x4*)(x + (size_t)row * 1024 + c); const f32x4 xn = (xv - mu) * rs * gg + bb;
                    *(f32x4*)(Z + (size_t)row * 1024 + c) = xn * ALPHA + gm * acc[ai][bj][m][n]; } }
    } };
struct FEpiUG { static constexpr bool PERM = true, AFTER_DRAIN = false; bf16_t* U; bf16_t* G;
    __device__ __forceinline__ void operator()(AccT acc, const pg8::Unit& u, int wr, int wc, int fr, int fq) const {
        const int row0 = u.pm * 256 + wr * 64 + fr, c0 = u.pn * 128 + wc * 32 + 8 * fq;
#pragma unroll
        EPI_ROWS { const size_t o = (size_t)(row0 + ai * 128 + m * 16) * DFF + c0; *(u32x4*)(U + o) = pack8(acc[ai][0][m][0], acc[ai][0][m][1]); *(u32x4*)(G + o) = pack8(acc[ai][1][m][0], acc[ai][1][m][1]); }
    } };
struct FEpiZ2 { static constexpr bool PERM = true, AFTER_DRAIN = false; float* Z; const float* MOD;
    __device__ __forceinline__ void operator()(AccT acc, const pg8::Unit& u, int wr, int wc, int fr, int fq) const {
        const int row0 = u.pm * 256 + wr * 64 + fr, c0 = u.pn * 256 + wc * 32 + 8 * fq;
        const float* g2 = MOD + (u.pm / (SEQ / 256)) * 6144 + 5120;
#pragma unroll
        for (int bj = 0; bj < 2; ++bj)
#pragma unroll
            for (int n = 0; n < 2; ++n) { const int c = c0 + bj * 128 + n * 4; const f32x4 gm = *(const f32x4*)(g2 + c);
#pragma unroll
                EPI_ROWS { float* zp = Z + (size_t)(row0 + ai * 128 + m * 16) * 1024 + c; *(f32x4*)zp = *(const f32x4*)zp * ALPHA + gm * acc[ai][bj][m][n]; } }
    } };
template <class Epi> __device__ __forceinline__ void fast_gemm(unsigned char* lds, const bf16_t* A, const bf16_t* Bt, int M, int N, int K, const Epi& E) {
    pg8::Gemm g{A, Bt, M, N, K}; pg8::StaticOrder S; S.init(M, N, (int)gridDim.x, (int)blockIdx.x);
    pg8::gemm_phase<Epi, pg8::StaticOrder, true, true>((PG8_LAS unsigned char*)lds, g, S, E);
    __syncthreads();
}

namespace fa {
using bf16x8 = __attribute__((ext_vector_type(8))) short;
using s16x4  = __attribute__((ext_vector_type(4))) short;
using f32x16 = __attribute__((ext_vector_type(16))) float;
using u32x4  = __attribute__((ext_vector_type(4))) unsigned;
constexpr int NW = 8, QBLK = 32, KVBLK = 64, LD = 1024, NT = 68;
constexpr float THR = 8.f;
constexpr int SHM_V = KVBLK * 128 * 2, SHM_K = KVBLK * 64 * 2;
constexpr int OFF_K = 2 * SHM_V, OFF_WS = OFF_K + 2 * SHM_K, OFF_OST = OFF_WS + NW * 64 * 4, SHM_ATTN = OFF_OST + NW * 8192;
#define KSWZ64(row, colB) ((row) * 128 + ((colB) ^ ((((row) >> 1) & 7) << 4)))
#define SBAR() __builtin_amdgcn_sched_barrier(0)
__device__ __forceinline__ int crow(int r, int hi) { return (r & 3) + 8 * (r >> 2) + 4 * hi; }
__device__ __forceinline__ unsigned cvtpk(float lo, float hi) { unsigned r; asm volatile("v_cvt_pk_bf16_f32 %0, %1, %2" : "=v"(r) : "v"(lo), "v"(hi)); return r; }
__device__ __forceinline__ void partialSM(f32x16& p0, f32x16& p1, float& m_reg, float& mn, float& alpha) {
  constexpr float C = 1.4426950408889634f;
  float pmax = p0[0];
#pragma unroll
  for (int r = 1; r < 16; ++r) pmax = fmaxf(pmax, p0[r]);
#pragma unroll
  for (int r = 0; r < 16; ++r) pmax = fmaxf(pmax, p1[r]);
  { auto rr = __builtin_amdgcn_permlane32_swap(__float_as_uint(pmax), __float_as_uint(pmax), false, false);
    pmax = fmaxf(__uint_as_float(rr[0]), __uint_as_float(rr[1])); }
  if (__builtin_expect(__all(pmax - m_reg <= THR), 1)) { mn = m_reg; alpha = 1.f; }
  else { mn = fmaxf(m_reg, pmax); alpha = __builtin_amdgcn_exp2f((m_reg - mn) * C); m_reg = mn; }
  float mnC = -mn * C;
#pragma unroll
  for (int r = 0; r < 16; ++r) p0[r] = fmaf(p0[r], C, mnC);
#pragma unroll
  for (int r = 0; r < 16; ++r) p1[r] = fmaf(p1[r], C, mnC);
#pragma unroll
  for (int r = 0; r < 16; ++r) p0[r] = __builtin_amdgcn_exp2f(p0[r]);
}
__device__ __forceinline__ void finishSM(f32x16& p0, f32x16& p1, float alpha, float& l_reg, bf16x8& pa0, bf16x8& pa1, bf16x8& pa2, bf16x8& pa3) {
#pragma unroll
  for (int r = 0; r < 16; ++r) p1[r] = __builtin_amdgcn_exp2f(p1[r]);
  float ps = 0;
#pragma unroll
  for (int r = 0; r < 16; ++r) ps += p0[r];
#pragma unroll
  for (int r = 0; r < 16; ++r) ps += p1[r];
  { auto rr = __builtin_amdgcn_permlane32_swap(__float_as_uint(ps), __float_as_uint(ps), false, false);
    ps = __uint_as_float(rr[0]) + __uint_as_float(rr[1]); }
  l_reg = l_reg * alpha + ps;
#define PK4(P, BASE, OUT) do { unsigned a0 = cvtpk(P[BASE + 0], P[BASE + 1]), a1 = cvtpk(P[BASE + 2], P[BASE + 3]);   \
    unsigned b0 = cvtpk(P[BASE + 4], P[BASE + 5]), b1 = cvtpk(P[BASE + 6], P[BASE + 7]);                              \
    auto r0 = __builtin_amdgcn_permlane32_swap(a0, b0, false, false); auto r1 = __builtin_amdgcn_permlane32_swap(a1, b1, false, false); \
    u32x4 w = {r0[0], r1[0], r0[1], r1[1]}; OUT = *reinterpret_cast<bf16x8*>(&w); } while (0)
  PK4(p0, 0, pa0); PK4(p0, 8, pa1); PK4(p1, 0, pa2); PK4(p1, 8, pa3);
#undef PK4
}
__device__ __forceinline__ void qkt(f32x16& p0, f32x16& p1, const char* Ks, const bf16x8* qr, int r32, int hi) {
  p0 = f32x16{}; p1 = f32x16{};
#pragma unroll
  for (int d0 = 0; d0 < 4; ++d0) { const int cb = (d0 * 16 + hi * 8) * 2;
    bf16x8 b0 = *reinterpret_cast<const bf16x8*>(Ks + KSWZ64(r32, cb));
    bf16x8 b1 = *reinterpret_cast<const bf16x8*>(Ks + KSWZ64(32 + r32, cb));
    p0 = __builtin_amdgcn_mfma_f32_32x32x16_bf16(b0, qr[d0], p0, 0, 0, 0);
    p1 = __builtin_amdgcn_mfma_f32_32x32x16_bf16(b1, qr[d0], p1, 0, 0, 0); }
}
__device__ __forceinline__ int v_st(int k, int c) { const int kk = (k & ~0xC) | ((k & 4) << 1) | ((k & 8) >> 1); return ((kk >> 3) * 4 + (c >> 5)) * 512 + ((kk & 7) * 32 + (c & 31)) * 2; }
__device__ __forceinline__ int v_rd_base(int lane) { return ((lane & 3) << 3) | (((lane >> 2) & 3) << 6) | (((lane >> 4) & 1) << 5) | (((lane >> 5) & 1) << 8); }
constexpr int v_rd_off(int d0, int ks, int half) { return d0 * 512 + ks * 4096 + half * 2048; }
template <int OFF> __device__ __forceinline__ s16x4 tr_read(int vb) { s16x4 r; asm volatile("ds_read_b64_tr_b16 %0, %1 offset:%2" : "=&v"(r) : "v"(vb), "i"(OFF) : "memory"); return r; }
template <int D0> __device__ __forceinline__ void pv_one(f32x16& od, int vb, bf16x8 pa0, bf16x8 pa1, bf16x8 pa2, bf16x8 pa3) {
  const s16x4 l0 = tr_read<v_rd_off(D0, 0, 0)>(vb), h0 = tr_read<v_rd_off(D0, 0, 1)>(vb), l1 = tr_read<v_rd_off(D0, 1, 0)>(vb), h1 = tr_read<v_rd_off(D0, 1, 1)>(vb);
  const s16x4 l2 = tr_read<v_rd_off(D0, 2, 0)>(vb), h2 = tr_read<v_rd_off(D0, 2, 1)>(vb), l3 = tr_read<v_rd_off(D0, 3, 0)>(vb), h3 = tr_read<v_rd_off(D0, 3, 1)>(vb);
  asm volatile("s_waitcnt lgkmcnt(0)" ::: "memory"); SBAR();
#define PK(L, H) (bf16x8){L[0], L[1], L[2], L[3], H[0], H[1], H[2], H[3]}
  od = __builtin_amdgcn_mfma_f32_32x32x16_bf16(pa0, PK(l0, h0), od, 0, 0, 0);
  od = __builtin_amdgcn_mfma_f32_32x32x16_bf16(pa1, PK(l1, h1), od, 0, 0, 0);
  od = __builtin_amdgcn_mfma_f32_32x32x16_bf16(pa2, PK(l2, h2), od, 0, 0, 0);
  od = __builtin_amdgcn_mfma_f32_32x32x16_bf16(pa3, PK(l3, h3), od, 0, 0, 0);
#undef PK
}
__device__ __forceinline__ void pv_d0(f32x16* o, int vb, bf16x8 pa0, bf16x8 pa1, bf16x8 pa2, bf16x8 pa3) {
  pv_one<0>(o[0], vb, pa0, pa1, pa2, pa3); pv_one<1>(o[1], vb, pa0, pa1, pa2, pa3); pv_one<2>(o[2], vb, pa0, pa1, pa2, pa3); pv_one<3>(o[3], vb, pa0, pa1, pa2, pa3);
}

__device__ __forceinline__ void attn_unit(int b, int h, int qb, const bf16_t* __restrict__ QD, const bf16_t* __restrict__ KD, const bf16_t* __restrict__ VD, bf16_t* __restrict__ AD,
                                          float lam, const float* __restrict__ gsub, char* lds) {
  int tid_ = threadIdx.x; asm volatile("" : "+v"(tid_));
  const int tid = tid_, wid = tid >> 6, lane = tid & 63, r32 = lane & 31, hi = lane >> 5;
  char* V_lds = lds; char* K_lds = lds + OFF_K;
  float* ws = (float*)(lds + OFF_WS) + wid * 64; float* li_l = ws; float* al_l = ws + 32;
  char* ost = lds + OFF_OST + wid * 8192;
  const long qrow0 = (long)b * SEQ + qb * 256;
  const int sr = tid >> 4, sc = (tid & 15) * 8, vst0 = v_st(sr, sc);
  const int kr = tid >> 3, kc = (tid & 7) * 8, kst = KSWZ64(kr, kc * 2);
  const int koff = kr * LD + kc, voff = sr * LD + sc;
  const int vb0 = (int)(uintptr_t)V_lds + v_rd_base(lane);
#pragma unroll 1
  for (int c = 0; c < 2; ++c) {
    float m_reg = -1e30f, l_reg = 0; f32x16 o[4] = {}; bf16x8 qr[4];
    const bf16_t* Qw = QD + (qrow0 + wid * QBLK + r32) * LD + h * 128 + c * 64 + hi * 8;
#pragma unroll
    for (int d0 = 0; d0 < 4; ++d0) qr[d0] = *reinterpret_cast<const bf16x8*>(Qw + d0 * 16);
    const bf16_t* Kl = KD + (long)b * SEQ * LD + h * 128 + c * 64;
    const bf16_t* Kc = KD + ((long)ML + b * CTX) * LD + h * 128 + c * 64;
    const bf16_t* Vl = VD + (long)b * SEQ * LD + h * 128;
    const bf16_t* Vc = VD + ((long)ML + b * CTX) * LD + h * 128;
    constexpr int SDEPTH = 2;
    struct { bf16x8 vs0, vs1, ks; } sr_[SDEPTH];
#define SLOAD(i, j) do { const long to_ = ((j) < 64) ? (long)(j) * (64 * LD) : (long)((j) - 64) * (64 * LD); const bf16_t* kp_ = ((j) < 64 ? Kl : Kc) + to_; const bf16_t* vp_ = ((j) < 64 ? Vl : Vc) + to_; \
    sr_[i].vs0 = *reinterpret_cast<const bf16x8*>(vp_ + voff); sr_[i].vs1 = *reinterpret_cast<const bf16x8*>(vp_ + voff + 32 * LD); sr_[i].ks = *reinterpret_cast<const bf16x8*>(kp_ + koff); } while (0)
#define SWRITE(bb, i) do { *(bf16x8*)(V_lds + (bb) * SHM_V + vst0) = sr_[i].vs0; *(bf16x8*)(V_lds + (bb) * SHM_V + vst0 + 8192) = sr_[i].vs1; *(bf16x8*)(K_lds + (bb) * SHM_K + kst) = sr_[i].ks; } while (0)
#define SWAIT() do { if constexpr (SDEPTH == 2) asm volatile("s_waitcnt vmcnt(3)" ::: "memory"); else asm volatile("s_waitcnt vmcnt(0)" ::: "memory"); } while (0)
#define RESC(a) do { if (__any((a) < 1.f)) { if (hi == 0) al_l[r32] = (a); asm volatile("s_waitcnt lgkmcnt(0)" ::: "memory"); \
    _Pragma("unroll") for (int d = 0; d < 4; ++d) _Pragma("unroll") for (int r = 0; r < 16; ++r) o[d][r] *= al_l[crow(r, hi)]; } } while (0)
    f32x16 pA0, pA1, pB0, pB1; float mnA, mnB, alA, alB; bf16x8 pa0, pa1, pa2, pa3;
    constexpr int SE = 0, SO = SDEPTH - 1;
    SLOAD(SE, 0); asm volatile("s_waitcnt vmcnt(0)" ::: "memory"); SWRITE(0, SE); __syncthreads();
    qkt(pA0, pA1, K_lds, qr, r32, hi); partialSM(pA0, pA1, m_reg, mnA, alA);
    SLOAD(SO, 1); if constexpr (SDEPTH == 2) SLOAD(SE, 2);
    SWAIT(); SWRITE(1, SO); __syncthreads();
    for (int j = 1; j + 1 < NT; j += 2) {
      SBAR(); qkt(pB0, pB1, K_lds + SHM_K, qr, r32, hi);
      finishSM(pA0, pA1, alA, l_reg, pa0, pa1, pa2, pa3); SBAR();
      SLOAD(SO, j + SDEPTH); SBAR();
      pv_d0(o, vb0, pa0, pa1, pa2, pa3); partialSM(pB0, pB1, m_reg, mnB, alB);
      __syncthreads(); SWAIT(); SWRITE(0, SE);
      RESC(alB); __syncthreads();
      SBAR(); qkt(pA0, pA1, K_lds, qr, r32, hi);
      finishSM(pB0, pB1, alB, l_reg, pa0, pa1, pa2, pa3); SBAR();
      if (SDEPTH == 1 || j + 3 < NT) SLOAD(SE, j + 1 + SDEPTH); SBAR();
      pv_d0(o, vb0 + SHM_V, pa0, pa1, pa2, pa3); partialSM(pA0, pA1, m_reg, mnA, alA);
      __syncthreads(); SWAIT(); SWRITE(1, SO);
      RESC(alA); __syncthreads();
    }
    SBAR(); qkt(pB0, pB1, K_lds + SHM_K, qr, r32, hi);
    finishSM(pA0, pA1, alA, l_reg, pa0, pa1, pa2, pa3); SBAR();
    pv_d0(o, vb0, pa0, pa1, pa2, pa3); partialSM(pB0, pB1, m_reg, mnB, alB);
    __syncthreads(); RESC(alB);
    finishSM(pB0, pB1, alB, l_reg, pa0, pa1, pa2, pa3); SBAR();
    pv_d0(o, vb0 + SHM_V, pa0, pa1, pa2, pa3);
#undef SLOAD
#undef SWRITE
#undef SWAIT
#undef RESC
    if (hi == 0) li_l[r32] = l_reg; asm volatile("s_waitcnt lgkmcnt(0)" ::: "memory");
    float rli[16];
#pragma unroll
    for (int r = 0; r < 16; ++r) rli[r] = __builtin_amdgcn_rcpf(li_l[crow(r, hi)]);
    unsigned* pst = (unsigned*)ost;
    if (c == 0) {
#pragma unroll
      for (int d0 = 0; d0 < 4; ++d0)
#pragma unroll
        for (int rp = 0; rp < 8; ++rp) pst[(d0 * 8 + rp) * 64 + lane] = cvtpk(o[d0][2 * rp] * rli[2 * rp], o[d0][2 * rp + 1] * rli[2 * rp + 1]);
    } else {
#pragma unroll
      for (int d0 = 0; d0 < 4; ++d0)
#pragma unroll
        for (int rp = 0; rp < 8; ++rp) { const unsigned w = pst[(d0 * 8 + rp) * 64 + lane];
          o[d0][2 * rp] = __uint_as_float(w << 16) - lam * (o[d0][2 * rp] * rli[2 * rp]); o[d0][2 * rp + 1] = __uint_as_float(w & 0xffff0000u) - lam * (o[d0][2 * rp + 1] * rli[2 * rp + 1]); }
      asm volatile("s_waitcnt lgkmcnt(0)" ::: "memory");
      float* stf = (float*)ost;
      const int ch = lane & 15, rq = lane >> 4;
      f32x4 g0 = *(const f32x4*)(gsub + ch * 8), g1 = *(const f32x4*)(gsub + ch * 8 + 4); g0 = g0 * (1.f - LAM_INIT); g1 = g1 * (1.f - LAM_INIT);
#pragma unroll
      for (int rh = 0; rh < 2; ++rh) {
#pragma unroll
        for (int rr = 0; rr < 8; ++rr) { const int lr = (rr & 3) + 8 * (rr >> 2) + 4 * hi;
#pragma unroll
          for (int d0 = 0; d0 < 4; ++d0) stf[lr * 128 + d0 * 32 + r32] = o[d0][rh * 8 + rr]; }
        asm volatile("s_waitcnt lgkmcnt(0)" ::: "memory");
#pragma unroll
        for (int i = 0; i < 4; ++i) { const int row = i * 4 + rq;
          f32x4 v0 = *(const f32x4*)(stf + row * 128 + ch * 8), v1 = *(const f32x4*)(stf + row * 128 + ch * 8 + 4);
          float ss = (v0[0] * v0[0] + v0[1] * v0[1]) + (v0[2] * v0[2] + v0[3] * v0[3]) + (v1[0] * v1[0] + v1[1] * v1[1]) + (v1[2] * v1[2] + v1[3] * v1[3]);
          ss += __shfl_xor(ss, 1); ss += __shfl_xor(ss, 2); ss += __shfl_xor(ss, 4); ss += __shfl_xor(ss, 8);
          const float rs = 1.f / sqrtf(ss * (1.f / 128.f) + LN_EPS);
          v0 = v0 * rs * g0; v1 = v1 * rs * g1;
          u32x4 w; w.x = cvtpk(v0[0], v0[1]); w.y = cvtpk(v0[2], v0[3]); w.z = cvtpk(v1[0], v1[1]); w.w = cvtpk(v1[2], v1[3]);
          *(u32x4*)(AD + (qrow0 + wid * QBLK + rh * 16 + row) * LD + h * 128 + ch * 8) = w; }
        asm volatile("s_waitcnt lgkmcnt(0)" ::: "memory");
      }
    }
    __syncthreads();
  }
}
#undef KSWZ64
#undef SBAR
}
__device__ __forceinline__ void d_attn_fast(const Ctx& C, const bf16_t* __restrict__ QD, const bf16_t* __restrict__ KD, const bf16_t* __restrict__ VD, bf16_t* __restrict__ AD,
                                            const float* __restrict__ SCAL, const float* __restrict__ gsub) {
  const float lam = SCAL[0];
  const int vcu = (C.G % 8 == 0) ? (C.bx % 8) * (C.G / 8) + C.bx / 8 : C.bx;
  for (int i = 0; (long)i * C.G + vcu < 1024; ++i) {
    int bh, qb;
    if (C.G == 256) { bh = (vcu >> 5) * 8 + i * 2 + ((vcu & 31) >> 4); qb = vcu & 15; }
    else { const int L = i * C.G + vcu; bh = L >> 4; qb = L & 15; }
    fa::attn_unit(bh >> 3, bh & 7, qb, QD, KD, VD, AD, lam, gsub, (char*)C.lds);
  }
}

namespace rt {
typedef __attribute__((address_space(3))) unsigned char* lptr;
typedef short v4i16_t __attribute__((ext_vector_type(4)));
typedef unsigned u32x2 __attribute__((ext_vector_type(2)));
constexpr int RSQ = 544, RSV = 160;
constexpr int O_Q = 0, O_K = 64 * RSQ, O_ST = 2 * 64 * RSQ, O_V = 3 * 64 * RSQ, O_VP = O_V + 64 * RSV, O_P = O_VP + 64 * RSV, O_END = O_P + 64 * RSV;
constexpr int NSTEP = 68;
__device__ __forceinline__ bf16x8 ld128(lptr p) { return *(const __attribute__((address_space(3))) bf16x8*)p; }
__device__ __forceinline__ bf16x8 trfrag(lptr lo, lptr hi) {
    const v4i16_t a = __builtin_amdgcn_ds_read_tr16_b64_v4i16((__attribute__((address_space(3))) v4i16_t*)lo), b = __builtin_amdgcn_ds_read_tr16_b64_v4i16((__attribute__((address_space(3))) v4i16_t*)hi);
    return (bf16x8){a[0], a[1], a[2], a[3], b[0], b[1], b[2], b[3]}; }
__device__ __forceinline__ u32x2 pack4(const f32x4& v) { u32x2 w; w.x = cvtpk(v[0], v[1]); w.y = cvtpk(v[2], v[3]); return w; }
#define MFMA16(a, b, c) __builtin_amdgcn_mfma_f32_16x16x32_bf16((a), (b), (c), 0, 0, 0)

template <int PASS>
__device__ __forceinline__ void ret_pass(int b, int h, int vs, const bf16_t* __restrict__ QR, const bf16_t* __restrict__ KR, const bf16_t* __restrict__ VR, bf16_t* __restrict__ YR,
                                         const float lgf2, const float lgb2, const lptr lds, const int tid, const int w, const int fr, const int fq) {
    const int ct = w & 3, it0 = 2 * (w >> 2), jt = w & 3;
    const int qrow = tid >> 5, qch = tid & 31, vrow = tid >> 3, vch = tid & 7;
    const int li4 = (fr >> 2), lip = (fr & 3);
    const lptr pS = lds + O_ST + (16 * ct + fr) * RSQ + 16 * fq;
    const lptr pQ0 = lds + O_Q + (16 * it0 + fr) * RSQ + 16 * fq, pQ1 = pQ0 + 16 * RSQ;
    const lptr pK = lds + O_K + (16 * jt + fr) * RSQ + 16 * fq;
    const lptr pPw = lds + O_P + (16 * it0 + fr) * RSV + (16 * jt + 4 * fq) * 2;
    const lptr pPr = lds + O_P + (16 * it0 + fr) * RSV + (4 * fq) * 2;
    const lptr pVt = lds + O_V + (4 * fq + li4) * RSV + (16 * ct + 4 * lip) * 2;
    const lptr pKt = lds + O_K + (4 * fq + li4) * RSQ + (32 * w + 4 * lip) * 2;
    const lptr pVPt = lds + O_VP + (4 * fq + li4) * RSV + (4 * lip) * 2;
    const lptr pSTw = lds + O_ST + fr * RSQ + (32 * w + 4 * fq) * 2;
    const float lg2 = PASS ? lgb2 : lgf2, ds = __builtin_amdgcn_exp2f(lg2 * 64.f);
    const float dkv = __builtin_amdgcn_exp2f(lg2 * (PASS ? (float)vrow : (float)(63 - vrow)));
    float dq[2], msk[2][4];
#pragma unroll
    for (int t = 0; t < 2; ++t) { const int i = 16 * (it0 + t) + fr; dq[t] = __builtin_amdgcn_exp2f(lg2 * (PASS ? (float)(64 - i) : (float)(i + 1)));
#pragma unroll
        for (int r = 0; r < 4; ++r) { const int j = 16 * jt + 4 * fq + r, dd = i - j; msk[t][r] = dd > 0 ? __builtin_amdgcn_exp2f(lgf2 * (float)dd) : (dd < 0 ? __builtin_amdgcn_exp2f(lgb2 * (float)(-dd)) : 2.f); } }
    f32x4 S[2][4];
#pragma unroll
    for (int dt = 0; dt < 2; ++dt)
#pragma unroll
        for (int c4 = 0; c4 < 4; ++c4) S[dt][c4] = (f32x4){0.f, 0.f, 0.f, 0.f};
    bf16x8 stq[4], stk[4], stv;
#define RT_ROWBASE(step, rb, rq, lat) do { if ((step) < 4) { const int cc_ = PASS ? 3 - (step) : (step); rb = ML + b * CTX + cc_ * 64; rq = b * SEQ; lat = false; } \
        else { const int n_ = PASS ? (NSTEP - 1) - (step) : (step) - 4; rb = b * SEQ + n_ * 64; rq = rb; lat = true; } } while (0)
#define RT_LOAD(step) do { int rb_, rq_; bool lat_; RT_ROWBASE(step, rb_, rq_, lat_); (void)lat_; \
        _Pragma("unroll") for (int k = 0; k < 4; ++k) { stk[k] = *(const bf16x8*)(KR + (size_t)(rb_ + qrow + 16 * k) * 1024 + h * 256 + qch * 8); \
            stq[k] = *(const bf16x8*)(QR + (size_t)(rq_ + qrow + 16 * k) * 1024 + h * 256 + qch * 8); } \
        stv = *(const bf16x8*)(VR + (size_t)(rb_ + vrow) * 2048 + h * 512 + vs * 64 + vch * 8); } while (0)
#define RT_WRITE() do { \
        _Pragma("unroll") for (int k = 0; k < 4; ++k) { *(__attribute__((address_space(3))) bf16x8*)(lds + O_K + (qrow + 16 * k) * RSQ + qch * 16) = stk[k]; \
            *(__attribute__((address_space(3))) bf16x8*)(lds + O_Q + (qrow + 16 * k) * RSQ + qch * 16) = stq[k]; } \
        *(__attribute__((address_space(3))) bf16x8*)(lds + O_V + vrow * RSV + vch * 16) = stv; \
        { f32x4 a_, b_; unpack8(__builtin_bit_cast(u32x4, stv), a_, b_); a_ = a_ * dkv; b_ = b_ * dkv; const u32x4 w_ = pack8(a_, b_); \
          *(__attribute__((address_space(3))) u32x4*)(lds + O_VP + vrow * RSV + vch * 16) = w_; } } while (0)
    RT_LOAD(0); RT_WRITE();
#pragma unroll 1
    for (int step = 0; step < NSTEP; ++step) {
        int rowbase, rq_unused; bool lat; RT_ROWBASE(step, rowbase, rq_unused, lat); (void)rq_unused;
        __syncthreads();
        bf16_t* yp0 = YR + (size_t)(rowbase + 16 * it0 + fr) * 2048 + h * 512 + vs * 64 + 16 * ct + 4 * fq; bf16_t* yp1 = yp0 + (size_t)16 * 2048;
        u32x2 yo0 = {0u, 0u}, yo1 = {0u, 0u};
        if (PASS == 1 && lat) { yo0 = *(const u32x2*)yp0; yo1 = *(const u32x2*)yp1; }
        { const int nx = step + 1 < NSTEP ? step + 1 : step; RT_LOAD(nx); }
        if (lat) {
            f32x4 ay0 = {0.f, 0.f, 0.f, 0.f}, ay1 = ay0, ap0 = ay0, ap1 = ay0;
            bf16x8 as_c = ld128(pS), q0_c = ld128(pQ0), q1_c = ld128(pQ1), ak_c = q0_c;
            if (PASS == 0) ak_c = ld128(pK);
#pragma unroll
            for (int ks = 0; ks < 8; ++ks) {
                bf16x8 as_n = as_c, q0_n = q0_c, q1_n = q1_c, ak_n = ak_c;
                if (ks < 7) { as_n = ld128(pS + 64 * (ks + 1)); q0_n = ld128(pQ0 + 64 * (ks + 1)); q1_n = ld128(pQ1 + 64 * (ks + 1)); if (PASS == 0) ak_n = ld128(pK + 64 * (ks + 1)); }
                ay0 = MFMA16(as_c, q0_c, ay0); ay1 = MFMA16(as_c, q1_c, ay1);
                if (PASS == 0) { ap0 = MFMA16(ak_c, q0_c, ap0); ap1 = MFMA16(ak_c, q1_c, ap1); }
                as_c = as_n; q0_c = q0_n; q1_c = q1_n; ak_c = ak_n;
            }
            ay0 = ay0 * dq[0]; ay1 = ay1 * dq[1];
            if (PASS == 0) {
#pragma unroll
                for (int r = 0; r < 4; ++r) { ap0[r] *= msk[0][r]; ap1[r] *= msk[1][r]; }
                *(__attribute__((address_space(3))) u32x2*)(pPw) = pack4(ap0); *(__attribute__((address_space(3))) u32x2*)(pPw + 16 * RSV) = pack4(ap1);
                __syncthreads();
                const bf16x8 av0 = trfrag(pVt, pVt + 16 * RSV), av1 = trfrag(pVt + 32 * RSV, pVt + 32 * RSV + 16 * RSV);
                u32x2 pl[2][2], ph[2][2];
#pragma unroll
                for (int ks = 0; ks < 2; ++ks)
#pragma unroll
                    for (int t = 0; t < 2; ++t) { pl[ks][t] = *(const __attribute__((address_space(3))) u32x2*)(pPr + t * 16 * RSV + ks * 64); ph[ks][t] = *(const __attribute__((address_space(3))) u32x2*)(pPr + t * 16 * RSV + ks * 64 + 32); }
#pragma unroll
                for (int ks = 0; ks < 2; ++ks) { const u32x4 b0 = {pl[ks][0].x, pl[ks][0].y, ph[ks][0].x, ph[ks][0].y}, b1 = {pl[ks][1].x, pl[ks][1].y, ph[ks][1].x, ph[ks][1].y};
                    ay0 = MFMA16(ks ? av1 : av0, __builtin_bit_cast(bf16x8, b0), ay0); ay1 = MFMA16(ks ? av1 : av0, __builtin_bit_cast(bf16x8, b1), ay1); }
                *(u32x2*)yp0 = pack4(ay0); *(u32x2*)yp1 = pack4(ay1);
            } else {
                f32x4 o0, o1;
                o0[0] = __uint_as_float(yo0.x << 16); o0[1] = __uint_as_float(yo0.x & 0xffff0000u); o0[2] = __uint_as_float(yo0.y << 16); o0[3] = __uint_as_float(yo0.y & 0xffff0000u);
                o1[0] = __uint_as_float(yo1.x << 16); o1[1] = __uint_as_float(yo1.x & 0xffff0000u); o1[2] = __uint_as_float(yo1.y << 16); o1[3] = __uint_as_float(yo1.y & 0xffff0000u);
                *(u32x2*)yp0 = pack4(ay0 + o0); *(u32x2*)yp1 = pack4(ay1 + o1);
            }
        }
        bf16x8 ak[2][2], bv[2][4];
#pragma unroll
        for (int ks = 0; ks < 2; ++ks) {
#pragma unroll
            for (int dt = 0; dt < 2; ++dt) ak[ks][dt] = trfrag(pKt + dt * 32 + ks * 32 * RSQ, pKt + dt * 32 + ks * 32 * RSQ + 16 * RSQ);
#pragma unroll
            for (int c4 = 0; c4 < 4; ++c4) bv[ks][c4] = trfrag(pVPt + c4 * 32 + ks * 32 * RSV, pVPt + c4 * 32 + ks * 32 * RSV + 16 * RSV);
        }
#pragma unroll
        for (int dt = 0; dt < 2; ++dt)
#pragma unroll
            for (int c4 = 0; c4 < 4; ++c4) S[dt][c4] = S[dt][c4] * ds;
#pragma unroll
        for (int ks = 0; ks < 2; ++ks)
#pragma unroll
            for (int dt = 0; dt < 2; ++dt)
#pragma unroll
                for (int c4 = 0; c4 < 4; ++c4) S[dt][c4] = MFMA16(ak[ks][dt], bv[ks][c4], S[dt][c4]);
        __syncthreads();
#pragma unroll
        for (int dt = 0; dt < 2; ++dt)
#pragma unroll
            for (int c4 = 0; c4 < 4; ++c4) *(__attribute__((address_space(3))) u32x2*)(pSTw + c4 * 16 * RSQ + dt * 32) = pack4(S[dt][c4]);
        RT_WRITE();
    }
    __syncthreads();
#undef RT_ROWBASE
#undef RT_LOAD
#undef RT_WRITE
}
__device__ __forceinline__ void ret_stream(int b, int h, int vs, const bf16_t* __restrict__ QR, const bf16_t* __restrict__ KR, const bf16_t* __restrict__ VR, bf16_t* __restrict__ YR,
                                           const float* __restrict__ SCAL, unsigned char* lds_) {
    int tid_ = threadIdx.x; asm volatile("" : "+v"(tid_));
    const int tid = tid_, w = __builtin_amdgcn_readfirstlane(tid >> 6), lane = tid & 63, fr = lane & 15, fq = lane >> 4;
    const float L2E = 1.4426950408889634f, lgf2 = SCAL[1 + h] * L2E, lgb2 = SCAL[5 + h] * L2E;
    ret_pass<0>(b, h, vs, QR, KR, VR, YR, lgf2, lgb2, (lptr)lds_, tid, w, fr, fq);
    ret_pass<1>(b, h, vs, QR, KR, VR, YR, lgf2, lgb2, (lptr)lds_, tid, w, fr, fq);
}
#undef MFMA16
}
__device__ __forceinline__ void d_ret_fast(const Ctx& C, const bf16_t* __restrict__ QR, const bf16_t* __restrict__ KR, const bf16_t* __restrict__ VR, bf16_t* __restrict__ YR, const float* __restrict__ SCAL) {
    for (int sid0 = C.bx; sid0 < 256; sid0 += C.G) {
        const int sid = (C.G == 256) ? ((sid0 & 7) * 32 + (sid0 >> 3)) : sid0;
        rt::ret_stream(sid >> 5, (sid >> 3) & 3, sid & 7, QR, KR, VR, YR, SCAL, C.lds);
    }
}


typedef __attribute__((address_space(1))) unsigned gu32;
#define RLX_AGENT __ATOMIC_RELAXED, __HIP_MEMORY_SCOPE_AGENT
#define XB_TMO      128
#define XB_XCNT(j)  (256  + 64 * (j))
#define XB_XSUB(j)  (1280 + 64 * (j))
#define XB_XGEN(j)  (2304 + 64 * (j))
#define XB_TOP      3328
#define XB_TOPGEN   3392
#define XCD_BAR_WORDS 3456
#define XB_SPIN_CAP (1u << 18)

__device__ __forceinline__ unsigned xb_ld(unsigned* p)              { return __hip_atomic_load(p, __ATOMIC_RELAXED, __HIP_MEMORY_SCOPE_AGENT); }
__device__ __forceinline__ unsigned xb_add(unsigned* p, unsigned v) { return __hip_atomic_fetch_add(p, v, __ATOMIC_RELAXED, __HIP_MEMORY_SCOPE_AGENT); }
__device__ __forceinline__ unsigned xb_xcc_id() { return (unsigned)__builtin_amdgcn_s_getreg((3 << 11) | 20) & 0xFu; }
#define XB_SPIN(cond, bar) do { unsigned _sp = 0; while (cond) { __builtin_amdgcn_s_sleep(1); \
    if ((++_sp & 255u) == 0u) { if (xb_ld(&(bar)[XB_TMO])) break; if (_sp > XB_SPIN_CAP) { atomicAdd(&(bar)[XB_TMO], 1u); break; } } } } while (0)

struct XcdBarrier {
    unsigned* bar; unsigned x;
    volatile LAS unsigned* st;
};

__device__ __forceinline__ XcdBarrier xcd_barrier_post(unsigned* bar, volatile LAS unsigned* st) {
    XcdBarrier b; b.bar = bar; b.x = xb_xcc_id(); b.st = st;
    if (threadIdx.x == 0) (void)xb_add(&bar[XB_XCNT(b.x)], 1u);
    return b;
}
__device__ __forceinline__ void xcd_barrier_complete(unsigned* bar, unsigned x, unsigned& nloc, unsigned& nx) {
    const unsigned G = gridDim.x * gridDim.y * gridDim.z;
    unsigned sum, cnt, mine, sp = 0u;
    for (;;) {
        sum = 0u; cnt = 0u; mine = 0u;
#pragma unroll
        for (unsigned j = 0; j < 16; ++j) { const unsigned c = xb_ld(&bar[XB_XCNT(j)]); sum += c; cnt += (c > 0u) ? 1u : 0u; mine = (j == x) ? c : mine; }
        if (sum == G) break;
        __builtin_amdgcn_s_sleep(1);
        if ((++sp & 255u) == 0u) { if (xb_ld(&bar[XB_TMO])) break; if (sp > XB_SPIN_CAP) { atomicAdd(&bar[XB_TMO], 1u); break; } }
    }
    nloc = mine > 0u ? mine : 1u; nx = cnt > 0u ? cnt : 1u;
}

__device__ __forceinline__ void xcd_barrier(const XcdBarrier& b) {
    asm volatile("s_waitcnt vmcnt(0)" ::: "memory");
    __syncthreads();
    if (threadIdx.x == 0) {
        unsigned* bar = b.bar;
        __builtin_amdgcn_s_waitcnt(0);
        unsigned nloc = b.st[0], nx = b.st[1];
        if (nloc == 0u) { xcd_barrier_complete(bar, b.x, nloc, nx); b.st[0] = nloc; b.st[1] = nx; }
        const unsigned old = xb_add(&bar[XB_XSUB(b.x)], 1u);
        const unsigned gen = old / nloc;
        if (old + 1u == (gen + 1u) * nloc) {
            __builtin_amdgcn_fence(__ATOMIC_RELEASE, "agent");
            asm volatile("s_waitcnt vmcnt(0)" ::: "memory");
            const unsigned og = xb_add(&bar[XB_TOP], 1u);
            const unsigned tg = og / nx;
            if (og + 1u == (tg + 1u) * nx) xb_add(&bar[XB_TOPGEN], 1u);
            else XB_SPIN(xb_ld(&bar[XB_TOPGEN]) == tg, bar);
            __builtin_amdgcn_fence(__ATOMIC_ACQUIRE, "agent");
            xb_add(&bar[XB_XGEN(b.x)], 1u);
            asm volatile("s_waitcnt vmcnt(0)" ::: "memory");
        } else {
            XB_SPIN(xb_ld(&bar[XB_XGEN(b.x)]) == gen, bar);
            __builtin_amdgcn_fence(__ATOMIC_ACQUIRE, "agent");
            asm volatile("s_waitcnt vmcnt(0)" ::: "memory");
        }
    }
    __syncthreads();
}


__device__ __forceinline__ float gelu1(float v) {
    const float av = fabsf(v), t = __builtin_amdgcn_rcpf(av * 0.2316418882f + 1.0f);
    float q = t * 0.5307027145f + (-0.7265760135f); q = q * t + 0.7107068705f; q = q * t + (-0.142248368f); q = q * t + 0.127414796f; q = q * t;
    const float e = __builtin_amdgcn_exp2f((v * v) * (-0.72134752044f)), m = v * (q * e);
    return v < 0.f ? m : v - m; }
__device__ __forceinline__ f32x4 gelu4(const f32x4& u) { f32x4 r;
#pragma unroll
    for (int i = 0; i < 4; ++i) r[i] = gelu1(u[i]);
    return r; }
__device__ __forceinline__ void d_convgate_v(const Ctx& C, const bf16_t* __restrict__ U, const float* __restrict__ cw, const float* __restrict__ cb, bf16_t* H) {
    constexpr int NFG = DFF / 8, RB = 8, NIT = NFG * (ML / RB);
    for (int it = C.gt; it < NIT; it += C.NGT) {
        const int fg = it % NFG, rb = it / NFG, f = fg * 8, r0 = rb * RB;
        const f32x4 w0a = *(const f32x4*)(cw + f), w0b = *(const f32x4*)(cw + f + 4), w1a = *(const f32x4*)(cw + DFF + f), w1b = *(const f32x4*)(cw + DFF + f + 4);
        const f32x4 w2a = *(const f32x4*)(cw + 2 * DFF + f), w2b = *(const f32x4*)(cw + 2 * DFF + f + 4), ba = *(const f32x4*)(cb + f), bb = *(const f32x4*)(cb + f + 4);
        const int t0 = r0 & (SEQ - 1);
        f32x4 pa = {0.f, 0.f, 0.f, 0.f}, pb = pa, ca, cbv, na, nb;
        if (t0 > 0) unpack8(*(const u32x4*)(U + (size_t)(r0 - 1) * DFF + f), pa, pb);
        unpack8(*(const u32x4*)(U + (size_t)r0 * DFF + f), ca, cbv);
#pragma unroll
        for (int r = 0; r < RB; ++r) { const int row = r0 + r, t = t0 + r;
            if (t < SEQ - 1) unpack8(*(const u32x4*)(U + (size_t)(row + 1) * DFF + f), na, nb); else { na = (f32x4){0.f, 0.f, 0.f, 0.f}; nb = na; }
            f32x4 ga, gb; unpack8(*(const u32x4*)(H + (size_t)row * DFF + f), ga, gb);
            const f32x4 ua = ba + w0a * pa + w1a * ca + w2a * na, ub = bb + w0b * pb + w1b * cbv + w2b * nb;
            *(u32x4*)(H + (size_t)row * DFF + f) = pack8(gelu4(ua) * ga, gelu4(ub) * gb);
            pa = ca; pb = cbv; ca = na; cbv = nb; }
    }
}

#ifndef PROBE_DUP
#define PROBE_DUP -1
#endif
#define REP(k) for (int rep_ = 0; rep_ < ((PROBE_DUP == (k)) ? 2 : 1); ++rep_)
constexpr int LDS_BYTES = 147456;
constexpr int LDS_MISC = 147456 - 64;
struct Params { const float* in[24]; float* out; unsigned char* ws; };
__global__ void __launch_bounds__(512, 2) mega(Params P) {
    extern __shared__ __attribute__((aligned(16))) unsigned char lds[];
    cg::grid_group grid = cg::this_grid();
    { volatile LAS unsigned* m_ = (volatile LAS unsigned*)((LAS unsigned char*)lds + LDS_MISC); if (threadIdx.x < 16) m_[threadIdx.x] = 0u; }
    __syncthreads();
    XcdBarrier bar = xcd_barrier_post((unsigned*)(P.ws + WS_BAR), (volatile LAS unsigned*)((LAS unsigned char*)lds + LDS_MISC));
#define GSYNC() xcd_barrier(bar)
#define CTX() Ctx C; { int t_ = threadIdx.x; asm volatile("" : "+v"(t_)); C.tid = t_; C.lane = C.tid & 63; C.wave = C.tid >> 6; C.bx = blockIdx.x; C.G = gridDim.x; \
    C.gw = C.bx * 8 + C.wave; C.NGW = C.G * 8; C.gt = C.bx * 512 + C.tid; C.NGT = C.G * 512; C.lds = lds; }
    const float* x = P.in[0]; const float* c = P.in[1]; const float* ctx = P.in[2]; const float* cctx = P.in[3];
    const float* lng = P.in[4]; const float* lnb = P.in[5]; const float* wmod = P.in[6]; const float* bmod = P.in[7];
    const float* win = P.in[8]; const float* bgate = P.in[9]; const float* logit = P.in[10]; const float* dlam = P.in[11];
    const float* gsub = P.in[12]; const float* wret = P.in[13]; const float* wdif = P.in[14]; const float* wo = P.in[15];
    const float* ln1g = P.in[16]; const float* ln1b = P.in[17]; const float* wup = P.in[18]; const float* cw = P.in[19];
    const float* cb = P.in[20]; const float* wdn = P.in[21]; const float* ln2g = P.in[22]; const float* ln2b = P.in[23];
    unsigned char* ws = P.ws; float* out = P.out;
    float* MOD = (float*)(ws + WS_MOD); float* TAB = (float*)(ws + WS_TAB); float* SCAL = (float*)(ws + WS_SCAL); float* STATS = (float*)(ws + WS_STATS); float* RS = (float*)(ws + WS_RS);
    bf16_t* WIN = (bf16_t*)(ws + WS_WIN); bf16_t* WRET = (bf16_t*)(ws + WS_WRET); bf16_t* WDIF = (bf16_t*)(ws + WS_WDIF); bf16_t* WO = (bf16_t*)(ws + WS_WO);
    bf16_t* WUP = (bf16_t*)(ws + WS_WUP); bf16_t* WDN = (bf16_t*)(ws + WS_WDN); bf16_t* XM = (bf16_t*)(ws + WS_XM);
    bf16_t* QR = (bf16_t*)(ws + WS_QR); bf16_t* KR = (bf16_t*)(ws + WS_KR); bf16_t* VR = (bf16_t*)(ws + WS_VR); float* SST = (float*)(ws + WS_SST);
    bf16_t* QD = (bf16_t*)(ws + WS_QD); bf16_t* KD = (bf16_t*)(ws + WS_KD); bf16_t* VD = (bf16_t*)(ws + WS_VD); bf16_t* OD = (bf16_t*)(ws + WS_OD); bf16_t* AD = (bf16_t*)(ws + WS_AD);
    bf16_t* SG = (bf16_t*)(ws + WS_SG); float* MR = (float*)(ws + WS_MR); bf16_t* MB = (bf16_t*)(ws + WS_MB);
    bf16_t* UB = (bf16_t*)(ws + WS_U); bf16_t* H = (bf16_t*)(ws + WS_H);
    bf16_t* YR = (bf16_t*)out;

    {
        CTX();
        float* scr = (float*)(lds + 65536) + C.wave * (64 * 33);
        constexpr int I_IN = 16 * 352, I_RET = 32 * 32, I_DIF = 16 * 32, I_O = 16 * 32, I_UP = 16 * 176, I_DN = 44 * 32;
        constexpr int NIT = I_IN + I_RET + I_DIF + I_O + I_UP + I_DN;
        for (int it = C.gw; it < NIT; it += C.NGW) {
            int r = it;
            if (r < I_IN) { transpose_item<1>(win, 1024, NIN, WIN, scr, r, C.lane); continue; } r -= I_IN;
            if (r < I_RET) { transpose_item<0>(wret, 2048, 1024, WRET, scr, r, C.lane); continue; } r -= I_RET;
            if (r < I_DIF) { transpose_item<0>(wdif, 1024, 1024, WDIF, scr, r, C.lane); continue; } r -= I_DIF;
            if (r < I_O) { transpose_item<0>(wo, 1024, 1024, WO, scr, r, C.lane); continue; } r -= I_O;
            if (r < I_UP) { transpose_item<2>(wup, 1024, 5632, WUP, scr, r, C.lane); continue; } r -= I_UP;
            transpose_item<0>(wdn, 2816, 1024, WDN, scr, r, C.lane);
        }
        d_mod(C, c, cctx, wmod, bmod, MOD);
        d_tables(C, logit, dlam, TAB, SCAL);
    }
    grid.sync();
    REP(1) { CTX(); d_lnmod(C, x, ctx, lng, lnb, MOD, XM, STATS); }
    GSYNC();
    REP(2) fast_gemm(lds, XM, WIN + (size_t)C_QR * 1024, MA, 4096, 1024, FEpiRetQKV{QR, KR, VR, TAB});
    GSYNC();
    REP(3) { CTX(); d_ret_fast(C, QR, KR, VR, YR, SCAL); }
    GSYNC();
    REP(11) { CTX(); d_ret_stats(C, YR, RS); }
    REP(4) fast_gemm(lds, XM, WIN + (size_t)C_QD * 1024, MA, 3072, 1024, FEpiDifQKV{QD, KD, VD, TAB});
    GSYNC();
    REP(5) { CTX(); d_attn_fast(C, QD, KD, VD, AD, SCAL, gsub); }
    GSYNC();
    fast_gemm(lds, XM, WIN + (size_t)C_GR * 1024, ML, 2048, 1024, FEpiGr{YR, RS});
    GSYNC();
    REP(6) fast_gemm(lds, XM, WIN + (size_t)C_GATE * 1024, ML, 2048, 1024, FEpiGate{SG, bgate});
    GSYNC();
    REP(7) fast_gemm(lds, YR, WRET, ML, 1024, 2048, FEpiMr{MR, SG});
    GSYNC();
    REP(8) fast_gemm(lds, AD, WDIF, ML, 1024, 1024, FEpiMb{MB, MR, SG});
    GSYNC();
    fast_gemm(lds, MB, WO, ML, 1024, 1024, FEpiZ1{out, x, STATS, lng, lnb, MOD});
    GSYNC();
    { CTX(); d_ln_rows(C, out, ln1g, ln1b, MOD, XM); }
    GSYNC();
    REP(9) fast_gemm(lds, XM, WUP, ML, 5632, 1024, FEpiUG{UB, H});
    GSYNC();
    { CTX(); d_convgate_v(C, UB, cw, cb, H); }
    GSYNC();
    fast_gemm(lds, H, WDN, ML, 1024, DFF, FEpiZ2{out, MOD});
    GSYNC();
    { CTX(); d_ln_rows(C, out, ln2g, ln2b, MOD, (bf16_t*)nullptr); }
}

extern "C" void kernel_launch(void* const* d_in, const int* in_sizes, int n_in, void* d_out, int out_size, void* d_ws, size_t ws_size, hipStream_t stream) {
    static int grid = 0;
    if (grid == 0) {
        if (n_in != 24 || ws_size < WS_NEED) { fprintf(stderr, "kernel_launch: unexpected n_in %d / ws %zu\n", n_in, ws_size); grid = -1; return; }
        int dev = 0, cus = 0, per_cu = 0;
        if (hipGetDevice(&dev) != hipSuccess || hipDeviceGetAttribute(&cus, hipDeviceAttributeMultiprocessorCount, dev) != hipSuccess) { grid = -1; return; }
        if (hipFuncSetAttribute((const void*)mega, hipFuncAttributeMaxDynamicSharedMemorySize, LDS_BYTES) != hipSuccess) { fprintf(stderr, "kernel_launch: hipFuncSetAttribute failed\n"); grid = -1; return; }
        if (hipOccupancyMaxActiveBlocksPerMultiprocessor(&per_cu, (const void*)mega, 512, LDS_BYTES) != hipSuccess || per_cu < 1) { fprintf(stderr, "kernel_launch: occupancy query failed (%d)\n", per_cu); (void)hipGetLastError(); grid = -1; return; }
        grid = cus * 1;
        fprintf(stderr, "kernel_launch: cus %d per_cu %d grid %d\n", cus, per_cu, grid);
    }
    if (grid < 0) return;
    if (hipMemsetAsync((char*)d_ws + WS_BAR, 0, 16384, stream) != hipSuccess) { fprintf(stderr, "kernel_launch: memset failed\n"); return; }
    Params p{};
    for (int i = 0; i < 24; ++i) p.in[i] = (const float*)d_in[i];
    p.out = (float*)d_out; p.ws = (unsigned char*)d_ws;
    void* args[] = {&p};
    hipError_t e = hipLaunchCooperativeKernel((const void*)mega, dim3(grid), dim3(512), args, LDS_BYTES, stream);
    if (e != hipSuccess) fprintf(stderr, "kernel_launch: cooperative launch failed: %s (grid %d)\n", hipGetErrorString(e), grid);
}
```

```cpp
#include <hip/hip_runtime.h>
#include <hip/hip_cooperative_groups.h>
namespace cg = cooperative_groups;
#include <cstdio>
#include <cstdint>
#include <cmath>

typedef unsigned short bf16_t;
typedef short bf16x8 __attribute__((ext_vector_type(8)));
typedef float f32x4 __attribute__((ext_vector_type(4)));

constexpr int D = 1024, NB = 8, SEQ = 4096, CTX = 256, ML = NB * SEQ  , MC = NB * CTX  , MA = ML + MC  ;
constexpr int NIN = 11264, DFF = 2816;
constexpr int C_QR = 0, C_KR = 1024, C_VR = 2048, C_GR = 4096, C_QD = 6144, C_KD = 7168, C_VD = 8192, C_GATE = 9216;
constexpr float LN_EPS = 1e-5f;
constexpr float ALPHA = 1.189207115002721f;
constexpr float LAM_INIT = 0.2f;

constexpr size_t MiB = 1u << 20;
constexpr size_t WS_MOD = 0;
constexpr size_t WS_TAB = 256 * 1024;
constexpr size_t WS_SCAL = 320 * 1024;
constexpr size_t WS_BAR = 384 * 1024;
constexpr size_t WS_STATS = 512 * 1024;
constexpr size_t WS_RS = 1 * MiB;
constexpr size_t WS_WIN = 2 * MiB;
constexpr size_t WS_WRET = 24 * MiB;
constexpr size_t WS_WDIF = 28 * MiB;
constexpr size_t WS_WO = 30 * MiB;
constexpr size_t WS_WUP = 32 * MiB;
constexpr size_t WS_WDN = 43 * MiB;
constexpr size_t WS_XM = 50 * MiB;
constexpr size_t WS_R = 118 * MiB;
constexpr size_t WS_QR = WS_R;
constexpr size_t WS_KR = WS_R + 64 * MiB;
constexpr size_t WS_VR = WS_R + 132 * MiB;
constexpr size_t WS_SST = WS_R + 272 * MiB;
constexpr size_t WS_QD = WS_R;
constexpr size_t WS_KD = WS_R + 64 * MiB;
constexpr size_t WS_VD = WS_R + 132 * MiB;
constexpr size_t WS_OD = WS_R + 200 * MiB;
constexpr size_t WS_AD = WS_R + 328 * MiB;
constexpr size_t WS_SG = WS_R;
constexpr size_t WS_MR = WS_R + 128 * MiB;
constexpr size_t WS_MB = WS_R + 256 * MiB;
constexpr size_t WS_SIDE = WS_R;
constexpr size_t WS_H = WS_R + 176 * MiB;
constexpr size_t WS_NEED = 512 * MiB;
constexpr int LDS_MISC = 147456 - 64;

__device__ __forceinline__ float bf2f(bf16_t v) { return __uint_as_float(((unsigned)v) << 16); }
__device__ __forceinline__ bf16_t f2bf(float f) { unsigned u = __float_as_uint(f); return (bf16_t)((u + 0x7fffu + ((u >> 16) & 1u)) >> 16); }
__device__ __forceinline__ float siluf(float x) { return x / (1.f + __expf(-x)); }
__device__ __forceinline__ float sigmf(float x) { return 1.f / (1.f + __expf(-x)); }
__device__ __forceinline__ float wave_sum(float v) {
#pragma unroll
    for (int o = 1; o < 64; o <<= 1) v += __shfl_xor(v, o);
    return v;
}

#define LAS __attribute__((address_space(3)))
__device__ __forceinline__ unsigned pk2(float lo, float hi) { return (unsigned)f2bf(lo) | ((unsigned)f2bf(hi) << 16); }
typedef unsigned v4u __attribute__((ext_vector_type(4)));
template <int MAP>
__device__ __forceinline__ void transpose_item(const float* __restrict__ W, int K, int N, bf16_t* __restrict__ WT, float* scr, int item, int lane) {
    const int nblk = N / 32, kb = item / nblk, nb = item % nblk, k0 = 64 * kb, n0 = 32 * nb;
    int s0 = n0;
    if (MAP == 1) { if (n0 >= C_QD && n0 < C_QD + 2048) { const int r = n0 - C_QD, t = r >> 8, p = r & 255, bj = p >> 7, qq = p & 127; s0 = C_QD + t * 256 + 64 * (qq >> 5) + 32 * bj; } }
    if (MAP == 2) { const int t = n0 >> 8, p = n0 & 255; s0 = p < 128 ? 128 * t + p : 2816 + 128 * t + (p - 128); }
#pragma unroll 8
    for (int i = 0; i < 32; ++i) { const int kk = 2 * i + (lane >> 5); scr[kk * 33 + (lane & 31)] = W[(size_t)(k0 + kk) * N + s0 + (lane & 31)]; }
    __builtin_amdgcn_s_waitcnt(0xC07F); __builtin_amdgcn_wave_barrier();
    const int c = lane & 7;
#pragma unroll
    for (int j = 0; j < 4; ++j) { const int n = (lane >> 3) + 8 * j; const float* s = scr + (8 * c) * 33 + n;
        v4u o; o.x = pk2(s[0 * 33], s[1 * 33]); o.y = pk2(s[2 * 33], s[3 * 33]); o.z = pk2(s[4 * 33], s[5 * 33]); o.w = pk2(s[6 * 33], s[7 * 33]);
        *(v4u*)(WT + (size_t)(n0 + n) * K + k0 + 8 * c) = o; }
    __builtin_amdgcn_s_waitcnt(0xC07F); __builtin_amdgcn_wave_barrier();
}


struct Ctx { int tid, lane, wave, bx, G, gw, NGW, gt, NGT, vcu; unsigned char* lds; };

__device__ __forceinline__ void d_mod(const Ctx& C, const float* __restrict__ c, const float* __restrict__ cctx, const float* __restrict__ wmod,
                                      const float* __restrict__ bmod, float* __restrict__ MOD) {
    if (C.bx >= 192) return;
    float* sc = (float*)C.lds;
    float* red = sc + 9 * 1024;
    for (int i = C.tid; i < 9 * 1024; i += 512) { const int r = i >> 10, k = i & 1023; const float v = r < 8 ? c[r * 1024 + k] : cctx[k]; sc[i] = siluf(v); }
    __syncthreads();
    for (int grp = C.bx; grp < 192; grp += C.G) {
        const int col = C.tid & 31, ks = C.tid >> 5, j = grp * 32 + col;
        float acc[9];
#pragma unroll
        for (int r = 0; r < 9; ++r) acc[r] = 0.f;
        for (int k = ks * 64; k < ks * 64 + 64; ++k) { const float w = wmod[(size_t)k * 6144 + j];
#pragma unroll
            for (int r = 0; r < 9; ++r) acc[r] += sc[r * 1024 + k] * w; }
#pragma unroll
        for (int r = 0; r < 9; ++r) red[(ks * 9 + r) * 32 + col] = acc[r];
        __syncthreads();
        if (C.tid < 288) { const int r = C.tid >> 5, cc = C.tid & 31; float a = bmod[grp * 32 + cc];
#pragma unroll
            for (int s = 0; s < 16; ++s) a += red[(s * 9 + r) * 32 + cc];
            MOD[r * 6144 + grp * 32 + cc] = a; }
        __syncthreads();
    }
}

__device__ __forceinline__ void sincos_acc(float ang, float& cs, float& sn) {
    const double TWO_PI = 6.283185307179586476925286766559;
    double a = (double)ang; const double k = rint(a / TWO_PI); double r = a - k * TWO_PI;
    const double r2 = r * r;
    double s = 1.0, c = 1.0;
#pragma unroll
    for (int n = 13; n >= 1; --n) { s = 1.0 - s * r2 / (double)((2 * n) * (2 * n + 1)); c = 1.0 - c * r2 / (double)((2 * n - 1) * (2 * n)); }
    sn = (float)(r * s); cs = (float)c;
}
__device__ __forceinline__ void d_tables(const Ctx& C, const float* __restrict__ logit, const float* __restrict__ dlam, float* __restrict__ TAB, float* __restrict__ SCAL) {
    if (C.bx == C.G - 1) {
        if (C.tid < 64) { float a = dlam[C.tid] * dlam[64 + C.tid], b = dlam[128 + C.tid] * dlam[192 + C.tid];
            a = wave_sum(a); b = wave_sum(b);
            if (C.tid == 0) SCAL[0] = expf(a) - expf(b) + LAM_INIT;
        } else if (C.tid < 72) { const float x = logit[C.tid - 64]; SCAL[1 + C.tid - 64] = fminf(x, 0.f) - log1pf(expf(-fabsf(x))); }
    }
    for (int i = C.gt; i < 64 * 64 + 64 * 16; i += C.NGT) {
        if (i < 4096) { const int p = i >> 6, f = i & 63; const float inv = powf(10000.f, -((float)(2 * f) / 128.f)); float cs, sn; sincos_acc((float)p * inv, cs, sn); TAB[i] = cs; TAB[4096 + i] = sn; }
        else { const int q = i - 4096, p = q >> 4, f = q & 15; const float inv = powf(10000.f, -((float)(2 * f) / 32.f)); float cs, sn; sincos_acc((float)p * inv, cs, sn); TAB[8192 + q] = cs; TAB[8192 + 1024 + q] = sn; }
    }
}

__device__ __forceinline__ void d_lnmod(const Ctx& C, const float* __restrict__ x, const float* __restrict__ ctx, const float* __restrict__ g, const float* __restrict__ bb,
                                        const float* __restrict__ MOD, bf16_t* __restrict__ XM, float* __restrict__ STATS) {
    const int lane = C.lane;
    for (int row = C.gw; row < MA; row += C.NGW) {
        const float* src = row < ML ? x + (size_t)row * D : ctx + (size_t)(row - ML) * D;
        const int mr = row < ML ? row / SEQ : 8;
        const float* sh = MOD + mr * 6144; const float* sc = sh + 1024;
        f32x4 v[4]; float s = 0.f;
#pragma unroll
        for (int j = 0; j < 4; ++j) { v[j] = *(const f32x4*)(src + j * 256 + lane * 4); s += (v[j].x + v[j].y) + (v[j].z + v[j].w); }
        const float mean = wave_sum(s) * (1.f / D); float s2 = 0.f;
#pragma unroll
        for (int j = 0; j < 4; ++j) { v[j] = v[j] - mean; s2 += (v[j].x * v[j].x + v[j].y * v[j].y) + (v[j].z * v[j].z + v[j].w * v[j].w); }
        const float rstd = 1.f / sqrtf(wave_sum(s2) * (1.f / D) + LN_EPS);
        if (row < ML && lane == 0) { STATS[row * 2] = mean; STATS[row * 2 + 1] = rstd; }
#pragma unroll
        for (int j = 0; j < 4; ++j) { const int c0 = j * 256 + lane * 4;
            const f32x4 gg = *(const f32x4*)(g + c0), bv = *(const f32x4*)(bb + c0), s1 = *(const f32x4*)(sc + c0), h1 = *(const f32x4*)(sh + c0);
            const f32x4 xn = v[j] * rstd * gg + bv; const f32x4 o = xn * (s1 + 1.f) + h1;
            ushort4 w; w.x = f2bf(o.x); w.y = f2bf(o.y); w.z = f2bf(o.z); w.w = f2bf(o.w);
            *(ushort4*)(XM + (size_t)row * D + c0) = w; }
    }
}

template <class Epi>
__device__ __forceinline__ void d_gemm(const Ctx& C, const bf16_t* __restrict__ A, int lda, const bf16_t* __restrict__ Bt, int ldb, int M, int N, int K, const Epi& epi) {
    const int fr = C.lane & 15, fq = C.lane >> 4, ntn = N / 256, nt = (M / 128) * ntn;
    for (int t = C.bx; t < nt; t += C.G) {
        const int row0 = (t / ntn) * 128 + (C.wave >> 2) * 64, col0 = (t % ntn) * 256 + (C.wave & 3) * 64;
        f32x4 acc[4][4];
#pragma unroll
        for (int i = 0; i < 4; ++i)
#pragma unroll
            for (int j = 0; j < 4; ++j) acc[i][j] = (f32x4){0.f, 0.f, 0.f, 0.f};
        const bf16_t* Ap = A + (size_t)(row0 + fr) * lda + fq * 8;
        const bf16_t* Bp = Bt + (size_t)(col0 + fr) * ldb + fq * 8;
        for (int k0 = 0; k0 < K; k0 += 32) {
            bf16x8 a[4], b[4];
#pragma unroll
            for (int i = 0; i < 4; ++i) { a[i] = *(const bf16x8*)(Ap + (size_t)i * 16 * lda + k0); b[i] = *(const bf16x8*)(Bp + (size_t)i * 16 * ldb + k0); }
#pragma unroll
            for (int i = 0; i < 4; ++i)
#pragma unroll
                for (int j = 0; j < 4; ++j) acc[i][j] = __builtin_amdgcn_mfma_f32_16x16x32_bf16(a[i], b[j], acc[i][j], 0, 0, 0);
        }
#pragma unroll
        for (int i = 0; i < 4; ++i)
#pragma unroll
            for (int j = 0; j < 4; ++j)
#pragma unroll
                for (int r = 0; r < 4; ++r) epi(row0 + i * 16 + fq * 4 + r, col0 + j * 16 + fr, acc[i][j][r]);
    }
}

struct EpiRetQKV { bf16_t *QR, *KR, *VR;
    __device__ __forceinline__ void operator()(int r, int c, float v) const {
        if (c < 1024) { if (r < ML) QR[(size_t)r * 1024 + c] = f2bf(v); }
        else if (c < 2048) KR[(size_t)r * 1024 + (c - 1024)] = f2bf(v * 0.0625f);
        else VR[(size_t)r * 2048 + (c - 2048)] = f2bf(v); } };
struct EpiDifQKV { bf16_t *QD, *KD, *VD;
    __device__ __forceinline__ void operator()(int r, int c, float v) const {
        if (c < 1024) { if (r < ML) QD[(size_t)r * 1024 + c] = f2bf(v * 0.125f); }
        else if (c < 2048) KD[(size_t)r * 1024 + (c - 1024)] = f2bf(v);
        else VD[(size_t)r * 1024 + (c - 2048)] = f2bf(v); } };
struct EpiGr { bf16_t* YR; const float* RS;
    __device__ __forceinline__ void operator()(int r, int c, float v) const {
        const int h = c >> 9; const float mu = RS[(r * 4 + h) * 2], rs = RS[(r * 4 + h) * 2 + 1];
        const size_t o = (size_t)r * 2048 + c; const float yn = (bf2f(YR[o]) - mu) * rs; YR[o] = f2bf(siluf(v) * yn); } };
struct EpiGate { bf16_t* SG; const float* bg;
    __device__ __forceinline__ void operator()(int r, int c, float v) const { SG[(size_t)r * 2048 + c] = f2bf(sigmf(v + bg[c])); } };
struct EpiMr { float* MR; const bf16_t* SG;
    __device__ __forceinline__ void operator()(int r, int c, float v) const { MR[(size_t)r * 1024 + c] = bf2f(SG[(size_t)r * 2048 + c]) * v; } };
struct EpiMb { bf16_t* MB; const float* MR; const bf16_t* SG;
    __device__ __forceinline__ void operator()(int r, int c, float v) const { MB[(size_t)r * 1024 + c] = f2bf(MR[(size_t)r * 1024 + c] + bf2f(SG[(size_t)r * 2048 + 1024 + c]) * v); } };
struct EpiZ1 { float* Z; const float* x; const float* STATS; const float* g; const float* b; const float* MOD;
    __device__ __forceinline__ void operator()(int r, int c, float v) const {
        const float xn = (x[(size_t)r * 1024 + c] - STATS[r * 2]) * STATS[r * 2 + 1] * g[c] + b[c];
        Z[(size_t)r * 1024 + c] = ALPHA * xn + MOD[(r / SEQ) * 6144 + 2048 + c] * v; } };
struct EpiUG { bf16_t* UG;
    __device__ __forceinline__ void operator()(int r, int c, float v) const { UG[(size_t)r * 5632 + c] = f2bf(v); } };
struct EpiZ2 { float* Z; const float* MOD;
    __device__ __forceinline__ void operator()(int r, int c, float v) const { const size_t o = (size_t)r * 1024 + c; Z[o] = ALPHA * Z[o] + MOD[(r / SEQ) * 6144 + 5120 + c] * v; } };

__device__ __forceinline__ void d_rope_ret(const Ctx& C, bf16_t* __restrict__ X, const float* __restrict__ TAB) {
    for (int idx = C.gt; idx < ML * 512; idx += C.NGT) {
        const int row = idx >> 9, p = idx & 511, h = p >> 7, j = p & 127;
        const int t = row & (SEQ - 1), pr = t >> 6, pc = t & 63;
        const int ti = j < 64 ? pr * 64 + j : pc * 64 + (j - 64);
        const float cs = TAB[ti], sn = TAB[4096 + ti];
        bf16_t* a = X + (size_t)row * 1024 + h * 256 + j;
        const float x1 = bf2f(a[0]), x2 = bf2f(a[128]);
        a[0] = f2bf(x1 * cs - x2 * sn); a[128] = f2bf(x2 * cs + x1 * sn);
    }
}
__device__ __forceinline__ void d_rope_dif(const Ctx& C, bf16_t* __restrict__ X, const float* __restrict__ TAB) {
    for (int idx = C.gt; idx < ML * 512; idx += C.NGT) {
        const int row = idx >> 9, p = idx & 511, blk = p >> 5, j = p & 31;
        const int t = row & (SEQ - 1), pr = t >> 6, pc = t & 63;
        const int ti = j < 16 ? pr * 16 + j : pc * 16 + (j - 16);
        const float cs = TAB[8192 + ti], sn = TAB[8192 + 1024 + ti];
        bf16_t* a = X + (size_t)row * 1024 + blk * 64 + j;
        const float x1 = bf2f(a[0]), x2 = bf2f(a[32]);
        a[0] = f2bf(x1 * cs - x2 * sn); a[32] = f2bf(x2 * cs + x1 * sn);
    }
}

__device__ __forceinline__ void d_ret_naive(const Ctx& C, const bf16_t* __restrict__ QR, const bf16_t* __restrict__ KR, const bf16_t* __restrict__ VR,
                                            bf16_t* __restrict__ YR, float* __restrict__ Sg, const float* __restrict__ SCAL) {
    bf16_t* qs = (bf16_t*)C.lds; bf16_t* ks = qs + 128 * 256; bf16_t* vs = ks + 128 * 256; bf16_t* Ps = qs;
    const int tid = C.tid;
    for (int bid = C.bx; bid < 256; bid += C.G) {
    const int vsl = bid & 7, h = (bid >> 3) & 3, b = bid >> 5;
    float* S = Sg + (size_t)bid * 16384;
    const float lgf = SCAL[1 + h], lgb = SCAL[5 + h];
    const int c = tid & 63, g8 = tid >> 6;
    for (int pass = 0; pass < 2; ++pass) {
        const float lg = pass ? lgb : lgf;
        for (int i = 0; i < 32; ++i) S[(g8 * 32 + i) * 64 + c] = 0.f;
        __syncthreads();
        for (int step = 0; step < 34; ++step) {
            const bool lat = step >= 2;
            int tz = 0; asm volatile("" : "+v"(tz));
            int rowbase;
            if (!lat) { const int cc = pass ? 1 - step : step; rowbase = ML + b * CTX + cc * 128; }
            else { const int n = pass ? 33 - step : step - 2; rowbase = b * SEQ + n * 128; }
            for (int p = tid; p < 128 * 32; p += 512) { const int r = p >> 5, ch = p & 31;
                *(bf16x8*)(ks + r * 256 + ch * 8) = *(const bf16x8*)(KR + (size_t)(rowbase + r) * 1024 + h * 256 + ch * 8);
                if (lat) *(bf16x8*)(qs + r * 256 + ch * 8) = *(const bf16x8*)(QR + (size_t)(rowbase + r) * 1024 + h * 256 + ch * 8); }
            for (int p = tid; p < 128 * 8; p += 512) { const int r = p >> 3, ch = p & 7;
                *(bf16x8*)(vs + r * 64 + ch * 8) = *(const bf16x8*)(VR + (size_t)(rowbase + r) * 2048 + h * 512 + vsl * 64 + ch * 8); }
            __syncthreads();
            if (lat) {
                float yacc[16];
#pragma unroll
                for (int ii = 0; ii < 16; ++ii) { const int i = g8 * 16 + ii + tz; float a = 0.f;
#pragma unroll 2
                    for (int d = 0; d < 256; ++d) a += bf2f(qs[i * 256 + d]) * bf2f(f2bf(S[d * 64 + c]));
                    yacc[ii] = a * __expf(lg * (pass ? (float)(128 - i) : (float)(i + 1))); }
                if (pass == 0) {
                    const int j = (tid & 127) + tz, g4 = tid >> 7; float pv[32];
#pragma unroll
                    for (int ii = 0; ii < 32; ++ii) { const int i = g4 * 32 + ii; float a = 0.f;
#pragma unroll 2
                        for (int d = 0; d < 256; ++d) a += bf2f(qs[i * 256 + d]) * bf2f(ks[j * 256 + d]);
                        const float m = i > j ? __expf(lgf * (float)(i - j)) : (i < j ? __expf(lgb * (float)(j - i)) : 2.f);
                        pv[ii] = a * m; }
                    __syncthreads();
#pragma unroll
                    for (int ii = 0; ii < 32; ++ii) Ps[(g4 * 32 + ii) * 128 + j] = f2bf(pv[ii]);
                    __syncthreads();
#pragma unroll
                    for (int ii = 0; ii < 16; ++ii) { const int i = g8 * 16 + ii; float a = 0.f;
#pragma unroll 2
                        for (int jj = 0; jj < 128; ++jj) a += bf2f(Ps[i * 128 + jj]) * bf2f(vs[jj * 64 + c]);
                        yacc[ii] += a; }
                }
#pragma unroll
                for (int ii = 0; ii < 16; ++ii) { const int i = g8 * 16 + ii; bf16_t* yp = YR + (size_t)(rowbase + i) * 2048 + h * 512 + vsl * 64 + c;
                    if (pass == 0) *yp = f2bf(yacc[ii]); else *yp = f2bf(bf2f(*yp) + yacc[ii]); }
            }
            const float ds = __expf(lg * 128.f);
            float acc[32];
#pragma unroll
            for (int i = 0; i < 32; ++i) acc[i] = 0.f;
#pragma unroll 1
            for (int jj = 0; jj < 128; ++jj) { const float vv = bf2f(f2bf(bf2f(vs[jj * 64 + c]) * __expf(lg * (pass ? (float)(jj + tz) : (float)(127 - jj + tz)))));
#pragma unroll
                for (int i = 0; i < 32; ++i) acc[i] += bf2f(ks[jj * 256 + g8 * 32 + i]) * vv; }
            __syncthreads();
#pragma unroll
            for (int i = 0; i < 32; ++i) { float* sp = S + (g8 * 32 + i) * 64 + c; *sp = *sp * ds + acc[i]; }
            __syncthreads();
        }
    }
    }
}

constexpr int ATTN_NAIVE_LDS = 64 * 64 * 2 + 64 * 128 * 2 + 64 * 65 * 4;
__device__ __forceinline__ void d_attn_naive(const Ctx& C, const bf16_t* __restrict__ QD, const bf16_t* __restrict__ KD, const bf16_t* __restrict__ VD, bf16_t* __restrict__ OD) {
    const int half = C.tid >> 8, tid = C.tid & 255, qi = tid >> 2, part = tid & 3;
    unsigned char* base = C.lds + half * ATTN_NAIVE_LDS;
    bf16_t* Ks = (bf16_t*)base; bf16_t* Vs = Ks + 64 * 64; float* Pm = (float*)(Vs + 64 * 128);
    for (int vb2 = C.bx; vb2 < 4096; vb2 += C.G) {
        const int vb = vb2 * 2 + half;
        const int qb = vb & 63, cc = (vb >> 6) & 1, h = (vb >> 7) & 7, b = vb >> 10;
        const int qrow = b * SEQ + qb * 64 + qi;
        float q[64];
#pragma unroll
        for (int d = 0; d < 64; ++d) q[d] = bf2f(QD[(size_t)qrow * 1024 + h * 128 + cc * 64 + d]);
        float o[32];
#pragma unroll
        for (int e = 0; e < 32; ++e) o[e] = 0.f;
        float m = -1e30f, l = 0.f;
        for (int kt = 0; kt < 68; ++kt) {
            const int krow0 = kt < 64 ? b * SEQ + kt * 64 : ML + b * CTX + (kt - 64) * 64;
            for (int p = tid; p < 64 * 8; p += 256) { const int r = p >> 3, ch = p & 7; *(bf16x8*)(Ks + r * 64 + ch * 8) = *(const bf16x8*)(KD + (size_t)(krow0 + r) * 1024 + h * 128 + cc * 64 + ch * 8); }
            for (int p = tid; p < 64 * 16; p += 256) { const int r = p >> 4, ch = p & 15; *(bf16x8*)(Vs + r * 128 + ch * 8) = *(const bf16x8*)(VD + (size_t)(krow0 + r) * 1024 + h * 128 + ch * 8); }
            __syncthreads();
            float s[16]; float mx = -1e30f;
#pragma unroll
            for (int jj = 0; jj < 16; ++jj) { const int j = part * 16 + jj; float a = 0.f;
#pragma unroll
                for (int d = 0; d < 64; ++d) a += q[d] * bf2f(Ks[j * 64 + d]);
                s[jj] = a; mx = fmaxf(mx, a); }
            mx = fmaxf(mx, __shfl_xor(mx, 1)); mx = fmaxf(mx, __shfl_xor(mx, 2));
            const float mn = fmaxf(m, mx), al = __expf(m - mn); m = mn;
            float ps = 0.f;
#pragma unroll
            for (int jj = 0; jj < 16; ++jj) { const float p = __expf(s[jj] - mn); ps += p; Pm[qi * 65 + part * 16 + jj] = bf2f(f2bf(p)); }
            l = l * al + ps;
#pragma unroll
            for (int e = 0; e < 32; ++e) o[e] *= al;
            __syncthreads();
            for (int j = 0; j < 64; ++j) { const float p = Pm[qi * 65 + j];
#pragma unroll
                for (int e = 0; e < 32; ++e) o[e] += p * bf2f(Vs[j * 128 + part * 32 + e]); }
            __syncthreads();
        }
        l += __shfl_xor(l, 1); l += __shfl_xor(l, 2);
        const float il = 1.f / l;
#pragma unroll
        for (int e = 0; e < 32; ++e) OD[(size_t)qrow * 2048 + h * 256 + cc * 128 + part * 32 + e] = f2bf(o[e] * il);
    }
}

__device__ __forceinline__ void d_prep_diff(const Ctx& C, const bf16_t* __restrict__ OD, const float* __restrict__ gsub, const float* __restrict__ SCAL, bf16_t* __restrict__ AD) {
    const int t = C.tid & 255, h = t >> 5, l = t & 31; const float lam = SCAL[0];
    for (int r2 = C.bx; r2 < ML / 2; r2 += C.G) {
        const int row = r2 * 2 + (C.tid >> 8);
        float a[4]; float ss = 0.f;
#pragma unroll
        for (int i = 0; i < 4; ++i) { const int e = l * 4 + i; a[i] = bf2f(OD[(size_t)row * 2048 + h * 256 + e]) - lam * bf2f(OD[(size_t)row * 2048 + h * 256 + 128 + e]); ss += a[i] * a[i]; }
#pragma unroll
        for (int o = 1; o < 32; o <<= 1) ss += __shfl_xor(ss, o);
        const float rs = 1.f / sqrtf(ss * (1.f / 128.f) + LN_EPS);
#pragma unroll
        for (int i = 0; i < 4; ++i) { const int e = l * 4 + i; AD[(size_t)row * 1024 + h * 128 + e] = f2bf(a[i] * rs * gsub[e] * (1.f - LAM_INIT)); }
    }
}
__device__ __forceinline__ void d_ret_stats(const Ctx& C, const bf16_t* __restrict__ YR, float* __restrict__ RS) {
    for (int it = C.gw; it < ML * 4; it += C.NGW) {
        const int row = it >> 2, h = it & 3;
        float v[8]; float s = 0.f;
#pragma unroll
        for (int i = 0; i < 8; ++i) { v[i] = bf2f(YR[(size_t)row * 2048 + h * 512 + C.lane * 8 + i]); s += v[i]; }
        const float mu = wave_sum(s) * (1.f / 512.f); float s2 = 0.f;
#pragma unroll
        for (int i = 0; i < 8; ++i) { const float d = v[i] - mu; s2 += d * d; }
        const float var = wave_sum(s2) * (1.f / 512.f);
        if (C.lane == 0) { RS[it * 2] = mu; RS[it * 2 + 1] = 1.f / sqrtf(var + LN_EPS); }
    }
}

__device__ __forceinline__ void d_ln_rows(const Ctx& C, float* __restrict__ Z, const float* __restrict__ g, const float* __restrict__ bb, const float* __restrict__ MOD, bf16_t* __restrict__ XM) {
    const int lane = C.lane;
    for (int row = C.gw; row < ML; row += C.NGW) {
        float* src = Z + (size_t)row * D;
        f32x4 v[4]; float s = 0.f;
#pragma unroll
        for (int j = 0; j < 4; ++j) { v[j] = *(const f32x4*)(src + j * 256 + lane * 4); s += (v[j].x + v[j].y) + (v[j].z + v[j].w); }
        const float mean = wave_sum(s) * (1.f / D); float s2 = 0.f;
#pragma unroll
        for (int j = 0; j < 4; ++j) { v[j] = v[j] - mean; s2 += (v[j].x * v[j].x + v[j].y * v[j].y) + (v[j].z * v[j].z + v[j].w * v[j].w); }
        const float rstd = 1.f / sqrtf(wave_sum(s2) * (1.f / D) + LN_EPS);
        const float* sh = MOD + (row / SEQ) * 6144 + 3072; const float* sc = sh + 1024;
#pragma unroll
        for (int j = 0; j < 4; ++j) { const int c0 = j * 256 + lane * 4;
            const f32x4 gg = *(const f32x4*)(g + c0), bv = *(const f32x4*)(bb + c0);
            const f32x4 xn = v[j] * rstd * gg + bv; *(f32x4*)(src + c0) = xn;
            if (XM) { const f32x4 s1 = *(const f32x4*)(sc + c0), h1 = *(const f32x4*)(sh + c0); const f32x4 o = xn * (s1 + 1.f) + h1;
                ushort4 w; w.x = f2bf(o.x); w.y = f2bf(o.y); w.z = f2bf(o.z); w.w = f2bf(o.w); *(ushort4*)(XM + (size_t)row * D + c0) = w; } }
    }
}

__device__ __forceinline__ void d_convgate(const Ctx& C, const bf16_t* __restrict__ UG, int row_off, const float* __restrict__ cw, const float* __restrict__ cb, bf16_t* __restrict__ H) {
    for (int idx = C.gt; idx < (ML / 2) * DFF; idx += C.NGT) {
        const int lr = idx / DFF, f = idx % DFF, row = row_off + lr, t = row & (SEQ - 1);
        const int uc = (f >> 7) * 256 + (f & 127);
        float u = cb[f] + cw[DFF + f] * bf2f(UG[(size_t)lr * 5632 + uc]);
        if (t > 0) u += cw[f] * bf2f(UG[(size_t)(lr - 1) * 5632 + uc]);
        if (t < SEQ - 1) u += cw[2 * DFF + f] * bf2f(UG[(size_t)(lr + 1) * 5632 + uc]);
        const float ge = 0.5f * u * (1.f + erff(u * 0.70710678118654752f));
        H[(size_t)row * DFF + f] = f2bf(ge * bf2f(UG[(size_t)lr * 5632 + uc + 128]));
    }
}

namespace pg8 {
#define PG8_LAS __attribute__((address_space(3)))
typedef unsigned short bf16_t;
typedef short bf16x8 __attribute__((ext_vector_type(8)));
typedef float f32x4 __attribute__((ext_vector_type(4)));
typedef unsigned u32x4 __attribute__((ext_vector_type(4)));
constexpr int BM = 256, BK = 64, HALF = 128, HTB = HALF * BK * 2  , STAGE_BYTES = 8 * HTB, NXCD = 8, WGM = 8;

__host__ __device__ __forceinline__ int lds_byte(int r, int c) { const int st = (r >> 4) * 2 + (c >> 5), rr = r & 15, cc = c & 31, ob = rr * 64 + cc * 2; return st * 1024 + (ob ^ (((ob >> 9) & 1) << 5)); }
__host__ __device__ __forceinline__ void stage_rc(int b, int& R, int& C) { const int st = b / 1024, sb = b % 1024, swz = sb ^ (((sb >> 9) & 1) << 5); R = (st >> 1) * 16 + swz / 64; C = (st & 1) * 32 + (swz % 64) / 2; }
__host__ __device__ __forceinline__ int perm32(int rho) { const int n = rho >> 4, i = rho & 15; return 8 * (i >> 2) + 4 * n + (i & 3); }

struct Unit { int pm, pn; };
struct Gemm { const bf16_t* A; const bf16_t* Bt; int M, N, K; };

struct StaticOrder {
    int nM, nN, nwg, G, c;
    __host__ __device__ void init(int M, int N, int G_, int c_) { nM = M / BM; nN = N / BM; nwg = nM * nN; G = G_; c = c_; }
    __host__ __device__ bool next(int i, Unit& u) const {
        const long L = (long)i * G + c; if (L >= nwg) return false;
        int wgid = (int)L; { const int q = nwg / NXCD, r = nwg % NXCD, xcd = wgid % NXCD, off = wgid / NXCD; wgid = (xcd < r ? xcd * (q + 1) : r * (q + 1) + (xcd - r) * q) + off; }
        const int nig = WGM * nN, gid = wgid / nig, fm = gid * WGM, gsz = (nM - fm) < WGM ? (nM - fm) : WGM;
        u.pm = fm + ((wgid % nig) % gsz); u.pn = (wgid % nig) / gsz; return true;
    }
    __device__ __forceinline__ void a_ready(const Unit&) const {}
    __device__ __forceinline__ void done(const Unit&) const {}
};

template <class Epi, class Sched, bool ALIGN_EPI = false, bool SP2 = false>
__device__ __forceinline__ void gemm_phase(PG8_LAS unsigned char* lds, const Gemm g, const Sched& S, const Epi& E) {
    int tid_ = threadIdx.x; asm volatile("" : "+v"(tid_));
    const int tid = tid_, wid = __builtin_amdgcn_readfirstlane(tid >> 6), lane = tid & 63, wr = wid >> 2, wc = wid & 3, fr = lane & 15, fq = lane >> 4;
    const int K = g.K, nt = K / BK;
    unsigned voffA[2], voffB[2];
#pragma unroll
    for (int i = 0; i < 2; ++i) { int R, C; stage_rc(tid * 16 + i * 8192, R, C); const int Rb = Epi::PERM ? ((R & ~31) + perm32(R & 31)) : R;
        voffA[i] = (unsigned)(R * K + C) * 2u; voffB[i] = (unsigned)(Rb * K + C) * 2u; }
    const size_t kstep = (size_t)(BK * 2);
    const size_t hstep = (size_t)HALF * K * 2;
    const size_t tstep = 2 * hstep;
    const unsigned ldsw = (unsigned)wid * 1024u;
    const int aoff = lds_byte(wr * 64 + fr, fq * 8), boff = lds_byte(wc * 32 + fr, fq * 8);
#define PG8_SA(b, h) (((b) * 2 + (h)) * HTB)
#define PG8_SB(b, h) ((4 + (b) * 2 + (h)) * HTB)
#define PG8_STAGE(bufoff, gbase, voff) do { _Pragma("unroll") for (int _i = 0; _i < 2; ++_i) \
        __builtin_amdgcn_global_load_lds((const unsigned*)((const char*)(gbase) + (voff)[_i]), (PG8_LAS unsigned*)(lds + (bufoff) + ldsw + _i * 8192), 16, 0, 0); } while (0)
#define PG8_LDA(dst, b, h) do { _Pragma("unroll") for (int m = 0; m < 4; ++m) _Pragma("unroll") for (int k = 0; k < 2; ++k) dst[m][k] = *(const PG8_LAS bf16x8*)(lds + PG8_SA(b, h) + aoff + m * 2048 + k * 1024); } while (0)
#define PG8_LDB(dst, b, h) do { _Pragma("unroll") for (int n = 0; n < 2; ++n) _Pragma("unroll") for (int k = 0; k < 2; ++k) dst[n][k] = *(const PG8_LAS bf16x8*)(lds + PG8_SB(b, h) + boff + n * 2048 + k * 1024); } while (0)
#define PG8_MMA(ai, bj, At, Bt) do { __builtin_amdgcn_s_setprio(1); _Pragma("unroll") for (int m = 0; m < 4; ++m) _Pragma("unroll") for (int n = 0; n < 2; ++n) _Pragma("unroll") for (int k = 0; k < 2; ++k) \
        acc[ai][bj][m][n] = __builtin_amdgcn_mfma_f32_16x16x32_bf16(Bt[n][k], At[m][k], acc[ai][bj][m][n], 0, 0, 0); __builtin_amdgcn_s_setprio(0); } while (0)
#define PG8_WAIT_V(n) asm volatile("s_waitcnt vmcnt(" #n ")" ::: "memory")
#define PG8_WAIT_L(n) asm volatile("s_waitcnt lgkmcnt(" #n ")" ::: "memory")
#define PG8_BAR __builtin_amdgcn_s_barrier()
#define PG8_SCHED __builtin_amdgcn_sched_barrier(0)
    Unit cur, nxt; int ui = 0;
    if (!S.next(0, cur)) return;
    f32x4 acc[2][2][4][2];
#pragma unroll
    for (int a = 0; a < 2; ++a)
#pragma unroll
        for (int b = 0; b < 2; ++b)
#pragma unroll
            for (int m = 0; m < 4; ++m)
#pragma unroll
                for (int n = 0; n < 2; ++n) acc[a][b][m][n] = (f32x4){0.f, 0.f, 0.f, 0.f};
    bf16x8 At[4][2], B0[2][2], B1[2][2];
    const char* cA = (const char*)g.A + (size_t)cur.pm * tstep; const char* cB = (const char*)g.Bt + (size_t)cur.pn * tstep;
    S.a_ready(cur);
    if constexpr (SP2) {
        PG8_STAGE(PG8_SB(0, 0), cB, voffB); PG8_STAGE(PG8_SB(0, 1), cB + hstep, voffB); PG8_STAGE(PG8_SA(0, 0), cA, voffA); PG8_STAGE(PG8_SA(0, 1), cA + hstep, voffA);
        if (wr == 1) PG8_BAR;
        PG8_WAIT_V(2); PG8_BAR;
        PG8_STAGE(PG8_SB(1, 0), cB + kstep, voffB); PG8_STAGE(PG8_SA(1, 0), cA + kstep, voffA); PG8_STAGE(PG8_SB(1, 1), cB + hstep + kstep, voffB);
        PG8_WAIT_V(6); PG8_BAR;
    } else {
        PG8_STAGE(PG8_SB(0, 0), cB, voffB); PG8_STAGE(PG8_SA(0, 0), cA, voffA); PG8_STAGE(PG8_SB(0, 1), cB + hstep, voffB); PG8_STAGE(PG8_SA(0, 1), cA + hstep, voffA);
        if (wr == 1) PG8_BAR;
        PG8_WAIT_V(4); PG8_BAR;
        PG8_STAGE(PG8_SB(1, 0), cB + kstep, voffB); PG8_STAGE(PG8_SA(1, 0), cA + kstep, voffA); PG8_STAGE(PG8_SB(1, 1), cB + hstep + kstep, voffB);
        PG8_WAIT_V(6); PG8_BAR;
    }
    for (;;) {
        const bool has_next = S.next(ui + 1, nxt);
        const char* nA = has_next ? (const char*)g.A + (size_t)nxt.pm * tstep : cA; const char* nB = has_next ? (const char*)g.Bt + (size_t)nxt.pn * tstep : cB;
        for (int t = 0; t < nt; t += 2) {
            const bool last = (t == nt - 2);
            const char* a1 = cA + (size_t)(t + 1) * kstep;
            const char* a2 = last ? nA : cA + (size_t)(t + 2) * kstep; const char* b2 = last ? nB : cB + (size_t)(t + 2) * kstep;
            const char* a3 = a2 + kstep; const char* b3 = b2 + kstep;
            if (last && has_next) S.a_ready(nxt);
            if constexpr (SP2) {
            PG8_LDB(B0, 0, 0); PG8_LDB(B1, 0, 1); PG8_SCHED; PG8_LDA(At, 0, 0); PG8_STAGE(PG8_SA(1, 1), a1 + hstep, voffA);
            PG8_WAIT_V(8); PG8_WAIT_L(0); PG8_BAR; PG8_MMA(0, 0, At, B0); PG8_MMA(0, 1, At, B1); PG8_BAR; PG8_SCHED;
            PG8_LDA(At, 0, 1); PG8_STAGE(PG8_SB(0, 0), b2, voffB); PG8_STAGE(PG8_SB(0, 1), b2 + hstep, voffB); PG8_STAGE(PG8_SA(0, 0), a2, voffA);
            PG8_WAIT_V(8); PG8_WAIT_L(0); PG8_BAR; PG8_MMA(1, 0, At, B0); PG8_MMA(1, 1, At, B1); PG8_BAR; PG8_SCHED;
            PG8_LDB(B0, 1, 0); PG8_LDB(B1, 1, 1); PG8_SCHED; PG8_LDA(At, 1, 0); PG8_STAGE(PG8_SA(0, 1), a2 + hstep, voffA);
            PG8_WAIT_V(8); PG8_WAIT_L(0); PG8_BAR; PG8_MMA(0, 0, At, B0); PG8_MMA(0, 1, At, B1); PG8_BAR; PG8_SCHED;
            PG8_LDA(At, 1, 1); PG8_STAGE(PG8_SB(1, 0), b3, voffB); PG8_STAGE(PG8_SB(1, 1), b3 + hstep, voffB); PG8_STAGE(PG8_SA(1, 0), a3, voffA);
            PG8_WAIT_V(8); PG8_WAIT_L(0); PG8_BAR; PG8_MMA(1, 0, At, B0); PG8_MMA(1, 1, At, B1); PG8_BAR; PG8_SCHED;
            } else {
            PG8_LDB(B0, 0, 0); PG8_SCHED; PG8_LDA(At, 0, 0); PG8_STAGE(PG8_SA(1, 1), a1 + hstep, voffA);
            PG8_WAIT_L(8); PG8_BAR; PG8_WAIT_L(0); PG8_MMA(0, 0, At, B0); PG8_BAR; PG8_SCHED;
            PG8_LDB(B1, 0, 1); PG8_STAGE(PG8_SB(0, 0), b2, voffB);
            PG8_BAR; PG8_WAIT_L(0); PG8_MMA(0, 1, At, B1); PG8_BAR;
            PG8_LDA(At, 0, 1); PG8_STAGE(PG8_SA(0, 0), a2, voffA);
            PG8_BAR; PG8_WAIT_L(0); PG8_MMA(1, 0, At, B0); PG8_BAR; PG8_SCHED;
            PG8_STAGE(PG8_SB(0, 1), b2 + hstep, voffB);
            PG8_WAIT_V(6); PG8_BAR; PG8_MMA(1, 1, At, B1); PG8_BAR;
            PG8_LDB(B0, 1, 0); PG8_SCHED; PG8_LDA(At, 1, 0); PG8_STAGE(PG8_SA(0, 1), a2 + hstep, voffA);
            PG8_WAIT_L(8); PG8_BAR; PG8_WAIT_L(0); PG8_MMA(0, 0, At, B0); PG8_BAR; PG8_SCHED;
            PG8_LDB(B1, 1, 1); PG8_STAGE(PG8_SB(1, 0), b3, voffB);
            PG8_BAR; PG8_WAIT_L(0); PG8_MMA(0, 1, At, B1); PG8_BAR;
            PG8_LDA(At, 1, 1); PG8_STAGE(PG8_SA(1, 0), a3, voffA);
            PG8_BAR; PG8_WAIT_L(0); PG8_MMA(1, 0, At, B0); PG8_BAR; PG8_SCHED;
            PG8_STAGE(PG8_SB(1, 1), b3 + hstep, voffB);
            PG8_WAIT_V(6); PG8_BAR; PG8_MMA(1, 1, At, B1); PG8_BAR;
            }
        }
        if constexpr (ALIGN_EPI) { if (wr == 0) PG8_BAR; }
        if constexpr (!Epi::AFTER_DRAIN) { E(acc, cur, wr, wc, fr, fq); S.done(cur); }
        if (!has_next) break;
#pragma unroll
        for (int a = 0; a < 2; ++a)
#pragma unroll
            for (int b = 0; b < 2; ++b)
#pragma unroll
                for (int m = 0; m < 4; ++m)
#pragma unroll
                    for (int n = 0; n < 2; ++n) acc[a][b][m][n] = (f32x4){0.f, 0.f, 0.f, 0.f};
        cur = nxt; cA = nA; cB = nB; ++ui;
        if constexpr (ALIGN_EPI) { if (wr == 1) PG8_BAR; }
    }
    PG8_WAIT_V(0);
    if constexpr (!ALIGN_EPI) { if (wr == 0) PG8_BAR; }
    PG8_BAR;
    if constexpr (Epi::AFTER_DRAIN) { E.fused(acc, cur, wr, wc, fr, fq, lds, wid, lane); S.done(cur); }
#undef PG8_SA
#undef PG8_SB
#undef PG8_STAGE
#undef PG8_LDA
#undef PG8_LDB
#undef PG8_MMA
#undef PG8_WAIT_V
#undef PG8_WAIT_L
#undef PG8_BAR
#undef PG8_SCHED
}
}


__device__ __forceinline__ float gelu1(float v) {
    const float av = fabsf(v), t = __builtin_amdgcn_rcpf(av * 0.2316418882f + 1.0f);
    float q = t * 0.5307027145f + (-0.7265760135f); q = q * t + 0.7107068705f; q = q * t + (-0.142248368f); q = q * t + 0.127414796f; q = q * t;
    const float e = __builtin_amdgcn_exp2f((v * v) * (-0.72134752044f)), m = v * (q * e);
    return v < 0.f ? m : v - m; }
__device__ __forceinline__ f32x4 gelu4(const f32x4& u) { f32x4 r;
#pragma unroll
    for (int i = 0; i < 4; ++i) r[i] = gelu1(u[i]);
    return r; }
typedef unsigned u32x4 __attribute__((ext_vector_type(4)));
typedef float f32x2_t __attribute__((ext_vector_type(2))); typedef __bf16 bf16x2_t __attribute__((ext_vector_type(2)));
__device__ __forceinline__ unsigned cvtpk(float lo, float hi) { f32x2_t v = {lo, hi}; bf16x2_t b = __builtin_convertvector(v, bf16x2_t); return __builtin_bit_cast(unsigned, b); }
__device__ __forceinline__ u32x4 pack8(const f32x4& a, const f32x4& b) { u32x4 w; w.x = cvtpk(a[0], a[1]); w.y = cvtpk(a[2], a[3]); w.z = cvtpk(b[0], b[1]); w.w = cvtpk(b[2], b[3]); return w; }
__device__ __forceinline__ void unpack8(const u32x4& w, f32x4& a, f32x4& b) {
    a[0] = __uint_as_float(w.x << 16); a[1] = __uint_as_float(w.x & 0xffff0000u); a[2] = __uint_as_float(w.y << 16); a[3] = __uint_as_float(w.y & 0xffff0000u);
    b[0] = __uint_as_float(w.z << 16); b[1] = __uint_as_float(w.z & 0xffff0000u); b[2] = __uint_as_float(w.w << 16); b[3] = __uint_as_float(w.w & 0xffff0000u); }
typedef const f32x4 (&AccT)[2][2][4][2];
#define EPI_ROWS for (int ai = 0; ai < 2; ++ai) _Pragma("unroll") for (int m = 0; m < 4; ++m)

struct FEpiRetQKV { static constexpr bool PERM = true, AFTER_DRAIN = false; bf16_t *QR, *KR, *VR; const float* TAB;
    __device__ __forceinline__ void operator()(AccT acc, const pg8::Unit& u, int wr, int wc, int fr, int fq) const {
        const int row0 = u.pm * 256 + wr * 64 + fr, j0 = wc * 32 + 8 * fq;
        if (u.pn < 8) {
            const bool isq = u.pn < 4; const int h = u.pn & 3;
            if (isq && u.pm >= ML / 256) return;
            bf16_t* dst = (isq ? QR : KR) + h * 256 + j0; const float sc = isq ? 1.f : 0.0625f;
            const bool lat = u.pm < ML / 256, byrow = j0 < 64;
#define ROPE_ROW(ai, m) do { const int row = row0 + (ai) * 128 + (m) * 16; \
                const f32x4 x1a = acc[ai][0][m][0], x1b = acc[ai][0][m][1], x2a = acc[ai][1][m][0], x2b = acc[ai][1][m][1]; \
                const f32x4 o1a = (x1a * c0 - x2a * s0) * sc, o1b = (x1b * c1 - x2b * s1) * sc, o2a = (x2a * c0 + x1a * s0) * sc, o2b = (x2b * c1 + x1b * s1) * sc; \
                bf16_t* rp = dst + (size_t)row * 1024; *(u32x4*)rp = pack8(o1a, o1b); *(u32x4*)(rp + PAIRD) = pack8(o2a, o2b); } while (0)
#define ROPE_TAB(t_) f32x4 c0 = {1.f, 1.f, 1.f, 1.f}, c1 = c0, s0 = {0.f, 0.f, 0.f, 0.f}, s1 = s0; \
                if (lat) { const int t = (t_) & (SEQ - 1), p = byrow ? (t >> 6) : (t & 63); const float* tp = TBASE + p * TSTR + TOFF; \
                    c0 = *(const f32x4*)tp; c1 = *(const f32x4*)(tp + 4); s0 = *(const f32x4*)(tp + TSIN); s1 = *(const f32x4*)(tp + TSIN + 4); }
#define PAIRD 128
#define TBASE TAB
#define TSTR 64
#define TOFF (j0 & 63)
#define TSIN 4096
            if (byrow) {
#pragma unroll
                for (int ai = 0; ai < 2; ++ai) { ROPE_TAB(row0 + ai * 128)
#pragma unroll
                    for (int m = 0; m < 4; ++m) ROPE_ROW(ai, m); }
            } else {
#pragma unroll
                for (int m = 0; m < 4; ++m) { ROPE_TAB(row0 + m * 16)
#pragma unroll
                    for (int ai = 0; ai < 2; ++ai) ROPE_ROW(ai, m); }
            }
#undef PAIRD
#undef TBASE
#undef TSTR
#undef TOFF
#undef TSIN
        } else {
            bf16_t* dst = VR + (u.pn - 8) * 256 + j0;
#pragma unroll
            EPI_ROWS { bf16_t* rp = dst + (size_t)(row0 + ai * 128 + m * 16) * 2048; *(u32x4*)rp = pack8(acc[ai][0][m][0], acc[ai][0][m][1]); *(u32x4*)(rp + 128) = pack8(acc[ai][1][m][0], acc[ai][1][m][1]); }
        }
    } };
constexpr float QSCALE = 0.125f;
struct FEpiDifQKV { static constexpr bool PERM = true, AFTER_DRAIN = false; bf16_t *QD, *KD, *VD; const float* TAB;
    __device__ __forceinline__ void operator()(AccT acc, const pg8::Unit& u, int wr, int wc, int fr, int fq) const {
        const int row0 = u.pm * 256 + wr * 64 + fr, j0 = wc * 32 + 8 * fq;
        if (u.pn < 8) {
            const bool isq = u.pn < 4; const int tl = u.pn & 3;
            if (isq && u.pm >= ML / 256) return;
            const int dd0 = 8 * fq;
            bf16_t* dst = (isq ? QD : KD) + tl * 256 + wc * 64 + dd0; const float sc = isq ? QSCALE : 1.f;
            const bool lat = u.pm < ML / 256, byrow = dd0 < 16;
#define PAIRD 32
#define TBASE (TAB + 8192)
#define TSTR 16
#define TOFF (dd0 & 15)
#define TSIN 1024
            if (byrow) {
#pragma unroll
                for (int ai = 0; ai < 2; ++ai) { ROPE_TAB(row0 + ai * 128)
#pragma unroll
                    for (int m = 0; m < 4; ++m) ROPE_ROW(ai, m); }
            } else {
#pragma unroll
                for (int m = 0; m < 4; ++m) { ROPE_TAB(row0 + m * 16)
#pragma unroll
                    for (int ai = 0; ai < 2; ++ai) ROPE_ROW(ai, m); }
            }
#undef PAIRD
#undef TBASE
#undef TSTR
#undef TOFF
#undef TSIN
        } else {
            bf16_t* dst = VD + (u.pn - 8) * 256 + j0;
#pragma unroll
            EPI_ROWS { bf16_t* rp = dst + (size_t)(row0 + ai * 128 + m * 16) * 1024; *(u32x4*)rp = pack8(acc[ai][0][m][0], acc[ai][0][m][1]); *(u32x4*)(rp + 128) = pack8(acc[ai][1][m][0], acc[ai][1][m][1]); }
        }
    } };
__device__ __forceinline__ f32x4 silu4(const f32x4& v) { f32x4 r; r[0] = siluf(v[0]); r[1] = siluf(v[1]); r[2] = siluf(v[2]); r[3] = siluf(v[3]); return r; }
__device__ __forceinline__ f32x4 sigm4(const f32x4& v) { f32x4 r; r[0] = sigmf(v[0]); r[1] = sigmf(v[1]); r[2] = sigmf(v[2]); r[3] = sigmf(v[3]); return r; }
struct FEpiGr { static constexpr bool PERM = true, AFTER_DRAIN = false; bf16_t* YR; const float* RS;
    __device__ __forceinline__ void operator()(AccT acc, const pg8::Unit& u, int wr, int wc, int fr, int fq) const {
        const int row0 = u.pm * 256 + wr * 64 + fr, j0 = wc * 32 + 8 * fq, h = u.pn >> 1;
#pragma unroll
        EPI_ROWS { const int row = row0 + ai * 128 + m * 16; const float mu = RS[(row * 4 + h) * 2], rs = RS[(row * 4 + h) * 2 + 1];
            bf16_t* rp = YR + (size_t)row * 2048 + u.pn * 256 + j0;
#pragma unroll
            for (int bj = 0; bj < 2; ++bj) { f32x4 ya, yb; unpack8(*(const u32x4*)(rp + bj * 128), ya, yb);
                *(u32x4*)(rp + bj * 128) = pack8(silu4(acc[ai][bj][m][0]) * ((ya - mu) * rs), silu4(acc[ai][bj][m][1]) * ((yb - mu) * rs)); } }
    } };
struct FEpiGate { static constexpr bool PERM = true, AFTER_DRAIN = false; bf16_t* SG; const float* bg;
    __device__ __forceinline__ void operator()(AccT acc, const pg8::Unit& u, int wr, int wc, int fr, int fq) const {
        const int row0 = u.pm * 256 + wr * 64 + fr, c0 = u.pn * 256 + wc * 32 + 8 * fq;
        f32x4 bv[2][2];
#pragma unroll
        for (int bj = 0; bj < 2; ++bj) { bv[bj][0] = *(const f32x4*)(bg + c0 + bj * 128); bv[bj][1] = *(const f32x4*)(bg + c0 + bj * 128 + 4); }
#pragma unroll
        EPI_ROWS { bf16_t* rp = SG + (size_t)(row0 + ai * 128 + m * 16) * 2048 + c0;
#pragma unroll
            for (int bj = 0; bj < 2; ++bj) *(u32x4*)(rp + bj * 128) = pack8(sigm4(acc[ai][bj][m][0] + bv[bj][0]), sigm4(acc[ai][bj][m][1] + bv[bj][1])); }
    } };
struct FEpiMr { static constexpr bool PERM = true, AFTER_DRAIN = false; float* MR; const bf16_t* SG;
    __device__ __forceinline__ void operator()(AccT acc, const pg8::Unit& u, int wr, int wc, int fr, int fq) const {
        const int row0 = u.pm * 256 + wr * 64 + fr, c0 = u.pn * 256 + wc * 32 + 8 * fq;
#pragma unroll
        EPI_ROWS { const int row = row0 + ai * 128 + m * 16;
#pragma unroll
            for (int bj = 0; bj < 2; ++bj) { f32x4 ga, gb; unpack8(*(const u32x4*)(SG + (size_t)row * 2048 + c0 + bj * 128), ga, gb);
                float* op = MR + (size_t)row * 1024 + c0 + bj * 128; *(f32x4*)op = ga * acc[ai][bj][m][0]; *(f32x4*)(op + 4) = gb * acc[ai][bj][m][1]; } }
    } };
struct FEpiMb { static constexpr bool PERM = true, AFTER_DRAIN = false; bf16_t* MB; const float* MR; const bf16_t* SG;
    __device__ __forceinline__ void operator()(AccT acc, const pg8::Unit& u, int wr, int wc, int fr, int fq) const {
        const int row0 = u.pm * 256 + wr * 64 + fr, c0 = u.pn * 256 + wc * 32 + 8 * fq;
#pragma unroll
        EPI_ROWS { const int row = row0 + ai * 128 + m * 16;
#pragma unroll
            for (int bj = 0; bj < 2; ++bj) { f32x4 ga, gb; unpack8(*(const u32x4*)(SG + (size_t)row * 2048 + 1024 + c0 + bj * 128), ga, gb);
                const float* ip = MR + (size_t)row * 1024 + c0 + bj * 128;
                *(u32x4*)(MB + (size_t)row * 1024 + c0 + bj * 128) = pack8(*(const f32x4*)ip + ga * acc[ai][bj][m][0], *(const f32x4*)(ip + 4) + gb * acc[ai][bj][m][1]); } }
    } };
struct FEpiZ1 { static constexpr bool PERM = true, AFTER_DRAIN = false; float* Z; const float* x; const float* STATS; const float* g; const float* b; const float* MOD;
    __device__ __forceinline__ void operator()(AccT acc, const pg8::Unit& u, int wr, int wc, int fr, int fq) const {
        const int row0 = u.pm * 256 + wr * 64 + fr, c0 = u.pn * 256 + wc * 32 + 8 * fq;
        const float* g1 = MOD + (u.pm / (SEQ / 256)) * 6144 + 2048;
#pragma unroll
        for (int bj = 0; bj < 2; ++bj)
#pragma unroll
            for (int n = 0; n < 2; ++n) { const int c = c0 + bj * 128 + n * 4; const f32x4 gg = *(const f32x4*)(g + c), bb = *(const f32x4*)(b + c), gm = *(const f32x4*)(g1 + c);
#pragma unroll
                EPI_ROWS { const int row = row0 + ai * 128 + m * 16; const float mu = STATS[row * 2], rs = STATS[row * 2 + 1];
                    const f32x4 xv = *(const f32x4*)(x + (size_t)row * 1024 + c); const f32x4 xn = (xv - mu) * rs * gg + bb;
                    *(f32x4*)(Z + (size_t)row * 1024 + c) = xn * ALPHA + gm * acc[ai][bj][m][n]; } }
    } };
struct FEpiUG { static constexpr bool PERM = true, AFTER_DRAIN = false; bf16_t* U; bf16_t* G;
    __device__ __forceinline__ void operator()(AccT acc, const pg8::Unit& u, int wr, int wc, int fr, int fq) const {
        const int row0 = u.pm * 256 + wr * 64 + fr, c0 = u.pn * 128 + wc * 32 + 8 * fq;
#pragma unroll
        EPI_ROWS { const size_t o = (size_t)(row0 + ai * 128 + m * 16) * DFF + c0; *(u32x4*)(U + o) = pack8(acc[ai][0][m][0], acc[ai][0][m][1]); *(u32x4*)(G + o) = pack8(acc[ai][1][m][0], acc[ai][1][m][1]); }
    } };
template <int CTRL> __device__ __forceinline__ float dpp_mov(float oldv, float srcv) {
    return __int_as_float(__builtin_amdgcn_update_dpp(__float_as_int(oldv), __float_as_int(srcv), CTRL, 0xF, 0xF, false)); }
constexpr int DPP_SHL1 = 0x101, DPP_SHR1 = 0x111, DPP_ROR1 = 0x121, DPP_ROR15 = 0x12F;
constexpr int LDS_XCH = 131072;
struct FEpiUGC { static constexpr bool PERM = true, AFTER_DRAIN = false; bf16_t* H; bf16_t* SIDE; const float* cw; const float* cb; unsigned char* lds;
    __device__ __forceinline__ void operator()(AccT acc, const pg8::Unit& u, int wr, int wc, int fr, int fq) const {
        LAS float* X = (LAS float*)((LAS unsigned char*)lds + LDS_XCH);
        const int w8 = wr * 4 + wc;
#pragma unroll
        for (int ai = 0; ai < 2; ++ai)
#pragma unroll
            for (int n = 0; n < 2; ++n) {
                if (fr == 0) *(LAS f32x4*)(X + ((w8 * 2 + ai) * 2 + 0) * 32 + 8 * fq + 4 * n) = acc[ai][0][0][n];
                if (fr == 15) *(LAS f32x4*)(X + ((w8 * 2 + ai) * 2 + 1) * 32 + 8 * fq + 4 * n) = acc[ai][0][3][n]; }
        asm volatile("s_waitcnt lgkmcnt(0)\n\ts_barrier" ::: "memory");
        const int f = u.pn * 128 + wc * 32 + 8 * fq, row0 = u.pm * 256 + wr * 64 + fr, ws8 = (wr ^ 1) * 4 + wc;
        f32x4 w0[2], w1[2], w2[2], bb[2];
#pragma unroll
        for (int n = 0; n < 2; ++n) { w0[n] = *(const f32x4*)(cw + f + 4 * n); w1[n] = *(const f32x4*)(cw + DFF + f + 4 * n); w2[n] = *(const f32x4*)(cw + 2 * DFF + f + 4 * n); bb[n] = *(const f32x4*)(cb + f + 4 * n); }
#pragma unroll
        for (int ai = 0; ai < 2; ++ai) {
            const int aiu = wr ? ai : ai - 1, aid = wr ? ai + 1 : ai;
            f32x4 eu[2], ed[2];
#pragma unroll
            for (int n = 0; n < 2; ++n) { eu[n] = (f32x4){0.f, 0.f, 0.f, 0.f}; ed[n] = eu[n];
                if (aiu >= 0) eu[n] = *(const LAS f32x4*)(X + ((ws8 * 2 + aiu) * 2 + 1) * 32 + 8 * fq + 4 * n);
                if (aid <= 1) ed[n] = *(const LAS f32x4*)(X + ((ws8 * 2 + aid) * 2 + 0) * 32 + 8 * fq + 4 * n); }
#pragma unroll
            for (int m = 0; m < 4; ++m) {
                const int r = ai * 128 + wr * 64 + m * 16 + fr;
                f32x4 hv[2];
#pragma unroll
                for (int n = 0; n < 2; ++n) {
                    const f32x4 cur = acc[ai][0][m][n]; f32x4 up, dn;
#pragma unroll
                    for (int e = 0; e < 4; ++e) {
                        const float ou = (m > 0) ? dpp_mov<DPP_ROR1>(0.f, acc[ai][0][m > 0 ? m - 1 : 0][n][e]) : eu[n][e];
                        up[e] = dpp_mov<DPP_SHR1>(ou, cur[e]);
                        const float od = (m < 3) ? dpp_mov<DPP_ROR15>(0.f, acc[ai][0][m < 3 ? m + 1 : 3][n][e]) : ed[n][e];
                        dn[e] = dpp_mov<DPP_SHL1>(od, cur[e]); }
                    const f32x4 uc = bb[n] + w0[n] * up + w1[n] * cur + w2[n] * dn;
                    hv[n] = gelu4(uc) * acc[ai][1][m][n]; }
                if (r != 0 && r != 255) *(u32x4*)(H + (size_t)(row0 + ai * 128 + m * 16) * DFF + f) = pack8(hv[0], hv[1]);
                if ((ai == 0 && m == 0 && wr == 0 && fr < 2) || (ai == 1 && m == 3 && wr == 1 && fr >= 14)) {
                    const int k = (r < 2) ? r : r - 252;
                    *(u32x4*)(SIDE + ((size_t)u.pm * 6 + k) * DFF + f) = pack8(acc[ai][0][m][0], acc[ai][0][m][1]);
                    if (r == 0 || r == 255) *(u32x4*)(SIDE + ((size_t)u.pm * 6 + (r == 0 ? 4 : 5)) * DFF + f) = pack8(acc[ai][1][m][0], acc[ai][1][m][1]); }
            }
        }
    } };
__device__ __forceinline__ void d_conv_fix(const Ctx& C, const bf16_t* __restrict__ SIDE, const float* __restrict__ cw, const float* __restrict__ cb, bf16_t* __restrict__ H) {
    constexpr int NFG = DFF / 8;
    for (int it = C.gt; it < (ML / 256) * 2 * NFG; it += C.NGT) {
        const int fg = it % NFG, pe = it / NFG, pm = pe >> 1, edge = pe & 1, f = fg * 8, row = pm * 256 + (edge ? 255 : 0), t = row & (SEQ - 1);
        f32x4 ua = {0.f, 0.f, 0.f, 0.f}, ub = ua, ca, cb2, da = ua, db = ua, ga, gb;
        const bf16_t* S0 = SIDE + (size_t)pm * 6 * DFF + f;
        if (!edge) { if (t != 0) unpack8(*(const u32x4*)(S0 - 6 * DFF + 3 * DFF), ua, ub); unpack8(*(const u32x4*)(S0), ca, cb2); unpack8(*(const u32x4*)(S0 + DFF), da, db); unpack8(*(const u32x4*)(S0 + 4 * DFF), ga, gb); }
        else { unpack8(*(const u32x4*)(S0 + 2 * DFF), ua, ub); unpack8(*(const u32x4*)(S0 + 3 * DFF), ca, cb2); if (t != SEQ - 1) unpack8(*(const u32x4*)(S0 + 6 * DFF), da, db); unpack8(*(const u32x4*)(S0 + 5 * DFF), ga, gb); }
        const f32x4 w0a = *(const f32x4*)(cw + f), w0b = *(const f32x4*)(cw + f + 4), w1a = *(const f32x4*)(cw + DFF + f), w1b = *(const f32x4*)(cw + DFF + f + 4);
        const f32x4 w2a = *(const f32x4*)(cw + 2 * DFF + f), w2b = *(const f32x4*)(cw + 2 * DFF + f + 4), ba = *(const f32x4*)(cb + f), bb = *(const f32x4*)(cb + f + 4);
        const f32x4 x0 = ba + w0a * ua + w1a * ca + w2a * da, x1 = bb + w0b * ub + w1b * cb2 + w2b * db;
        *(u32x4*)(H + (size_t)row * DFF + f) = pack8(gelu4(x0) * ga, gelu4(x1) * gb);
    }
}
struct FEpiZ2 { static constexpr bool PERM = true, AFTER_DRAIN = false; float* Z; const float* MOD;
    __device__ __forceinline__ void operator()(AccT acc, const pg8::Unit& u, int wr, int wc, int fr, int fq) const {
        const int row0 = u.pm * 256 + wr * 64 + fr, c0 = u.pn * 256 + wc * 32 + 8 * fq;
        const float* g2 = MOD + (u.pm / (SEQ / 256)) * 6144 + 5120;
#pragma unroll
        for (int bj = 0; bj < 2; ++bj)
#pragma unroll
            for (int n = 0; n < 2; ++n) { const int c = c0 + bj * 128 + n * 4; const f32x4 gm = *(const f32x4*)(g2 + c);
#pragma unroll
                EPI_ROWS { float* zp = Z + (size_t)(row0 + ai * 128 + m * 16) * 1024 + c; *(f32x4*)zp = *(const f32x4*)zp * ALPHA + gm * acc[ai][bj][m][n]; } }
    } };
template <class Epi> __device__ __forceinline__ void fast_gemm(unsigned char* lds, const bf16_t* A, const bf16_t* Bt, int M, int N, int K, const Epi& E) {
    pg8::Gemm g{A, Bt, M, N, K}; pg8::StaticOrder S; S.init(M, N, (int)gridDim.x, (int)((volatile LAS unsigned*)((LAS unsigned char*)lds + LDS_MISC))[7]);
    pg8::gemm_phase<Epi, pg8::StaticOrder, true, true>((PG8_LAS unsigned char*)lds, g, S, E);
    __syncthreads();
}

namespace fa {
using bf16x8 = __attribute__((ext_vector_type(8))) short;
using s16x4  = __attribute__((ext_vector_type(4))) short;
using f32x16 = __attribute__((ext_vector_type(16))) float;
using u32x4  = __attribute__((ext_vector_type(4))) unsigned;
constexpr int NW = 8, QBLK = 32, KVBLK = 64, LD = 1024, NT = 68;
constexpr float THR = 8.f;
constexpr int SHM_V = KVBLK * 128 * 2, SHM_K = KVBLK * 64 * 2;
constexpr int OFF_K = 2 * SHM_V, OFF_WS = OFF_K + 2 * SHM_K, OFF_OST = OFF_WS + NW * 64 * 4, SHM_ATTN = OFF_OST + NW * 8192;
#define KSWZ64(row, colB) ((row) * 128 + ((colB) ^ ((((row) >> 1) & 7) << 4)))
#define SBAR() __builtin_amdgcn_sched_barrier(0)
__device__ __forceinline__ int crow(int r, int hi) { return (r & 3) + 8 * (r >> 2) + 4 * hi; }
__device__ __forceinline__ unsigned cvtpk(float lo, float hi) { unsigned r; asm volatile("v_cvt_pk_bf16_f32 %0, %1, %2" : "=v"(r) : "v"(lo), "v"(hi)); return r; }
__device__ __forceinline__ void partialSM(f32x16& p0, f32x16& p1, float& m_reg, float& mn, float& alpha) {
  constexpr float C = 1.4426950408889634f;
  float pmax = p0[0];
#pragma unroll
  for (int r = 1; r < 16; ++r) pmax = fmaxf(pmax, p0[r]);
#pragma unroll
  for (int r = 0; r < 16; ++r) pmax = fmaxf(pmax, p1[r]);
  { auto rr = __builtin_amdgcn_permlane32_swap(__float_as_uint(pmax), __float_as_uint(pmax), false, false);
    pmax = fmaxf(__uint_as_float(rr[0]), __uint_as_float(rr[1])); }
  if (__builtin_expect(__all(pmax - m_reg <= THR), 1)) { mn = m_reg; alpha = 1.f; }
  else { mn = fmaxf(m_reg, pmax); alpha = __builtin_amdgcn_exp2f((m_reg - mn) * C); m_reg = mn; }
  float mnC = -mn * C;
#pragma unroll
  for (int r = 0; r < 16; ++r) p0[r] = fmaf(p0[r], C, mnC);
#pragma unroll
  for (int r = 0; r < 16; ++r) p1[r] = fmaf(p1[r], C, mnC);
#pragma unroll
  for (int r = 0; r < 16; ++r) p0[r] = __builtin_amdgcn_exp2f(p0[r]);
}
__device__ __forceinline__ void finishSM(f32x16& p0, f32x16& p1, float alpha, float& l_reg, bf16x8& pa0, bf16x8& pa1, bf16x8& pa2, bf16x8& pa3) {
#pragma unroll
  for (int r = 0; r < 16; ++r) p1[r] = __builtin_amdgcn_exp2f(p1[r]);
  float ps = 0;
#pragma unroll
  for (int r = 0; r < 16; ++r) ps += p0[r];
#pragma unroll
  for (int r = 0; r < 16; ++r) ps += p1[r];
  { auto rr = __builtin_amdgcn_permlane32_swap(__float_as_uint(ps), __float_as_uint(ps), false, false);
    ps = __uint_as_float(rr[0]) + __uint_as_float(rr[1]); }
  l_reg = l_reg * alpha + ps;
#define PK4(P, BASE, OUT) do { unsigned a0 = cvtpk(P[BASE + 0], P[BASE + 1]), a1 = cvtpk(P[BASE + 2], P[BASE + 3]);   \
    unsigned b0 = cvtpk(P[BASE + 4], P[BASE + 5]), b1 = cvtpk(P[BASE + 6], P[BASE + 7]);                              \
    auto r0 = __builtin_amdgcn_permlane32_swap(a0, b0, false, false); auto r1 = __builtin_amdgcn_permlane32_swap(a1, b1, false, false); \
    u32x4 w = {r0[0], r1[0], r0[1], r1[1]}; OUT = *reinterpret_cast<bf16x8*>(&w); } while (0)
  PK4(p0, 0, pa0); PK4(p0, 8, pa1); PK4(p1, 0, pa2); PK4(p1, 8, pa3);
#undef PK4
}
__device__ __forceinline__ void qkt(f32x16& p0, f32x16& p1, const char* Ks, const bf16x8* qr, int r32, int hi) {
  p0 = f32x16{}; p1 = f32x16{};
#pragma unroll
  for (int d0 = 0; d0 < 4; ++d0) { const int cb = (d0 * 16 + hi * 8) * 2;
    bf16x8 b0 = *reinterpret_cast<const bf16x8*>(Ks + KSWZ64(r32, cb));
    bf16x8 b1 = *reinterpret_cast<const bf16x8*>(Ks + KSWZ64(32 + r32, cb));
    p0 = __builtin_amdgcn_mfma_f32_32x32x16_bf16(b0, qr[d0], p0, 0, 0, 0);
    p1 = __builtin_amdgcn_mfma_f32_32x32x16_bf16(b1, qr[d0], p1, 0, 0, 0); }
}
__device__ __forceinline__ int v_st(int k, int c) { const int kk = (k & ~0xC) | ((k & 4) << 1) | ((k & 8) >> 1); return ((kk >> 3) * 4 + (c >> 5)) * 512 + ((kk & 7) * 32 + (c & 31)) * 2; }
__device__ __forceinline__ int v_rd_base(int lane) { return ((lane & 3) << 3) | (((lane >> 2) & 3) << 6) | (((lane >> 4) & 1) << 5) | (((lane >> 5) & 1) << 8); }
constexpr int v_rd_off(int d0, int ks, int half) { return d0 * 512 + ks * 4096 + half * 2048; }
template <int OFF> __device__ __forceinline__ s16x4 tr_read(int vb) { s16x4 r; asm volatile("ds_read_b64_tr_b16 %0, %1 offset:%2" : "=&v"(r) : "v"(vb), "i"(OFF) : "memory"); return r; }
template <int D0> __device__ __forceinline__ void pv_one(f32x16& od, int vb, bf16x8 pa0, bf16x8 pa1, bf16x8 pa2, bf16x8 pa3) {
  const s16x4 l0 = tr_read<v_rd_off(D0, 0, 0)>(vb), h0 = tr_read<v_rd_off(D0, 0, 1)>(vb), l1 = tr_read<v_rd_off(D0, 1, 0)>(vb), h1 = tr_read<v_rd_off(D0, 1, 1)>(vb);
  const s16x4 l2 = tr_read<v_rd_off(D0, 2, 0)>(vb), h2 = tr_read<v_rd_off(D0, 2, 1)>(vb), l3 = tr_read<v_rd_off(D0, 3, 0)>(vb), h3 = tr_read<v_rd_off(D0, 3, 1)>(vb);
  asm volatile("s_waitcnt lgkmcnt(0)" ::: "memory"); SBAR();
#define PK(L, H) (bf16x8){L[0], L[1], L[2], L[3], H[0], H[1], H[2], H[3]}
  od = __builtin_amdgcn_mfma_f32_32x32x16_bf16(pa0, PK(l0, h0), od, 0, 0, 0);
  od = __builtin_amdgcn_mfma_f32_32x32x16_bf16(pa1, PK(l1, h1), od, 0, 0, 0);
  od = __builtin_amdgcn_mfma_f32_32x32x16_bf16(pa2, PK(l2, h2), od, 0, 0, 0);
  od = __builtin_amdgcn_mfma_f32_32x32x16_bf16(pa3, PK(l3, h3), od, 0, 0, 0);
#undef PK
}
__device__ __forceinline__ void pv_d0(f32x16* o, int vb, bf16x8 pa0, bf16x8 pa1, bf16x8 pa2, bf16x8 pa3) {
  pv_one<0>(o[0], vb, pa0, pa1, pa2, pa3); pv_one<1>(o[1], vb, pa0, pa1, pa2, pa3); pv_one<2>(o[2], vb, pa0, pa1, pa2, pa3); pv_one<3>(o[3], vb, pa0, pa1, pa2, pa3);
}

__device__ __forceinline__ void attn_unit(int b, int h, int qb, const bf16_t* __restrict__ QD, const bf16_t* __restrict__ KD, const bf16_t* __restrict__ VD, bf16_t* __restrict__ AD,
                                          float lam, const float* __restrict__ gsub, char* lds) {
  int tid_ = threadIdx.x; asm volatile("" : "+v"(tid_));
  const int tid = tid_, wid = tid >> 6, lane = tid & 63, r32 = lane & 31, hi = lane >> 5;
  char* V_lds = lds; char* K_lds = lds + OFF_K;
  float* ws = (float*)(lds + OFF_WS) + wid * 64; float* li_l = ws; float* al_l = ws + 32;
  char* ost = lds + OFF_OST + wid * 8192;
  const long qrow0 = (long)b * SEQ + qb * 256;
  const int sr = tid >> 4, sc = (tid & 15) * 8, vst0 = v_st(sr, sc);
  const int kr = tid >> 3, kc = (tid & 7) * 8, kst = KSWZ64(kr, kc * 2);
  const int koff = kr * LD + kc, voff = sr * LD + sc;
  const int vb0 = (int)(uintptr_t)V_lds + v_rd_base(lane);
#pragma unroll 1
  for (int c = 0; c < 2; ++c) {
    float m_reg = -1e30f, l_reg = 0; f32x16 o[4] = {}; bf16x8 qr[4];
    const bf16_t* Qw = QD + (qrow0 + wid * QBLK + r32) * LD + h * 128 + c * 64 + hi * 8;
#pragma unroll
    for (int d0 = 0; d0 < 4; ++d0) qr[d0] = *reinterpret_cast<const bf16x8*>(Qw + d0 * 16);
    const bf16_t* Kl = KD + (long)b * SEQ * LD + h * 128 + c * 64;
    const bf16_t* Kc = KD + ((long)ML + b * CTX) * LD + h * 128 + c * 64;
    const bf16_t* Vl = VD + (long)b * SEQ * LD + h * 128;
    const bf16_t* Vc = VD + ((long)ML + b * CTX) * LD + h * 128;
    constexpr int SDEPTH = 2;
    struct { bf16x8 vs0, vs1, ks; } sr_[SDEPTH];
#define SLOAD(i, j) do { const long to_ = ((j) < 64) ? (long)(j) * (64 * LD) : (long)((j) - 64) * (64 * LD); const bf16_t* kp_ = ((j) < 64 ? Kl : Kc) + to_; const bf16_t* vp_ = ((j) < 64 ? Vl : Vc) + to_; \
    sr_[i].vs0 = *reinterpret_cast<const bf16x8*>(vp_ + voff); sr_[i].vs1 = *reinterpret_cast<const bf16x8*>(vp_ + voff + 32 * LD); sr_[i].ks = *reinterpret_cast<const bf16x8*>(kp_ + koff); } while (0)
#define SWRITE(bb, i) do { *(bf16x8*)(V_lds + (bb) * SHM_V + vst0) = sr_[i].vs0; *(bf16x8*)(V_lds + (bb) * SHM_V + vst0 + 8192) = sr_[i].vs1; *(bf16x8*)(K_lds + (bb) * SHM_K + kst) = sr_[i].ks; } while (0)
#define SWAIT() do { if constexpr (SDEPTH == 2) asm volatile("s_waitcnt vmcnt(3)" ::: "memory"); else asm volatile("s_waitcnt vmcnt(0)" ::: "memory"); } while (0)
#define RESC(a) do { if (__any((a) < 1.f)) { if (hi == 0) al_l[r32] = (a); asm volatile("s_waitcnt lgkmcnt(0)" ::: "memory"); \
    _Pragma("unroll") for (int d = 0; d < 4; ++d) _Pragma("unroll") for (int r = 0; r < 16; ++r) o[d][r] *= al_l[crow(r, hi)]; } } while (0)
    f32x16 pA0, pA1, pB0, pB1; float mnA, mnB, alA, alB; bf16x8 pa0, pa1, pa2, pa3;
    constexpr int SE = 0, SO = SDEPTH - 1;
    SLOAD(SE, 0); asm volatile("s_waitcnt vmcnt(0)" ::: "memory"); SWRITE(0, SE); __syncthreads();
    qkt(pA0, pA1, K_lds, qr, r32, hi); partialSM(pA0, pA1, m_reg, mnA, alA);
    SLOAD(SO, 1); if constexpr (SDEPTH == 2) SLOAD(SE, 2);
    SWAIT(); SWRITE(1, SO); __syncthreads();
    for (int j = 1; j + 1 < NT; j += 2) {
      SBAR(); qkt(pB0, pB1, K_lds + SHM_K, qr, r32, hi);
      finishSM(pA0, pA1, alA, l_reg, pa0, pa1, pa2, pa3); SBAR();
      SLOAD(SO, j + SDEPTH); SBAR();
      pv_d0(o, vb0, pa0, pa1, pa2, pa3); partialSM(pB0, pB1, m_reg, mnB, alB);
      __syncthreads(); SWAIT(); SWRITE(0, SE);
      RESC(alB); __syncthreads();
      SBAR(); qkt(pA0, pA1, K_lds, qr, r32, hi);
      finishSM(pB0, pB1, alB, l_reg, pa0, pa1, pa2, pa3); SBAR();
      if (SDEPTH == 1 || j + 3 < NT) SLOAD(SE, j + 1 + SDEPTH); SBAR();
      pv_d0(o, vb0 + SHM_V, pa0, pa1, pa2, pa3); partialSM(pA0, pA1, m_reg, mnA, alA);
      __syncthreads(); SWAIT(); SWRITE(1, SO);
      RESC(alA); __syncthreads();
    }
    SBAR(); qkt(pB0, pB1, K_lds + SHM_K, qr, r32, hi);
    finishSM(pA0, pA1, alA, l_reg, pa0, pa1, pa2, pa3); SBAR();
    pv_d0(o, vb0, pa0, pa1, pa2, pa3); partialSM(pB0, pB1, m_reg, mnB, alB);
    __syncthreads(); RESC(alB);
    finishSM(pB0, pB1, alB, l_reg, pa0, pa1, pa2, pa3); SBAR();
    pv_d0(o, vb0 + SHM_V, pa0, pa1, pa2, pa3);
#undef SLOAD
#undef SWRITE
#undef SWAIT
#undef RESC
    if (hi == 0) li_l[r32] = l_reg; asm volatile("s_waitcnt lgkmcnt(0)" ::: "memory");
    float rli[16];
#pragma unroll
    for (int r = 0; r < 16; ++r) rli[r] = __builtin_amdgcn_rcpf(li_l[crow(r, hi)]);
    unsigned* pst = (unsigned*)ost;
    if (c == 0) {
#pragma unroll
      for (int d0 = 0; d0 < 4; ++d0)
#pragma unroll
        for (int rp = 0; rp < 8; ++rp) pst[(d0 * 8 + rp) * 64 + lane] = cvtpk(o[d0][2 * rp] * rli[2 * rp], o[d0][2 * rp + 1] * rli[2 * rp + 1]);
    } else {
#pragma unroll
      for (int d0 = 0; d0 < 4; ++d0)
#pragma unroll
        for (int rp = 0; rp < 8; ++rp) { const unsigned w = pst[(d0 * 8 + rp) * 64 + lane];
          o[d0][2 * rp] = __uint_as_float(w << 16) - lam * (o[d0][2 * rp] * rli[2 * rp]); o[d0][2 * rp + 1] = __uint_as_float(w & 0xffff0000u) - lam * (o[d0][2 * rp + 1] * rli[2 * rp + 1]); }
      asm volatile("s_waitcnt lgkmcnt(0)" ::: "memory");
      float* stf = (float*)ost;
      const int ch = lane & 15, rq = lane >> 4;
      f32x4 g0 = *(const f32x4*)(gsub + ch * 8), g1 = *(const f32x4*)(gsub + ch * 8 + 4); g0 = g0 * (1.f - LAM_INIT); g1 = g1 * (1.f - LAM_INIT);
#pragma unroll
      for (int rh = 0; rh < 2; ++rh) {
#pragma unroll
        for (int rr = 0; rr < 8; ++rr) { const int lr = (rr & 3) + 8 * (rr >> 2) + 4 * hi;
#pragma unroll
          for (int d0 = 0; d0 < 4; ++d0) stf[lr * 128 + d0 * 32 + r32] = o[d0][rh * 8 + rr]; }
        asm volatile("s_waitcnt lgkmcnt(0)" ::: "memory");
#pragma unroll
        for (int i = 0; i < 4; ++i) { const int row = i * 4 + rq;
          f32x4 v0 = *(const f32x4*)(stf + row * 128 + ch * 8), v1 = *(const f32x4*)(stf + row * 128 + ch * 8 + 4);
          float ss = (v0[0] * v0[0] + v0[1] * v0[1]) + (v0[2] * v0[2] + v0[3] * v0[3]) + (v1[0] * v1[0] + v1[1] * v1[1]) + (v1[2] * v1[2] + v1[3] * v1[3]);
          ss += __shfl_xor(ss, 1); ss += __shfl_xor(ss, 2); ss += __shfl_xor(ss, 4); ss += __shfl_xor(ss, 8);
          const float rs = 1.f / sqrtf(ss * (1.f / 128.f) + LN_EPS);
          v0 = v0 * rs * g0; v1 = v1 * rs * g1;
          u32x4 w; w.x = cvtpk(v0[0], v0[1]); w.y = cvtpk(v0[2], v0[3]); w.z = cvtpk(v1[0], v1[1]); w.w = cvtpk(v1[2], v1[3]);
          *(u32x4*)(AD + (qrow0 + wid * QBLK + rh * 16 + row) * LD + h * 128 + ch * 8) = w; }
        asm volatile("s_waitcnt lgkmcnt(0)" ::: "memory");
      }
    }
    __syncthreads();
  }
}
#undef KSWZ64
#undef SBAR
}
__device__ __forceinline__ void d_attn_fast(const Ctx& C, const bf16_t* __restrict__ QD, const bf16_t* __restrict__ KD, const bf16_t* __restrict__ VD, bf16_t* __restrict__ AD,
                                            const float* __restrict__ SCAL, const float* __restrict__ gsub) {
  const float lam = SCAL[0];
  const int vcu = (C.G == 256) ? C.vcu : C.bx;
  for (int i = 0; (long)i * C.G + vcu < 1024; ++i) {
    int bh, qb;
    if (C.G == 256) { bh = (vcu >> 5) * 8 + i * 2 + ((vcu & 31) >> 4); qb = vcu & 15; }
    else { const int L = i * C.G + vcu; bh = L >> 4; qb = L & 15; }
    fa::attn_unit(bh >> 3, bh & 7, qb, QD, KD, VD, AD, lam, gsub, (char*)C.lds);
  }
}

namespace rt {
typedef __attribute__((address_space(3))) unsigned char* lptr;
typedef short v4i16_t __attribute__((ext_vector_type(4)));
typedef unsigned u32x2 __attribute__((ext_vector_type(2)));
constexpr int RSQ = 544, RSV = 160;
constexpr int O_Q = 0, O_K = 64 * RSQ, O_ST = 2 * 64 * RSQ, O_V = 3 * 64 * RSQ, O_VP = O_V + 64 * RSV, O_P = O_VP + 64 * RSV, O_END = O_P + 64 * RSV;
constexpr int NSTEP = 68;
__device__ __forceinline__ bf16x8 ld128(lptr p) { return *(const __attribute__((address_space(3))) bf16x8*)p; }
__device__ __forceinline__ bf16x8 trfrag(lptr lo, lptr hi) {
    const v4i16_t a = __builtin_amdgcn_ds_read_tr16_b64_v4i16((__attribute__((address_space(3))) v4i16_t*)lo), b = __builtin_amdgcn_ds_read_tr16_b64_v4i16((__attribute__((address_space(3))) v4i16_t*)hi);
    return (bf16x8){a[0], a[1], a[2], a[3], b[0], b[1], b[2], b[3]}; }
__device__ __forceinline__ u32x2 pack4(const f32x4& v) { u32x2 w; w.x = cvtpk(v[0], v[1]); w.y = cvtpk(v[2], v[3]); return w; }
#define MFMA16(a, b, c) __builtin_amdgcn_mfma_f32_16x16x32_bf16((a), (b), (c), 0, 0, 0)

template <int PASS>
__device__ __forceinline__ void ret_pass(int b, int h, int vs, const bf16_t* __restrict__ QR, const bf16_t* __restrict__ KR, const bf16_t* __restrict__ VR, bf16_t* __restrict__ YR,
                                         const float lgf2, const float lgb2, const lptr lds, const int tid, const int w, const int fr, const int fq) {
    const int ct = w & 3, it0 = 2 * (w >> 2), jt = w & 3;
    const int qrow = tid >> 5, qch = tid & 31, vrow = tid >> 3, vch = tid & 7;
    const int li4 = (fr >> 2), lip = (fr & 3);
    const lptr pS = lds + O_ST + (16 * ct + fr) * RSQ + 16 * fq;
    const lptr pQ0 = lds + O_Q + (16 * it0 + fr) * RSQ + 16 * fq, pQ1 = pQ0 + 16 * RSQ;
    const lptr pK = lds + O_K + (16 * jt + fr) * RSQ + 16 * fq;
    const lptr pPw = lds + O_P + (16 * it0 + fr) * RSV + (16 * jt + 4 * fq) * 2;
    const lptr pPr = lds + O_P + (16 * it0 + fr) * RSV + (4 * fq) * 2;
    const lptr pVt = lds + O_V + (4 * fq + li4) * RSV + (16 * ct + 4 * lip) * 2;
    const lptr pKt = lds + O_K + (4 * fq + li4) * RSQ + (32 * w + 4 * lip) * 2;
    const lptr pVPt = lds + O_VP + (4 * fq + li4) * RSV + (4 * lip) * 2;
    const lptr pSTw = lds + O_ST + fr * RSQ + (32 * w + 4 * fq) * 2;
    const float lg2 = PASS ? lgb2 : lgf2, ds = __builtin_amdgcn_exp2f(lg2 * 64.f);
    const float dkv = __builtin_amdgcn_exp2f(lg2 * (PASS ? (float)vrow : (float)(63 - vrow)));
    float dq[2], msk[2][4];
#pragma unroll
    for (int t = 0; t < 2; ++t) { const int i = 16 * (it0 + t) + fr; dq[t] = __builtin_amdgcn_exp2f(lg2 * (PASS ? (float)(64 - i) : (float)(i + 1)));
#pragma unroll
        for (int r = 0; r < 4; ++r) { const int j = 16 * jt + 4 * fq + r, dd = i - j; msk[t][r] = dd > 0 ? __builtin_amdgcn_exp2f(lgf2 * (float)dd) : (dd < 0 ? __builtin_amdgcn_exp2f(lgb2 * (float)(-dd)) : 2.f); } }
    f32x4 S[2][4];
#pragma unroll
    for (int dt = 0; dt < 2; ++dt)
#pragma unroll
        for (int c4 = 0; c4 < 4; ++c4) S[dt][c4] = (f32x4){0.f, 0.f, 0.f, 0.f};
    struct StageRegs { bf16x8 q[4], k[4], v; } sA, sB;
#define RT_ROWBASE(step, rb, rq, lat) do { if ((step) < 4) { const int cc_ = PASS ? 3 - (step) : (step); rb = ML + b * CTX + cc_ * 64; rq = b * SEQ; lat = false; } \
        else { const int n_ = PASS ? (NSTEP - 1) - (step) : (step) - 4; rb = b * SEQ + n_ * 64; rq = rb; lat = true; } } while (0)
#define RT_LOAD(R, step_) do { const int st_ = (step_) < NSTEP ? (step_) : NSTEP - 1; int rb_, rq_; bool lat_; RT_ROWBASE(st_, rb_, rq_, lat_); (void)lat_; \
        _Pragma("unroll") for (int k = 0; k < 4; ++k) { R.k[k] = *(const bf16x8*)(KR + (size_t)(rb_ + qrow + 16 * k) * 1024 + h * 256 + qch * 8); \
            R.q[k] = *(const bf16x8*)(QR + (size_t)(rq_ + qrow + 16 * k) * 1024 + h * 256 + qch * 8); } \
        R.v = *(const bf16x8*)(VR + (size_t)(rb_ + vrow) * 2048 + h * 512 + vs * 64 + vch * 8); } while (0)
#define RT_WRITE(R) do { \
        _Pragma("unroll") for (int k = 0; k < 4; ++k) { *(__attribute__((address_space(3))) bf16x8*)(lds + O_K + (qrow + 16 * k) * RSQ + qch * 16) = R.k[k]; \
            *(__attribute__((address_space(3))) bf16x8*)(lds + O_Q + (qrow + 16 * k) * RSQ + qch * 16) = R.q[k]; } \
        *(__attribute__((address_space(3))) bf16x8*)(lds + O_V + vrow * RSV + vch * 16) = R.v; \
        { f32x4 a_, b_; unpack8(__builtin_bit_cast(u32x4, R.v), a_, b_); a_ = a_ * dkv; b_ = b_ * dkv; const u32x4 w_ = pack8(a_, b_); \
          *(__attribute__((address_space(3))) u32x4*)(lds + O_VP + vrow * RSV + vch * 16) = w_; } } while (0)
    RT_LOAD(sA, 0); RT_WRITE(sA); RT_LOAD(sB, 1);
#define RT_STEP(step, RL, RW) do { \
        int rowbase, rq_unused; bool lat; RT_ROWBASE(step, rowbase, rq_unused, lat); (void)rq_unused; \
        __syncthreads(); \
        bf16_t* yp0 = YR + (size_t)(rowbase + 16 * it0 + fr) * 2048 + h * 512 + vs * 64 + 16 * ct + 4 * fq; bf16_t* yp1 = yp0 + (size_t)16 * 2048; \
        u32x2 yo0 = {0u, 0u}, yo1 = {0u, 0u}; \
        if (PASS == 1 && lat) { yo0 = *(const u32x2*)yp0; yo1 = *(const u32x2*)yp1; } \
        RT_LOAD(RL, (step) + 2);                                    \
        if (lat) { \
            f32x4 ay0 = {0.f, 0.f, 0.f, 0.f}, ay1 = ay0, ap0 = ay0, ap1 = ay0; \
            bf16x8 as_c = ld128(pS), q0_c = ld128(pQ0), q1_c = ld128(pQ1), ak_c = q0_c; \
            if (PASS == 0) ak_c = ld128(pK); \
_Pragma("unroll") \
            for (int ks = 0; ks < 8; ++ks) { \
                bf16x8 as_n = as_c, q0_n = q0_c, q1_n = q1_c, ak_n = ak_c; \
                if (ks < 7) { as_n = ld128(pS + 64 * (ks + 1)); q0_n = ld128(pQ0 + 64 * (ks + 1)); q1_n = ld128(pQ1 + 64 * (ks + 1)); if (PASS == 0) ak_n = ld128(pK + 64 * (ks + 1)); } \
                ay0 = MFMA16(as_c, q0_c, ay0); ay1 = MFMA16(as_c, q1_c, ay1); \
                if (PASS == 0) { ap0 = MFMA16(ak_c, q0_c, ap0); ap1 = MFMA16(ak_c, q1_c, ap1); } \
                as_c = as_n; q0_c = q0_n; q1_c = q1_n; ak_c = ak_n; \
            } \
            ay0 = ay0 * dq[0]; ay1 = ay1 * dq[1]; \
            if (PASS == 0) { \
_Pragma("unroll") \
                for (int r = 0; r < 4; ++r) { ap0[r] *= msk[0][r]; ap1[r] *= msk[1][r]; } \
                *(__attribute__((address_space(3))) u32x2*)(pPw) = pack4(ap0); *(__attribute__((address_space(3))) u32x2*)(pPw + 16 * RSV) = pack4(ap1); \
                __syncthreads(); \
                const bf16x8 av0 = trfrag(pVt, pVt + 16 * RSV), av1 = trfrag(pVt + 32 * RSV, pVt + 32 * RSV + 16 * RSV); \
                u32x2 pl[2][2], ph[2][2]; \
_Pragma("unroll") \
                for (int ks = 0; ks < 2; ++ks) \
_Pragma("unroll") \
                    for (int t = 0; t < 2; ++t) { pl[ks][t] = *(const __attribute__((address_space(3))) u32x2*)(pPr + t * 16 * RSV + ks * 64); ph[ks][t] = *(const __attribute__((address_space(3))) u32x2*)(pPr + t * 16 * RSV + ks * 64 + 32); } \
_Pragma("unroll") \
                for (int ks = 0; ks < 2; ++ks) { const u32x4 b0 = {pl[ks][0].x, pl[ks][0].y, ph[ks][0].x, ph[ks][0].y}, b1 = {pl[ks][1].x, pl[ks][1].y, ph[ks][1].x, ph[ks][1].y}; \
                    ay0 = MFMA16(ks ? av1 : av0, __builtin_bit_cast(bf16x8, b0), ay0); ay1 = MFMA16(ks ? av1 : av0, __builtin_bit_cast(bf16x8, b1), ay1); } \
                *(u32x2*)yp0 = pack4(ay0); *(u32x2*)yp1 = pack4(ay1); \
            } else { \
                f32x4 o0, o1; \
                o0[0] = __uint_as_float(yo0.x << 16); o0[1] = __uint_as_float(yo0.x & 0xffff0000u); o0[2] = __uint_as_float(yo0.y << 16); o0[3] = __uint_as_float(yo0.y & 0xffff0000u); \
                o1[0] = __uint_as_float(yo1.x << 16); o1[1] = __uint_as_float(yo1.x & 0xffff0000u); o1[2] = __uint_as_float(yo1.y << 16); o1[3] = __uint_as_float(yo1.y & 0xffff0000u); \
                *(u32x2*)yp0 = pack4(ay0 + o0); *(u32x2*)yp1 = pack4(ay1 + o1); \
            } \
        } \
        bf16x8 ak[2][2], bv[2][4]; \
_Pragma("unroll") \
        for (int ks = 0; ks < 2; ++ks) { \
_Pragma("unroll") \
            for (int dt = 0; dt < 2; ++dt) ak[ks][dt] = trfrag(pKt + dt * 32 + ks * 32 * RSQ, pKt + dt * 32 + ks * 32 * RSQ + 16 * RSQ); \
_Pragma("unroll") \
            for (int c4 = 0; c4 < 4; ++c4) bv[ks][c4] = trfrag(pVPt + c4 * 32 + ks * 32 * RSV, pVPt + c4 * 32 + ks * 32 * RSV + 16 * RSV); \
        } \
_Pragma("unroll") \
        for (int dt = 0; dt < 2; ++dt) \
_Pragma("unroll") \
            for (int c4 = 0; c4 < 4; ++c4) S[dt][c4] = S[dt][c4] * ds; \
_Pragma("unroll") \
        for (int ks = 0; ks < 2; ++ks) \
_Pragma("unroll") \
            for (int dt = 0; dt < 2; ++dt) \
_Pragma("unroll") \
                for (int c4 = 0; c4 < 4; ++c4) S[dt][c4] = MFMA16(ak[ks][dt], bv[ks][c4], S[dt][c4]); \
        __syncthreads(); \
_Pragma("unroll") \
        for (int dt = 0; dt < 2; ++dt) \
_Pragma("unroll") \
            for (int c4 = 0; c4 < 4; ++c4) *(__attribute__((address_space(3))) u32x2*)(pSTw + c4 * 16 * RSQ + dt * 32) = pack4(S[dt][c4]); \
        RT_WRITE(RW); \
    } while (0)
#pragma unroll 1
    for (int step2 = 0; step2 < NSTEP; step2 += 2) { RT_STEP(step2, sA, sB); RT_STEP(step2 + 1, sB, sA); }
    __syncthreads();
#undef RT_ROWBASE
#undef RT_LOAD
#undef RT_WRITE
#undef RT_STEP
}
__device__ __forceinline__ void ret_stream(int b, int h, int vs, const bf16_t* __restrict__ QR, const bf16_t* __restrict__ KR, const bf16_t* __restrict__ VR, bf16_t* __restrict__ YR,
                                           const float* __restrict__ SCAL, unsigned char* lds_) {
    int tid_ = threadIdx.x; asm volatile("" : "+v"(tid_));
    const int tid = tid_, w = __builtin_amdgcn_readfirstlane(tid >> 6), lane = tid & 63, fr = lane & 15, fq = lane >> 4;
    const float L2E = 1.4426950408889634f, lgf2 = SCAL[1 + h] * L2E, lgb2 = SCAL[5 + h] * L2E;
    ret_pass<0>(b, h, vs, QR, KR, VR, YR, lgf2, lgb2, (lptr)lds_, tid, w, fr, fq);
    ret_pass<1>(b, h, vs, QR, KR, VR, YR, lgf2, lgb2, (lptr)lds_, tid, w, fr, fq);
}
#undef MFMA16
}
__device__ __forceinline__ void d_ret_fast(const Ctx& C, const bf16_t* __restrict__ QR, const bf16_t* __restrict__ KR, const bf16_t* __restrict__ VR, bf16_t* __restrict__ YR, const float* __restrict__ SCAL) {
    for (int sid0 = C.bx; sid0 < 256; sid0 += C.G) {
        const int sid = (C.G == 256) ? C.vcu : sid0;
        rt::ret_stream(sid >> 5, (sid >> 3) & 3, sid & 7, QR, KR, VR, YR, SCAL, C.lds);
    }
}


typedef __attribute__((address_space(1))) unsigned gu32;
#define RLX_AGENT __ATOMIC_RELAXED, __HIP_MEMORY_SCOPE_AGENT
#define XB_TMO      128
#define XB_XCNT(j)  (256  + 64 * (j))
#define XB_XSUB(j)  (1280 + 64 * (j))
#define XB_XGEN(j)  (2304 + 64 * (j))
#define XB_TOP      3328
#define XB_TOPGEN   3392
#define XCD_BAR_WORDS 3456
#define XB_SPIN_CAP (1u << 18)

__device__ __forceinline__ unsigned xb_ld(unsigned* p)              { return __hip_atomic_load(p, __ATOMIC_RELAXED, __HIP_MEMORY_SCOPE_AGENT); }
__device__ __forceinline__ unsigned xb_add(unsigned* p, unsigned v) { return __hip_atomic_fetch_add(p, v, __ATOMIC_RELAXED, __HIP_MEMORY_SCOPE_AGENT); }
__device__ __forceinline__ unsigned xb_xcc_id() { return (unsigned)__builtin_amdgcn_s_getreg((3 << 11) | 20) & 0xFu; }
#define XB_SPIN(cond, bar) do { unsigned _sp = 0; while (cond) { __builtin_amdgcn_s_sleep(1); \
    if ((++_sp & 255u) == 0u) { if (xb_ld(&(bar)[XB_TMO])) break; if (_sp > XB_SPIN_CAP) { atomicAdd(&(bar)[XB_TMO], 1u); break; } } } } while (0)

struct XcdBarrier {
    unsigned* bar; unsigned x;
    volatile LAS unsigned* st;
};

__device__ __forceinline__ XcdBarrier xcd_barrier_post(unsigned* bar, volatile LAS unsigned* st) {
    XcdBarrier b; b.bar = bar; b.x = xb_xcc_id(); b.st = st;
    if (threadIdx.x == 0) (void)xb_add(&bar[XB_XCNT(b.x)], 1u);
    return b;
}
__device__ __forceinline__ void xcd_barrier_complete(unsigned* bar, unsigned x, unsigned& nloc, unsigned& nx) {
    const unsigned G = gridDim.x * gridDim.y * gridDim.z;
    unsigned sum, cnt, mine, sp = 0u;
    for (;;) {
        sum = 0u; cnt = 0u; mine = 0u;
#pragma unroll
        for (unsigned j = 0; j < 16; ++j) { const unsigned c = xb_ld(&bar[XB_XCNT(j)]); sum += c; cnt += (c > 0u) ? 1u : 0u; mine = (j == x) ? c : mine; }
        if (sum == G) break;
        __builtin_amdgcn_s_sleep(1);
        if ((++sp & 255u) == 0u) { if (xb_ld(&bar[XB_TMO])) break; if (sp > XB_SPIN_CAP) { atomicAdd(&bar[XB_TMO], 1u); break; } }
    }
    nloc = mine > 0u ? mine : 1u; nx = cnt > 0u ? cnt : 1u;
}

__device__ __forceinline__ void xcd_barrier(const XcdBarrier& b) {
    asm volatile("s_waitcnt vmcnt(0)" ::: "memory");
    __syncthreads();
    if (threadIdx.x == 0) {
        unsigned* bar = b.bar;
        __builtin_amdgcn_s_waitcnt(0);
        unsigned nloc = b.st[0], nx = b.st[1];
        if (nloc == 0u) { xcd_barrier_complete(bar, b.x, nloc, nx); b.st[0] = nloc; b.st[1] = nx; }
        const unsigned old = xb_add(&bar[XB_XSUB(b.x)], 1u);
        const unsigned gen = old / nloc;
        if (old + 1u == (gen + 1u) * nloc) {
            __builtin_amdgcn_fence(__ATOMIC_RELEASE, "agent");
            asm volatile("s_waitcnt vmcnt(0)" ::: "memory");
            const unsigned og = xb_add(&bar[XB_TOP], 1u);
            const unsigned tg = og / nx;
            if (og + 1u == (tg + 1u) * nx) xb_add(&bar[XB_TOPGEN], 1u);
            else XB_SPIN(xb_ld(&bar[XB_TOPGEN]) == tg, bar);
            __builtin_amdgcn_fence(__ATOMIC_ACQUIRE, "agent");
            xb_add(&bar[XB_XGEN(b.x)], 1u);
            asm volatile("s_waitcnt vmcnt(0)" ::: "memory");
        } else {
            XB_SPIN(xb_ld(&bar[XB_XGEN(b.x)]) == gen, bar);
            __builtin_amdgcn_fence(__ATOMIC_ACQUIRE, "agent");
            asm volatile("s_waitcnt vmcnt(0)" ::: "memory");
        }
    }
    __syncthreads();
}


__device__ __forceinline__ void d_convgate_v(const Ctx& C, const bf16_t* __restrict__ U, const float* __restrict__ cw, const float* __restrict__ cb, bf16_t* H) {
    constexpr int NFG = DFF / 8, RB = 8, NIT = NFG * (ML / RB);
    for (int it = C.gt; it < NIT; it += C.NGT) {
        const int fg = it % NFG, rb = it / NFG, f = fg * 8, r0 = rb * RB;
        const f32x4 w0a = *(const f32x4*)(cw + f), w0b = *(const f32x4*)(cw + f + 4), w1a = *(const f32x4*)(cw + DFF + f), w1b = *(const f32x4*)(cw + DFF + f + 4);
        const f32x4 w2a = *(const f32x4*)(cw + 2 * DFF + f), w2b = *(const f32x4*)(cw + 2 * DFF + f + 4), ba = *(const f32x4*)(cb + f), bb = *(const f32x4*)(cb + f + 4);
        const int t0 = r0 & (SEQ - 1);
        f32x4 pa = {0.f, 0.f, 0.f, 0.f}, pb = pa, ca, cbv, na, nb;
        if (t0 > 0) unpack8(*(const u32x4*)(U + (size_t)(r0 - 1) * DFF + f), pa, pb);
        unpack8(*(const u32x4*)(U + (size_t)r0 * DFF + f), ca, cbv);
#pragma unroll
        for (int r = 0; r < RB; ++r) { const int row = r0 + r, t = t0 + r;
            if (t < SEQ - 1) unpack8(*(const u32x4*)(U + (size_t)(row + 1) * DFF + f), na, nb); else { na = (f32x4){0.f, 0.f, 0.f, 0.f}; nb = na; }
            f32x4 ga, gb; unpack8(*(const u32x4*)(H + (size_t)row * DFF + f), ga, gb);
            const f32x4 ua = ba + w0a * pa + w1a * ca + w2a * na, ub = bb + w0b * pb + w1b * cbv + w2b * nb;
            *(u32x4*)(H + (size_t)row * DFF + f) = pack8(gelu4(ua) * ga, gelu4(ub) * gb);
            pa = ca; pb = cbv; ca = na; cbv = nb; }
    }
}

#ifndef PROBE_DUP
#define PROBE_DUP -1
#endif
#define REP(k) for (int rep_ = 0; rep_ < ((PROBE_DUP == (k)) ? 2 : 1); ++rep_)
constexpr int LDS_BYTES = 147456;
struct Params { const float* in[24]; float* out; unsigned char* ws; };
__global__ void __launch_bounds__(512, 2) mega(Params P) {
    extern __shared__ __attribute__((aligned(16))) unsigned char lds[];
    cg::grid_group grid = cg::this_grid();
    { volatile LAS unsigned* m_ = (volatile LAS unsigned*)((LAS unsigned char*)lds + LDS_MISC); if (threadIdx.x < 16) m_[threadIdx.x] = 0u; }
    __syncthreads();
    XcdBarrier bar = xcd_barrier_post((unsigned*)(P.ws + WS_BAR), (volatile LAS unsigned*)((LAS unsigned char*)lds + LDS_MISC));
#define GSYNC() xcd_barrier(bar)
    volatile LAS unsigned* misc_ = (volatile LAS unsigned*)((LAS unsigned char*)lds + LDS_MISC);
    if (threadIdx.x == 0) { unsigned* xq = (unsigned*)(P.ws + WS_BAR) + 3584; misc_[4] = bar.x; misc_[5] = atomicAdd(&xq[bar.x * 8], 1u); }
#define CTX() Ctx C; { int t_ = threadIdx.x; asm volatile("" : "+v"(t_)); C.tid = t_; C.lane = C.tid & 63; C.wave = C.tid >> 6; C.bx = blockIdx.x; C.G = gridDim.x; \
    C.gw = C.bx * 8 + C.wave; C.NGW = C.G * 8; C.gt = C.bx * 512 + C.tid; C.NGT = C.G * 512; C.lds = lds; C.vcu = (int)misc_[6]; }
    const float* x = P.in[0]; const float* c = P.in[1]; const float* ctx = P.in[2]; const float* cctx = P.in[3];
    const float* lng = P.in[4]; const float* lnb = P.in[5]; const float* wmod = P.in[6]; const float* bmod = P.in[7];
    const float* win = P.in[8]; const float* bgate = P.in[9]; const float* logit = P.in[10]; const float* dlam = P.in[11];
    const float* gsub = P.in[12]; const float* wret = P.in[13]; const float* wdif = P.in[14]; const float* wo = P.in[15];
    const float* ln1g = P.in[16]; const float* ln1b = P.in[17]; const float* wup = P.in[18]; const float* cw = P.in[19];
    const float* cb = P.in[20]; const float* wdn = P.in[21]; const float* ln2g = P.in[22]; const float* ln2b = P.in[23];
    unsigned char* ws = P.ws; float* out = P.out;
    float* MOD = (float*)(ws + WS_MOD); float* TAB = (float*)(ws + WS_TAB); float* SCAL = (float*)(ws + WS_SCAL); float* STATS = (float*)(ws + WS_STATS); float* RS = (float*)(ws + WS_RS);
    bf16_t* WIN = (bf16_t*)(ws + WS_WIN); bf16_t* WRET = (bf16_t*)(ws + WS_WRET); bf16_t* WDIF = (bf16_t*)(ws + WS_WDIF); bf16_t* WO = (bf16_t*)(ws + WS_WO);
    bf16_t* WUP = (bf16_t*)(ws + WS_WUP); bf16_t* WDN = (bf16_t*)(ws + WS_WDN); bf16_t* XM = (bf16_t*)(ws + WS_XM);
    bf16_t* QR = (bf16_t*)(ws + WS_QR); bf16_t* KR = (bf16_t*)(ws + WS_KR); bf16_t* VR = (bf16_t*)(ws + WS_VR); float* SST = (float*)(ws + WS_SST);
    bf16_t* QD = (bf16_t*)(ws + WS_QD); bf16_t* KD = (bf16_t*)(ws + WS_KD); bf16_t* VD = (bf16_t*)(ws + WS_VD); bf16_t* OD = (bf16_t*)(ws + WS_OD); bf16_t* AD = (bf16_t*)(ws + WS_AD);
    bf16_t* SG = (bf16_t*)(ws + WS_SG); float* MR = (float*)(ws + WS_MR); bf16_t* MB = (bf16_t*)(ws + WS_MB);
    bf16_t* SIDE = (bf16_t*)(ws + WS_SIDE); bf16_t* H = (bf16_t*)(ws + WS_H);
    bf16_t* YR = (bf16_t*)out;

    {
        CTX();
        float* scr = (float*)(lds + 65536) + C.wave * (64 * 33);
        constexpr int I_IN = 16 * 352, I_RET = 32 * 32, I_DIF = 16 * 32, I_O = 16 * 32, I_UP = 16 * 176, I_DN = 44 * 32;
        constexpr int NIT = I_IN + I_RET + I_DIF + I_O + I_UP + I_DN;
        for (int it = C.gw; it < NIT; it += C.NGW) {
            int r = it;
            if (r < I_IN) { transpose_item<1>(win, 1024, NIN, WIN, scr, r, C.lane); continue; } r -= I_IN;
            if (r < I_RET) { transpose_item<0>(wret, 2048, 1024, WRET, scr, r, C.lane); continue; } r -= I_RET;
            if (r < I_DIF) { transpose_item<0>(wdif, 1024, 1024, WDIF, scr, r, C.lane); continue; } r -= I_DIF;
            if (r < I_O) { transpose_item<0>(wo, 1024, 1024, WO, scr, r, C.lane); continue; } r -= I_O;
            if (r < I_UP) { transpose_item<2>(wup, 1024, 5632, WUP, scr, r, C.lane); continue; } r -= I_UP;
            transpose_item<0>(wdn, 2816, 1024, WDN, scr, r, C.lane);
        }
        d_mod(C, c, cctx, wmod, bmod, MOD);
        d_tables(C, logit, dlam, TAB, SCAL);
    }
    grid.sync();
    if (threadIdx.x == 0) { const unsigned* xq = (const unsigned*)(P.ws + WS_BAR) + 3584; unsigned pre = 0u; bool even = true;
        for (unsigned j = 0; j < 16; ++j) { const unsigned c_ = __hip_atomic_load(&xq[j * 8], __ATOMIC_RELAXED, __HIP_MEMORY_SCOPE_AGENT); if (j < misc_[4]) pre += c_; if (j < 8 ? c_ != gridDim.x / 8 : c_ != 0u) even = false; }
        misc_[6] = pre + misc_[5];
        misc_[7] = even ? (misc_[5] * 8u + misc_[4]) : blockIdx.x; }
    __syncthreads();
    REP(1) { CTX(); d_lnmod(C, x, ctx, lng, lnb, MOD, XM, STATS); }
    GSYNC();
    REP(2) fast_gemm(lds, XM, WIN + (size_t)C_QR * 1024, MA, 4096, 1024, FEpiRetQKV{QR, KR, VR, TAB});
    GSYNC();
    REP(3) { CTX(); d_ret_fast(C, QR, KR, VR, YR, SCAL); }
    GSYNC();
    REP(11) { CTX(); d_ret_stats(C, YR, RS); }
    REP(4) fast_gemm(lds, XM, WIN + (size_t)C_QD * 1024, MA, 3072, 1024, FEpiDifQKV{QD, KD, VD, TAB});
    GSYNC();
    REP(5) { CTX(); d_attn_fast(C, QD, KD, VD, AD, SCAL, gsub); }
    GSYNC();
    fast_gemm(lds, XM, WIN + (size_t)C_GR * 1024, ML, 2048, 1024, FEpiGr{YR, RS});
    GSYNC();
    REP(6) fast_gemm(lds, XM, WIN + (size_t)C_GATE * 1024, ML, 2048, 1024, FEpiGate{SG, bgate});
    GSYNC();
    REP(7) fast_gemm(lds, YR, WRET, ML, 1024, 2048, FEpiMr{MR, SG});
    GSYNC();
    REP(8) fast_gemm(lds, AD, WDIF, ML, 1024, 1024, FEpiMb{MB, MR, SG});
    GSYNC();
    fast_gemm(lds, MB, WO, ML, 1024, 1024, FEpiZ1{out, x, STATS, lng, lnb, MOD});
    GSYNC();
    { CTX(); d_ln_rows(C, out, ln1g, ln1b, MOD, XM); }
    GSYNC();
    REP(9) fast_gemm(lds, XM, WUP, ML, 5632, 1024, FEpiUGC{H, SIDE, cw, cb, lds});
    GSYNC();
    { CTX(); d_conv_fix(C, SIDE, cw, cb, H); }
    GSYNC();
    fast_gemm(lds, H, WDN, ML, 1024, DFF, FEpiZ2{out, MOD});
    GSYNC();
    { CTX(); d_ln_rows(C, out, ln2g, ln2b, MOD, (bf16_t*)nullptr); }
}

extern "C" void kernel_launch(void* const* d_in, const int* in_sizes, int n_in, void* d_out, int out_size, void* d_ws, size_t ws_size, hipStream_t stream) {
    static int grid = 0;
    if (grid == 0) {
        if (n_in != 24 || ws_size < WS_NEED) { fprintf(stderr, "kernel_launch: unexpected n_in %d / ws %zu\n", n_in, ws_size); grid = -1; return; }
        int dev = 0, cus = 0, per_cu = 0;
        if (hipGetDevice(&dev) != hipSuccess || hipDeviceGetAttribute(&cus, hipDeviceAttributeMultiprocessorCount, dev) != hipSuccess) { grid = -1; return; }
        if (hipFuncSetAttribute((const void*)mega, hipFuncAttributeMaxDynamicSharedMemorySize, LDS_BYTES) != hipSuccess) { fprintf(stderr, "kernel_launch: hipFuncSetAttribute failed\n"); grid = -1; return; }
        if (hipOccupancyMaxActiveBlocksPerMultiprocessor(&per_cu, (const void*)mega, 512, LDS_BYTES) != hipSuccess || per_cu < 1) { fprintf(stderr, "kernel_launch: occupancy query failed (%d)\n", per_cu); (void)hipGetLastError(); grid = -1; return; }
        grid = cus * 1;
        fprintf(stderr, "kernel_launch: cus %d per_cu %d grid %d\n", cus, per_cu, grid);
    }
    if (grid < 0) return;
    if (hipMemsetAsync((char*)d_ws + WS_BAR, 0, 16384, stream) != hipSuccess) { fprintf(stderr, "kernel_launch: memset failed\n"); return; }
    Params p{};
    for (int i = 0; i < 24; ++i) p.in[i] = (const float*)d_in[i];
    p.out = (float*)d_out; p.ws = (unsigned char*)d_ws;
    void* args[] = {&p};
    hipError_t e = hipLaunchCooperativeKernel((const void*)mega, dim3(grid), dim3(512), args, LDS_BYTES, stream);
    if (e != hipSuccess) fprintf(stderr, "kernel_launch: cooperative launch failed: %s (grid %d)\n", hipGetErrorString(e), grid);
}
```
